# Optimizing an MI355X kernel written in HIP

```python
import math
import jax, jax.numpy as jnp
from jax import lax
import numpy as np

D_MODEL = 2048
BATCH = 4
SEQ = 8192
DEPTH = 1

GRID_W = 64
CTX_LEN = 256
MIX_WIDTH = D_MODEL
DA_HEADS = 8
DA_QK_DIM = 64
DA_V_DIM = 2 * DA_QK_DIM
DA_WIDTH = DA_HEADS * DA_V_DIM
NA_HEADS = 8
NA_HEAD_DIM = 128
NA_WIDTH = NA_HEADS * NA_HEAD_DIM
NA_WIN_ROWS = 8
NA_WIN_COLS = 16
Q_BLOCK = 128
ROPE_BASE = 10000.0
NORM_EPS = 1e-6
SUBLN_EPS = 1e-5
IN_COLS = 4 * DA_WIDTH + 4 * NA_WIDTH
NA_OFF = 4 * DA_WIDTH

kernel_name = "hybrid_diffattn_natten_dit_layer"


def rmsnorm(x, g, eps=NORM_EPS):
    xf = x.astype(jnp.float32)
    y = xf * lax.rsqrt(jnp.mean(xf * xf, axis=-1, keepdims=True) + eps)
    return (y * g.astype(jnp.float32)).astype(x.dtype)


def rope_1d(x, pos):
    half = x.shape[-1] // 2
    inv_freq = ROPE_BASE ** (-jnp.arange(half, dtype=jnp.float32) / half)
    ang = pos.astype(jnp.float32)[:, None] * inv_freq[None, :]
    cos = jnp.cos(ang).astype(x.dtype)
    sin = jnp.sin(ang).astype(x.dtype)
    x1, x2 = x[..., :half], x[..., half:]
    return jnp.concatenate([x1 * cos - x2 * sin, x2 * cos + x1 * sin], axis=-1)


def axial_rope(x, row_pos, col_pos):
    a = x.shape[-1] // 2
    return jnp.concatenate([rope_1d(x[..., :a], row_pos), rope_1d(x[..., a:], col_pos)], axis=-1)


def diff_attention(q, k, v, k_ctx, v_ctx, row_pos, col_pos, lam, subln_g, lambda_init):
    B, S, _ = q.shape
    n_ctx = k_ctx.shape[1]
    split_qk = lambda t, n: t.reshape(B, n, DA_HEADS, 2, DA_QK_DIM).transpose(0, 2, 3, 1, 4)
    split_v = lambda t, n: t.reshape(B, n, DA_HEADS, DA_V_DIM).transpose(0, 2, 1, 3)
    qh = axial_rope(split_qk(q, S), row_pos, col_pos) * (DA_QK_DIM ** -0.5)
    kh = axial_rope(split_qk(k, S), row_pos, col_pos)
    k_all = jnp.concatenate([kh, split_qk(k_ctx, n_ctx)], axis=3)
    v_all = jnp.concatenate([split_v(v, S), split_v(v_ctx, n_ctx)], axis=2)
    nb = S // Q_BLOCK
    q_blocks = jnp.moveaxis(qh.reshape(B, DA_HEADS, 2, nb, Q_BLOCK, DA_QK_DIM), 3, 0)

    def block(qb):
        s = jnp.einsum('bhiqd,bhikd->bhiqk', qb, k_all).astype(jnp.float32)
        p = jax.nn.softmax(s, axis=-1)
        attn = p[:, :, 0] - lam * p[:, :, 1]
        return jnp.einsum('bhqk,bhkd->bhqd', attn.astype(v_all.dtype), v_all)

    out = lax.map(block, q_blocks)
    out = out.transpose(1, 0, 3, 2, 4).reshape(B, S, DA_HEADS, DA_V_DIM)
    out = rmsnorm(out, subln_g, SUBLN_EPS) * (1.0 - lambda_init)
    return out.reshape(B, S, DA_WIDTH)


def neighbourhood_attention(q, k, v, k_ctx, v_ctx, rpb_l, rows):
    B, S, _ = q.shape
    n_ctx = k_ctx.shape[1]
    kr = min(NA_WIN_ROWS, rows)
    kc = min(NA_WIN_COLS, GRID_W)
    grid = lambda t: t.reshape(B, rows, GRID_W, NA_HEADS, NA_HEAD_DIM).transpose(0, 3, 1, 2, 4)
    qg = grid(q) * (NA_HEAD_DIM ** -0.5)
    kg = grid(k)
    vg = grid(v)
    kcx = k_ctx.reshape(B, n_ctx, NA_HEADS, NA_HEAD_DIM).transpose(0, 2, 1, 3)
    vcx = v_ctx.reshape(B, n_ctx, NA_HEADS, NA_HEAD_DIM).transpose(0, 2, 1, 3)
    j = np.arange(GRID_W)
    c0 = np.clip(j - kc // 2, 0, GRID_W - kc)
    col_idx_np = c0[:, None] + np.arange(kc)[None, :]
    col_off_np = col_idx_np - j[:, None] + (NA_WIN_COLS - 1)
    col_idx = jnp.asarray(col_idx_np, dtype=jnp.int32)
    bias_cols = rpb_l[:, :, jnp.asarray(col_off_np, dtype=jnp.int32)]
    n_win = kr * kc

    def row_block(args):
        r, q_row = args
        r0 = jnp.clip(r - kr // 2, 0, rows - kr)
        k_band = lax.dynamic_slice_in_dim(kg, r0, kr, axis=2)
        v_band = lax.dynamic_slice_in_dim(vg, r0, kr, axis=2)
        k_win = k_band[:, :, :, col_idx]
        v_win = v_band[:, :, :, col_idx]
        row_off = r0 + jnp.arange(kr, dtype=jnp.int32) - r + (NA_WIN_ROWS - 1)
        bias = jnp.transpose(bias_cols[:, row_off], (0, 2, 1, 3))
        s_win = jnp.einsum('bhqd,bhrqcd->bhqrc', q_row, k_win).astype(jnp.float32) + bias.astype(jnp.float32)
        s_ctx = jnp.einsum('bhqd,bhcd->bhqc', q_row, kcx).astype(jnp.float32)
        s = jnp.concatenate([s_win.reshape(B, NA_HEADS, GRID_W, n_win), s_ctx], axis=-1)
        p = jax.nn.softmax(s, axis=-1).astype(v.dtype)
        p_win = p[..., :n_win].reshape(B, NA_HEADS, GRID_W, kr, kc)
        return (jnp.einsum('bhqrc,bhrqcd->bhqd', p_win, v_win)
                + jnp.einsum('bhqc,bhcd->bhqd', p[..., n_win:], vcx))

    out = lax.map(row_block, (jnp.arange(rows, dtype=jnp.int32), jnp.moveaxis(qg, 2, 0)))
    return out.transpose(1, 0, 3, 2, 4).reshape(B, S, NA_WIDTH)


def setup_inputs(seed: int = 0) -> dict:
    key = jax.random.key(seed)
    ks = jax.random.split(key, 16)
    f32 = jnp.float32
    nrm = lambda k, shape, s: jax.random.normal(k, shape, f32) * s
    return {
        "x": nrm(ks[0], (BATCH, SEQ, D_MODEL), 1.0),
        "c": nrm(ks[1], (BATCH, D_MODEL), 1.0),
        "ctx": nrm(ks[2], (BATCH, CTX_LEN, D_MODEL), 1.0),
        "c_ctx": nrm(ks[3], (D_MODEL,), 1.0),
        "norm_g": 1.0 + nrm(ks[4], (DEPTH, D_MODEL), 0.02),
        "w_mod": nrm(ks[5], (DEPTH, D_MODEL, 3 * D_MODEL), 0.5 * D_MODEL ** -0.5),
        "b_mod": nrm(ks[6], (DEPTH, 3 * D_MODEL), 0.02),
        "w_in": nrm(ks[7], (DEPTH, D_MODEL, IN_COLS), D_MODEL ** -0.5),
        "w_out": nrm(ks[8], (DEPTH, MIX_WIDTH, D_MODEL), MIX_WIDTH ** -0.5),
        "lam_q1": nrm(ks[9], (DEPTH, DA_QK_DIM), 0.1),
        "lam_k1": nrm(ks[10], (DEPTH, DA_QK_DIM), 0.1),
        "lam_q2": nrm(ks[11], (DEPTH, DA_QK_DIM), 0.1),
        "lam_k2": nrm(ks[12], (DEPTH, DA_QK_DIM), 0.1),
        "subln_g": 1.0 + nrm(ks[13], (DEPTH, DA_V_DIM), 0.02),
        "rpb": nrm(ks[14], (DEPTH, NA_HEADS, 2 * NA_WIN_ROWS - 1, 2 * NA_WIN_COLS - 1), 0.1),
        "final_g": 1.0 + nrm(ks[15], (D_MODEL,), 0.02),
    }


def reference(x, c, ctx, c_ctx, norm_g, w_mod, b_mod, w_in, w_out, lam_q1, lam_k1, lam_q2, lam_k2, subln_g, rpb, final_g):
    B, S, _ = x.shape
    rows = S // GRID_W
    t = jnp.arange(S, dtype=jnp.int32)
    row_pos = t // GRID_W
    col_pos = t % GRID_W
    h = x
    for layer in range(DEPTH):
        lambda_init = 0.8 - 0.6 * math.exp(-0.3 * layer)
        wm, bm, wi = w_mod[layer], b_mod[layer], w_in[layer]
        shift, scale, gate = jnp.split(jax.nn.silu(c) @ wm + bm, 3, axis=-1)
        shift_c, scale_c = jnp.split(jax.nn.silu(c_ctx) @ wm[:, :2 * D_MODEL] + bm[:2 * D_MODEL], 2, axis=-1)
        hx = rmsnorm(h, norm_g[layer]) * (1.0 + scale[:, None]) + shift[:, None]
        hc = rmsnorm(ctx, norm_g[layer]) * (1.0 + scale_c) + shift_c
        proj = hx @ wi
        qa, ka, va, ga, qb, kb, vb, gb = jnp.split(proj, 8, axis=-1)
        ka_c, va_c = jnp.split(hc @ wi[:, DA_WIDTH:3 * DA_WIDTH], 2, axis=-1)
        kb_c, vb_c = jnp.split(hc @ wi[:, NA_OFF + NA_WIDTH:NA_OFF + 3 * NA_WIDTH], 2, axis=-1)
        lq1, lk1 = lam_q1[layer].astype(jnp.float32), lam_k1[layer].astype(jnp.float32)
        lq2, lk2 = lam_q2[layer].astype(jnp.float32), lam_k2[layer].astype(jnp.float32)
        lam = jnp.exp(jnp.sum(lq1 * lk1)) - jnp.exp(jnp.sum(lq2 * lk2)) + lambda_init
        oa = diff_attention(qa, ka, va, ka_c, va_c, row_pos, col_pos, lam, subln_g[layer], lambda_init)
        oa = oa * jax.nn.silu(ga)
        ob = neighbourhood_attention(qb, kb, vb, kb_c, vb_c, rpb[layer], rows) * jax.nn.silu(gb)
        mixed = jnp.concatenate([oa, ob], axis=-1) @ w_out[layer]
        h = h + gate[:, None] * mixed
    return rmsnorm(h, final_g)
```

```cpp
#include <hip/hip_runtime.h>
#include <hip/hip_cooperative_groups.h>
#include <cstdio>
#include <cstdint>
namespace cg = cooperative_groups;

#define LAS __attribute__((address_space(3)))
typedef unsigned short bf16_t;
typedef short bf16x8 __attribute__((ext_vector_type(8)));
typedef short s16x4 __attribute__((ext_vector_type(4)));
typedef float f32x4 __attribute__((ext_vector_type(4)));
typedef float f32x16 __attribute__((ext_vector_type(16)));
typedef unsigned u32x4 __attribute__((ext_vector_type(4)));

constexpr int DM = 2048, NB = 4, SEQ = 8192, CTX = 256, NTOK = NB * SEQ, NCTX = NB * CTX, INC = 8192, SKV = SEQ + CTX;
constexpr float LOG2E = 1.4426950408889634f;
constexpr float C2A = 0.125f * LOG2E;
constexpr float C2B = 0.08838834764831845f * LOG2E;
constexpr size_t MiB = 1u << 20;
constexpr size_t WS_MOD = 0, WS_LAM = 128 * 1024, WS_ROPE = 192 * 1024, WS_WIN = 1 * MiB, WS_WOUT = 33 * MiB, WS_HX = 48 * MiB;
constexpr size_t WS_QA = 192 * MiB, WS_KA = 256 * MiB, WS_VA = 328 * MiB, WS_QB = 400 * MiB, WS_KB = 464 * MiB, WS_VB = 536 * MiB;
constexpr size_t WS_G = 608 * MiB, WS_MIX = 736 * MiB, WS_END = 864 * MiB;
constexpr int LDS_BYTES = 135168;

__device__ __forceinline__ unsigned cvtpk(float lo, float hi) { unsigned r; asm volatile("v_cvt_pk_bf16_f32 %0, %1, %2" : "=v"(r) : "v"(lo), "v"(hi)); return r; }
__device__ __forceinline__ float bf2f(bf16_t v) { return __uint_as_float((unsigned)v << 16); }
__device__ __forceinline__ float silu_f(float v) { return v * __builtin_amdgcn_rcpf(1.f + __builtin_amdgcn_exp2f(-v * LOG2E)); }
__device__ __forceinline__ float wave_sum(float v) {
#pragma unroll
    for (int o = 1; o < 64; o <<= 1) v += __shfl_xor(v, o);
    return v;
}

namespace pg8 {
constexpr int BM = 256, BK = 64, HALF = 128, HTB = HALF * BK * 2, NXCD = 8, WGM = 8;
__host__ __device__ __forceinline__ int lds_byte(int r, int c) { const int st = (r >> 4) * 2 + (c >> 5), rr = r & 15, cc = c & 31, ob = rr * 64 + cc * 2; return st * 1024 + (ob ^ (((ob >> 9) & 1) << 5)); }
__host__ __device__ __forceinline__ void stage_rc(int b, int& R, int& C) { const int st = b / 1024, sb = b % 1024, swz = sb ^ (((sb >> 9) & 1) << 5); R = (st >> 1) * 16 + swz / 64; C = (st & 1) * 32 + (swz % 64) / 2; }
__host__ __device__ __forceinline__ int perm32(int rho) { const int n = rho >> 4, i = rho & 15; return 8 * (i >> 2) + 4 * n + (i & 3); }
__host__ __device__ __forceinline__ int perm32inv(int q) { return 16 * ((q >> 2) & 1) + 4 * (q >> 3) + (q & 3); }
struct Unit { int pm, pn; };
struct Gemm { const bf16_t* A; const bf16_t* Bt; int K; };

struct Order {
    int nM, nN, nwg, G, c, nX;
    __device__ void init(int nM_, int nN_, int G_, int c_, int nX_) { nM = nM_; nN = nN_; nwg = nM * nN; G = G_; c = c_; nX = nX_; }
    __device__ bool next(int i, Unit& u) const {
        const int L = i * G + c; if (L >= nwg + nX) return false;
        if (L >= nwg) { const int e = L - nwg; u.pm = nM + (e >> 4); const int q = e & 15; u.pn = q < 8 ? 4 + q : 12 + q; return true; }
        int wgid = L; { const int q = nwg / NXCD, r = nwg % NXCD, xcd = wgid % NXCD, off = wgid / NXCD; wgid = (xcd < r ? xcd * (q + 1) : r * (q + 1) + (xcd - r) * q) + off; }
        const int nig = WGM * nN, gid = wgid / nig, fm = gid * WGM, gsz = (nM - fm) < WGM ? (nM - fm) : WGM;
        u.pm = fm + ((wgid % nig) % gsz); u.pn = (wgid % nig) / gsz; return true;
    }
};

template <class Epi>
__device__ __forceinline__ void gemm_phase(LAS unsigned char* lds, const Gemm g, const Order& S, const Epi& E) {
    int tid = threadIdx.x; asm volatile("" : "+v"(tid));
    const int wid = __builtin_amdgcn_readfirstlane(tid >> 6), lane = tid & 63, wr = wid >> 2, wc = wid & 3, fr = lane & 15, fq = lane >> 4;
    const int K = g.K, nt = K / BK;
    unsigned voffA[2], voffB[2];
#pragma unroll
    for (int i = 0; i < 2; ++i) { int R, C; stage_rc(tid * 16 + i * 8192, R, C); const int Rb = (R & ~31) + perm32(R & 31);
        voffA[i] = (unsigned)(R * K + C) * 2u; voffB[i] = (unsigned)(Rb * K + C) * 2u; }
    const size_t kstep = (size_t)(BK * 2);
    const size_t hstep = (size_t)HALF * K * 2;
    const size_t tstep = 2 * hstep;
    const unsigned ldsw = (unsigned)wid * 1024u;
    const int aoff = lds_byte(wr * 64 + fr, fq * 8), boff = lds_byte(wc * 32 + fr, fq * 8);
#define PG8_SA(b, h) (((b) * 2 + (h)) * HTB)
#define PG8_SB(b, h) ((4 + (b) * 2 + (h)) * HTB)
#define PG8_STAGE(bufoff, gbase, voff) do { _Pragma("unroll") for (int _i = 0; _i < 2; ++_i) \
        __builtin_amdgcn_global_load_lds((const unsigned*)((const char*)(gbase) + (voff)[_i]), (LAS unsigned*)(lds + (bufoff) + ldsw + _i * 8192), 16, 0, 0); } while (0)
#define PG8_LDA(dst, b, h) do { _Pragma("unroll") for (int m = 0; m < 4; ++m) _Pragma("unroll") for (int k = 0; k < 2; ++k) dst[m][k] = *(const LAS bf16x8*)(lds + PG8_SA(b, h) + aoff + m * 2048 + k * 1024); } while (0)
#define PG8_LDB(dst, b, h) do { _Pragma("unroll") for (int n = 0; n < 2; ++n) _Pragma("unroll") for (int k = 0; k < 2; ++k) dst[n][k] = *(const LAS bf16x8*)(lds + PG8_SB(b, h) + boff + n * 2048 + k * 1024); } while (0)
#define PG8_MMA(ai, bj, At, Bt) do { __builtin_amdgcn_s_setprio(1); _Pragma("unroll") for (int m = 0; m < 4; ++m) _Pragma("unroll") for (int n = 0; n < 2; ++n) _Pragma("unroll") for (int k = 0; k < 2; ++k) \
        acc[ai][bj][m][n] = __builtin_amdgcn_mfma_f32_16x16x32_bf16(Bt[n][k], At[m][k], acc[ai][bj][m][n], 0, 0, 0); __builtin_amdgcn_s_setprio(0); } while (0)
#define PG8_WAIT_V(n) asm volatile("s_waitcnt vmcnt(" #n ")" ::: "memory")
#define PG8_WAIT_L(n) asm volatile("s_waitcnt lgkmcnt(" #n ")" ::: "memory")
#define PG8_BAR __builtin_amdgcn_s_barrier()
#define PG8_SCHED __builtin_amdgcn_sched_barrier(0)
    Unit cur, nxt; int ui = 0;
    if (!S.next(0, cur)) return;
    f32x4 acc[2][2][4][2];
#pragma unroll
    for (int a = 0; a < 2; ++a)
#pragma unroll
        for (int b = 0; b < 2; ++b)
#pragma unroll
            for (int m = 0; m < 4; ++m)
#pragma unroll
                for (int n = 0; n < 2; ++n) acc[a][b][m][n] = (f32x4){0.f, 0.f, 0.f, 0.f};
    bf16x8 At[4][2], B0[2][2], B1[2][2];
    const char* cA = (const char*)g.A + (size_t)cur.pm * tstep; const char* cB = (const char*)g.Bt + (size_t)cur.pn * tstep;
    PG8_STAGE(PG8_SB(0, 0), cB, voffB); PG8_STAGE(PG8_SB(0, 1), cB + hstep, voffB); PG8_STAGE(PG8_SA(0, 0), cA, voffA); PG8_STAGE(PG8_SA(0, 1), cA + hstep, voffA);
    if (wr == 1) PG8_BAR;
    PG8_WAIT_V(2); PG8_BAR;
    PG8_STAGE(PG8_SB(1, 0), cB + kstep, voffB); PG8_STAGE(PG8_SA(1, 0), cA + kstep, voffA); PG8_STAGE(PG8_SB(1, 1), cB + hstep + kstep, voffB);
    PG8_WAIT_V(6); PG8_BAR;
    for (;;) {
        const bool has_next = S.next(ui + 1, nxt);
        const char* nA = has_next ? (const char*)g.A + (size_t)nxt.pm * tstep : cA; const char* nB = has_next ? (const char*)g.Bt + (size_t)nxt.pn * tstep : cB;
        for (int t = 0; t < nt; t += 2) {
            const bool last = (t == nt - 2);
            const char* a1 = cA + (size_t)(t + 1) * kstep;
            const char* a2 = last ? nA : cA + (size_t)(t + 2) * kstep; const char* b2 = last ? nB : cB + (size_t)(t + 2) * kstep;
            const char* a3 = a2 + kstep; const char* b3 = b2 + kstep;
            PG8_LDB(B0, 0, 0); PG8_LDB(B1, 0, 1); PG8_SCHED; PG8_LDA(At, 0, 0); PG8_STAGE(PG8_SA(1, 1), a1 + hstep, voffA);
            PG8_WAIT_V(8); PG8_WAIT_L(0); PG8_BAR; PG8_MMA(0, 0, At, B0); PG8_MMA(0, 1, At, B1); PG8_BAR; PG8_SCHED;
            PG8_LDA(At, 0, 1); PG8_STAGE(PG8_SB(0, 0), b2, voffB); PG8_STAGE(PG8_SB(0, 1), b2 + hstep, voffB); PG8_STAGE(PG8_SA(0, 0), a2, voffA);
            PG8_WAIT_V(8); PG8_WAIT_L(0); PG8_BAR; PG8_MMA(1, 0, At, B0); PG8_MMA(1, 1, At, B1); PG8_BAR; PG8_SCHED;
            PG8_LDB(B0, 1, 0); PG8_LDB(B1, 1, 1); PG8_SCHED; PG8_LDA(At, 1, 0); PG8_STAGE(PG8_SA(0, 1), a2 + hstep, voffA);
            PG8_WAIT_V(8); PG8_WAIT_L(0); PG8_BAR; PG8_MMA(0, 0, At, B0); PG8_MMA(0, 1, At, B1); PG8_BAR; PG8_SCHED;
            PG8_LDA(At, 1, 1); PG8_STAGE(PG8_SB(1, 0), b3, voffB); PG8_STAGE(PG8_SB(1, 1), b3 + hstep, voffB); PG8_STAGE(PG8_SA(1, 0), a3, voffA);
            PG8_WAIT_V(8); PG8_WAIT_L(0); PG8_BAR; PG8_MMA(1, 0, At, B0); PG8_MMA(1, 1, At, B1); PG8_BAR; PG8_SCHED;
        }
        if (wr == 0) PG8_BAR;
        E(acc, cur, wr, wc, fr, fq);
        if (!has_next) break;
#pragma unroll
        for (int a = 0; a < 2; ++a)
#pragma unroll
            for (int b = 0; b < 2; ++b)
#pragma unroll
                for (int m = 0; m < 4; ++m)
#pragma unroll
                    for (int n = 0; n < 2; ++n) acc[a][b][m][n] = (f32x4){0.f, 0.f, 0.f, 0.f};
        cur = nxt; cA = nA; cB = nB; ++ui;
        if (wr == 1) PG8_BAR;
    }
    PG8_WAIT_V(0);
    PG8_BAR;
#undef PG8_SA
#undef PG8_SB
#undef PG8_STAGE
#undef PG8_LDA
#undef PG8_LDB
#undef PG8_MMA
#undef PG8_WAIT_V
#undef PG8_WAIT_L
#undef PG8_BAR
#undef PG8_SCHED
}
}

struct EpiIn {
    static constexpr bool PERM = true;
    bf16_t *QA, *KA, *VA, *QB, *KB, *VB, *G; const float* rope;
    __device__ __forceinline__ void operator()(const f32x4 (&acc)[2][2][4][2], const pg8::Unit& u, int wr, int wc, int fr, int fq) const {
        const int type = u.pn >> 2, hb = (u.pn & 3) * 2;
        const bool isctx = u.pm >= 128;
        const int b = isctx ? u.pm - 128 : (u.pm >> 5);
        const int sbase = (isctx ? SEQ : (u.pm & 31) * 256) + wr * 64 + fr;
        const int dcol = wc * 32 + 8 * fq;
        if (type == 3 || type == 7) {
            bf16_t* gp = G + ((size_t)b * SEQ + sbase) * DM + (type == 7 ? 1024 : 0) + hb * 128 + dcol;
#pragma unroll
            for (int ai = 0; ai < 2; ++ai)
#pragma unroll
                for (int m = 0; m < 4; ++m)
#pragma unroll
                    for (int bj = 0; bj < 2; ++bj) {
                        const f32x4 v0 = acc[ai][bj][m][0], v1 = acc[ai][bj][m][1];
                        u32x4 w; w.x = cvtpk(silu_f(v0[0]), silu_f(v0[1])); w.y = cvtpk(silu_f(v0[2]), silu_f(v0[3]));
                        w.z = cvtpk(silu_f(v1[0]), silu_f(v1[1])); w.w = cvtpk(silu_f(v1[2]), silu_f(v1[3]));
                        *(u32x4*)(gp + (size_t)(ai * 128 + m * 16) * DM + bj * 128) = w;
                    }
            return;
        }
        bf16_t* base; int SK; float sc = 1.f;
        switch (type) {
            case 0: base = QA; SK = SEQ; sc = C2A; break;
            case 1: base = KA; SK = SKV; break;
            case 2: base = VA; SK = SKV; break;
            case 4: base = QB; SK = SEQ; sc = C2B; break;
            case 5: base = KB; SK = SKV; break;
            default: base = VB; SK = SKV; break;
        }
        const bool dorope = (type <= 1) && !isctx;
        bf16_t* op = base + ((size_t)(b * 8 + hb) * SK + sbase) * 128 + dcol;
        const size_t hstride = (size_t)SK * 128;
#pragma unroll
        for (int ai = 0; ai < 2; ++ai)
#pragma unroll
            for (int m = 0; m < 4; ++m) {
                f32x4 cs0 = {1.f, 0.f, 1.f, 0.f}, cs1 = {1.f, 0.f, 1.f, 0.f};
                if (dorope) { const int s = sbase + ai * 128 + m * 16; const int pos = (wc & 1) ? (s & 63) : (s >> 6);
                    const f32x4* rp = (const f32x4*)(rope + (size_t)(pos * 16 + 4 * fq) * 2); cs0 = rp[0]; cs1 = rp[1]; }
#pragma unroll
                for (int bj = 0; bj < 2; ++bj) {
                    const f32x4 x1 = acc[ai][bj][m][0], x2 = acc[ai][bj][m][1];
                    f32x4 y1, y2;
                    y1[0] = x1[0] * cs0[0] - x2[0] * cs0[1]; y2[0] = x2[0] * cs0[0] + x1[0] * cs0[1];
                    y1[1] = x1[1] * cs0[2] - x2[1] * cs0[3]; y2[1] = x2[1] * cs0[2] + x1[1] * cs0[3];
                    y1[2] = x1[2] * cs1[0] - x2[2] * cs1[1]; y2[2] = x2[2] * cs1[0] + x1[2] * cs1[1];
                    y1[3] = x1[3] * cs1[2] - x2[3] * cs1[3]; y2[3] = x2[3] * cs1[2] + x1[3] * cs1[3];
                    y1 = y1 * sc; y2 = y2 * sc;
                    u32x4 w; w.x = cvtpk(y1[0], y1[1]); w.y = cvtpk(y1[2], y1[3]); w.z = cvtpk(y2[0], y2[1]); w.w = cvtpk(y2[2], y2[3]);
                    *(u32x4*)(op + (size_t)(ai * 128 + m * 16) * 128 + bj * hstride) = w;
                }
            }
    }
};
struct EpiOut {
    static constexpr bool PERM = true;
    const float* x; const float* mod; float* out;
    __device__ __forceinline__ void operator()(const f32x4 (&acc)[2][2][4][2], const pg8::Unit& u, int wr, int wc, int fr, int fq) const {
        const int row0 = u.pm * 256 + wr * 64 + fr, b = u.pm >> 5, col0 = u.pn * 256 + wc * 32 + 8 * fq;
        f32x4 gv[2][2];
#pragma unroll
        for (int bj = 0; bj < 2; ++bj)
#pragma unroll
            for (int n = 0; n < 2; ++n) gv[bj][n] = *(const f32x4*)(mod + b * 6144 + 4096 + col0 + bj * 128 + 4 * n);
#pragma unroll
        for (int ai = 0; ai < 2; ++ai)
#pragma unroll
            for (int m = 0; m < 4; ++m) {
                const size_t ro = (size_t)(row0 + ai * 128 + m * 16) * DM + col0;
#pragma unroll
                for (int bj = 0; bj < 2; ++bj) {
                    const f32x4 x0 = *(const f32x4*)(x + ro + bj * 128), x1 = *(const f32x4*)(x + ro + bj * 128 + 4);
                    *(f32x4*)(out + ro + bj * 128) = x0 + gv[bj][0] * acc[ai][bj][m][0];
                    *(f32x4*)(out + ro + bj * 128 + 4) = x1 + gv[bj][1] * acc[ai][bj][m][1];
                }
            }
    }
};

#define KSWZ(row, colB) ((row) * 256 + ((colB) ^ (((row) & 7) << 4)))
#define SBAR() __builtin_amdgcn_sched_barrier(0)
__device__ __forceinline__ int crow(int r, int hi) { return (r & 3) + 8 * (r >> 2) + 4 * hi; }
__device__ __forceinline__ int v_st(int k, int c) { const int kk = (k & ~0xC) | ((k & 4) << 1) | ((k & 8) >> 1); return ((kk >> 3) * 4 + (c >> 5)) * 512 + ((kk & 7) * 32 + (c & 31)) * 2; }
__device__ __forceinline__ int v_rd_base(int lane) { return ((lane & 3) << 3) | (((lane >> 2) & 3) << 6) | (((lane >> 4) & 1) << 5) | (((lane >> 5) & 1) << 8); }
constexpr int v_rd_off(int d0, int ks, int half) { return d0 * 512 + ks * 4096 + half * 2048; }
template <int OFF> __device__ __forceinline__ s16x4 tr_read(int vb) {
    s16x4 r; asm volatile("ds_read_b64_tr_b16 %0, %1 offset:%2" : "=&v"(r) : "v"(vb), "i"(OFF) : "memory"); return r;
}
template <int D0> __device__ __forceinline__ void pv_one(f32x16& od, int vb, bf16x8 pa0, bf16x8 pa1, bf16x8 pa2, bf16x8 pa3) {
    const s16x4 l0 = tr_read<v_rd_off(D0, 0, 0)>(vb), h0 = tr_read<v_rd_off(D0, 0, 1)>(vb), l1 = tr_read<v_rd_off(D0, 1, 0)>(vb), h1 = tr_read<v_rd_off(D0, 1, 1)>(vb);
    const s16x4 l2 = tr_read<v_rd_off(D0, 2, 0)>(vb), h2 = tr_read<v_rd_off(D0, 2, 1)>(vb), l3 = tr_read<v_rd_off(D0, 3, 0)>(vb), h3 = tr_read<v_rd_off(D0, 3, 1)>(vb);
    asm volatile("s_waitcnt lgkmcnt(0)" ::: "memory"); SBAR();
#define PK(L, H) (bf16x8){L[0], L[1], L[2], L[3], H[0], H[1], H[2], H[3]}
    od = __builtin_amdgcn_mfma_f32_32x32x16_bf16(pa0, PK(l0, h0), od, 0, 0, 0);
    od = __builtin_amdgcn_mfma_f32_32x32x16_bf16(pa1, PK(l1, h1), od, 0, 0, 0);
    od = __builtin_amdgcn_mfma_f32_32x32x16_bf16(pa2, PK(l2, h2), od, 0, 0, 0);
    od = __builtin_amdgcn_mfma_f32_32x32x16_bf16(pa3, PK(l3, h3), od, 0, 0, 0);
#undef PK
}

template <int NMAP, int D0> __device__ __forceinline__ void pv_all(f32x16 (&o)[NMAP][4], int vb, const bf16x8 (&pa)[NMAP][4]) {
    const s16x4 l0 = tr_read<v_rd_off(D0, 0, 0)>(vb), h0 = tr_read<v_rd_off(D0, 0, 1)>(vb), l1 = tr_read<v_rd_off(D0, 1, 0)>(vb), h1 = tr_read<v_rd_off(D0, 1, 1)>(vb);
    const s16x4 l2 = tr_read<v_rd_off(D0, 2, 0)>(vb), h2 = tr_read<v_rd_off(D0, 2, 1)>(vb), l3 = tr_read<v_rd_off(D0, 3, 0)>(vb), h3 = tr_read<v_rd_off(D0, 3, 1)>(vb);
    asm volatile("s_waitcnt lgkmcnt(0)" ::: "memory"); SBAR();
#define PK(L, H) (bf16x8){L[0], L[1], L[2], L[3], H[0], H[1], H[2], H[3]}
    const bf16x8 v0 = PK(l0, h0), v1 = PK(l1, h1), v2 = PK(l2, h2), v3 = PK(l3, h3);
#undef PK
#pragma unroll
    for (int mp = 0; mp < NMAP; ++mp) {
        o[mp][D0] = __builtin_amdgcn_mfma_f32_32x32x16_bf16(pa[mp][0], v0, o[mp][D0], 0, 0, 0);
        o[mp][D0] = __builtin_amdgcn_mfma_f32_32x32x16_bf16(pa[mp][1], v1, o[mp][D0], 0, 0, 0);
        o[mp][D0] = __builtin_amdgcn_mfma_f32_32x32x16_bf16(pa[mp][2], v2, o[mp][D0], 0, 0, 0);
        o[mp][D0] = __builtin_amdgcn_mfma_f32_32x32x16_bf16(pa[mp][3], v3, o[mp][D0], 0, 0, 0);
    }
}

struct AttnP { const bf16_t *QA, *KA, *VA, *QB, *KB, *VB, *G; bf16_t* MIX; const float *subln_g, *rpb, *lam; };

template <int MODE>
__device__ __forceinline__ void attn_item(const AttnP& a, int b, int h, int blk, char* lds) {
    constexpr int NMAP = MODE == 0 ? 2 : 1, KD0 = MODE == 0 ? 4 : 8, NT = MODE == 0 ? SKV / 64 : 16;
    constexpr float THR = 8.f;
    int tid = threadIdx.x; asm volatile("" : "+v"(tid));
    const int wid = __builtin_amdgcn_readfirstlane(tid >> 6), lane = tid & 63, r32 = lane & 31, hi = lane >> 5;
    char* V_lds = lds; char* K_lds = lds + 32768;
    float* wsf = (float*)(lds + 65536) + wid * 64;
    float* rpbs = (float*)(lds + 65536 + 2048);
    char* Qw = lds + 69632 + wid * 8192;
    const size_t bh = (size_t)(b * 8 + h);
    const int qrow = 4 * blk + (wid >> 1), half = wid & 1;
    const int qtok = MODE == 0 ? blk * 256 + wid * 32 : qrow * 64 + half * 32;
    const int ulo = min(max(4 * blk - 4, 0), 116), r0w = min(max(qrow - 4, 0), 120);
    {
        const bf16_t* Qg = (MODE == 0 ? a.QA : a.QB) + (bh * SEQ + qtok) * 128;
#pragma unroll
        for (int i = 0; i < 8; ++i) { const int row = i * 4 + (lane >> 4), c16 = lane & 15;
            const bf16x8 qv = *(const bf16x8*)(Qg + (size_t)row * 128 + c16 * 8);
            *(bf16x8*)(Qw + KSWZ(row, c16 * 16)) = qv; }
    }
    const char* Kh = (const char*)((MODE == 0 ? a.KA : a.KB) + bh * SKV * 128);
    const char* Vh = (const char*)((MODE == 0 ? a.VA : a.VB) + bh * SKV * 128);
    unsigned voffK[2], voffV[2];
#pragma unroll
    for (int ii = 0; ii < 2; ++ii) {
        const int krow = 8 * wid + 4 * ii + (lane >> 4), kch = (lane & 15) ^ (krow & 7);
        voffK[ii] = (unsigned)(krow * 256 + kch * 16);
        const int sub = 2 * (2 * wid + ii) + (lane >> 5), kk = (sub >> 2) * 8 + ((lane & 31) >> 2), cblk = sub & 3;
        const int kreal = (kk & ~0xC) | ((kk & 4) << 1) | ((kk & 8) >> 1);
        voffV[ii] = (unsigned)(kreal * 256 + (cblk * 32 + (lane & 3) * 8) * 2);
    }
    const int vb0 = (int)(uintptr_t)V_lds + v_rd_base(lane);
    int koff[4];
#pragma unroll
    for (int i = 0; i < 4; ++i) koff[i] = r32 * 256 + (((2 * i + hi) ^ (r32 & 7)) << 4);
    if (MODE == 1) { for (int i = tid; i < 465; i += 512) rpbs[i] = a.rpb[h * 465 + i] * LOG2E; }
    f32x16 o[NMAP][4]; float m_reg[NMAP], l_reg[NMAP];
#pragma unroll
    for (int mp = 0; mp < NMAP; ++mp) { m_reg[mp] = -1e30f; l_reg[mp] = 0.f;
#pragma unroll
        for (int d = 0; d < 4; ++d) o[mp][d] = f32x16{}; }
#define TROW(t) (MODE == 0 ? (t) * 64 : ((t) < 4 ? SEQ + (t) * 64 : (ulo + (t) - 4) * 64))
#define STAGE(t, bi) do { const size_t g0_ = (size_t)TROW(t) * 256; _Pragma("unroll") for (int ii_ = 0; ii_ < 2; ++ii_) { \
        __builtin_amdgcn_global_load_lds((const unsigned*)(Kh + g0_ + voffK[ii_]), (LAS unsigned*)((LAS unsigned char*)K_lds + (bi) * 16384 + wid * 2048 + ii_ * 1024), 16, 0, 0); \
        __builtin_amdgcn_global_load_lds((const unsigned*)(Vh + g0_ + voffV[ii_]), (LAS unsigned*)((LAS unsigned char*)V_lds + (bi) * 16384 + wid * 2048 + ii_ * 1024), 16, 0, 0); } } while (0)
    STAGE(0, 0);
    asm volatile("s_waitcnt vmcnt(0) lgkmcnt(0)" ::: "memory");
    __syncthreads();
    for (int t = 0; t < NT; ++t) {
        const int cur = t & 1;
        if (t + 1 < NT) STAGE(t + 1, cur ^ 1);
        bool active = true; int br = 0;
        if (MODE == 1 && t >= 4) { br = ulo + t - 4; active = (br >= r0w) && (br <= r0w + 7); }
        if (active) {
            const char* Kc = K_lds + cur * 16384; const int vb = vb0 + cur * 16384;
            bf16x8 pa[NMAP][4];
#pragma unroll
            for (int mp = 0; mp < NMAP; ++mp) {
                SBAR();
                f32x16 p0 = f32x16{}, p1 = f32x16{};
#pragma unroll
                for (int d0 = 0; d0 < KD0; ++d0) { const int dd = (MODE == 0 ? mp * 4 : 0) + d0; const int off = koff[dd & 3] + (dd >> 2) * 128;
                    const bf16x8 k0 = *(const bf16x8*)(Kc + off); const bf16x8 k1 = *(const bf16x8*)(Kc + off + 8192);
                    const bf16x8 qf = *(const bf16x8*)(Qw + off);
                    p0 = __builtin_amdgcn_mfma_f32_32x32x16_bf16(k0, qf, p0, 0, 0, 0);
                    p1 = __builtin_amdgcn_mfma_f32_32x32x16_bf16(k1, qf, p1, 0, 0, 0);
                    if ((d0 & 1) == 1) SBAR(); }
                if (MODE == 1 && t >= 4) {
                    const int j = half * 32 + r32, c0 = min(max(j - 8, 0), 48);
                    const float* bp = rpbs + (br - qrow + 7) * 31 + 15 - j;
#pragma unroll
                    for (int r = 0; r < 16; ++r) { const int kc = crow(r, hi); const bool ok = (unsigned)(kc - c0) < 16u; const float bv = bp[ok ? kc : j];
                        p0[r] = ok ? p0[r] + bv : -1e30f; }
#pragma unroll
                    for (int r = 0; r < 16; ++r) { const int kc = 32 + crow(r, hi); const bool ok = (unsigned)(kc - c0) < 16u; const float bv = bp[ok ? kc : j];
                        p1[r] = ok ? p1[r] + bv : -1e30f; }
                }
                float pmax = p0[0];
#pragma unroll
                for (int r = 1; r < 16; ++r) pmax = fmaxf(pmax, p0[r]);
#pragma unroll
                for (int r = 0; r < 16; ++r) pmax = fmaxf(pmax, p1[r]);
                { auto rr = __builtin_amdgcn_permlane32_swap(__float_as_uint(pmax), __float_as_uint(pmax), false, false);
                  pmax = fmaxf(__uint_as_float(rr[0]), __uint_as_float(rr[1])); }
                float mn = m_reg[mp], alpha = 1.f;
                if (!__all(pmax - m_reg[mp] <= THR)) { mn = fmaxf(m_reg[mp], pmax); alpha = __builtin_amdgcn_exp2f(m_reg[mp] - mn); m_reg[mp] = mn; }
                float ps = 0.f;
#pragma unroll
                for (int r = 0; r < 16; ++r) { p0[r] = __builtin_amdgcn_exp2f(p0[r] - mn); ps += p0[r]; }
#pragma unroll
                for (int r = 0; r < 16; ++r) { p1[r] = __builtin_amdgcn_exp2f(p1[r] - mn); ps += p1[r]; }
                { auto rr = __builtin_amdgcn_permlane32_swap(__float_as_uint(ps), __float_as_uint(ps), false, false);
                  ps = __uint_as_float(rr[0]) + __uint_as_float(rr[1]); }
                l_reg[mp] = l_reg[mp] * alpha + ps;
#define PK4(P, BASE, OUT) do { unsigned a0 = cvtpk(P[BASE + 0], P[BASE + 1]), a1 = cvtpk(P[BASE + 2], P[BASE + 3]);   \
    unsigned b0 = cvtpk(P[BASE + 4], P[BASE + 5]), b1 = cvtpk(P[BASE + 6], P[BASE + 7]);                              \
    auto r0 = __builtin_amdgcn_permlane32_swap(a0, b0, false, false); auto r1 = __builtin_amdgcn_permlane32_swap(a1, b1, false, false); \
    u32x4 w = {r0[0], r1[0], r0[1], r1[1]}; OUT = *reinterpret_cast<bf16x8*>(&w); } while (0)
                PK4(p0, 0, pa[mp][0]); PK4(p0, 8, pa[mp][1]); PK4(p1, 0, pa[mp][2]); PK4(p1, 8, pa[mp][3]);
#undef PK4
                if (__any(alpha < 1.f)) {
                    if (hi == 0) wsf[r32] = alpha;
                    asm volatile("s_waitcnt lgkmcnt(0)" ::: "memory");
#pragma unroll
                    for (int r = 0; r < 16; ++r) { const float al = wsf[crow(r, hi)];
#pragma unroll
                        for (int d = 0; d < 4; ++d) o[mp][d][r] *= al; }
                }
            }
            SBAR();
            pv_all<NMAP, 0>(o, vb, pa); pv_all<NMAP, 1>(o, vb, pa); pv_all<NMAP, 2>(o, vb, pa); pv_all<NMAP, 3>(o, vb, pa);
        }
        asm volatile("s_waitcnt vmcnt(0)" ::: "memory");
        __syncthreads();
    }
#undef TROW
#undef STAGE
    const float lam = MODE == 0 ? a.lam[0] : 0.f;
    if (hi == 0) { wsf[r32] = 1.f / l_reg[0]; if (MODE == 0) wsf[32 + r32] = lam / l_reg[NMAP - 1]; }
    asm volatile("s_waitcnt lgkmcnt(0)" ::: "memory");
    const size_t obase = ((size_t)b * SEQ + qtok) * DM + (MODE == 0 ? 0 : 1024) + h * 128 + r32;
    float sg[4];
#pragma unroll
    for (int d = 0; d < 4; ++d) sg[d] = MODE == 0 ? a.subln_g[d * 32 + r32] * 0.8f : 1.f;
#pragma unroll
    for (int r = 0; r < 16; ++r) {
        const int cr = crow(r, hi);
        const float ra = wsf[cr];
        float v[4];
        if (MODE == 0) {
            const float rb = wsf[32 + cr];
            float ss = 0.f;
#pragma unroll
            for (int d = 0; d < 4; ++d) { v[d] = o[0][d][r] * ra - o[NMAP - 1][d][r] * rb; ss += v[d] * v[d]; }
            ss += __shfl_xor(ss, 1); ss += __shfl_xor(ss, 2); ss += __shfl_xor(ss, 4); ss += __shfl_xor(ss, 8); ss += __shfl_xor(ss, 16);
            const float rstd = rsqrtf(ss * (1.f / 128.f) + 1e-5f);
#pragma unroll
            for (int d = 0; d < 4; ++d) v[d] *= rstd * sg[d];
        } else {
#pragma unroll
            for (int d = 0; d < 4; ++d) v[d] = o[0][d][r] * ra;
        }
        const size_t ro = obase + (size_t)cr * DM;
#pragma unroll
        for (int d = 0; d < 4; ++d) { const float gg = bf2f(a.G[ro + d * 32]); a.MIX[ro + d * 32] = (bf16_t)(cvtpk(v[d] * gg, 0.f) & 0xffffu); }
    }
}

struct Params {
    const float *x, *c, *ctx, *c_ctx, *norm_g, *w_mod, *b_mod, *w_in, *w_out, *lq1, *lk1, *lq2, *lk2, *subln_g, *rpb, *final_g;
    float* out; unsigned char* ws;
};

__device__ __forceinline__ void transpose_item(const float* W, int K, int N, bf16_t* WT, LAS float* scr, int item, int lane, int perm_below) {
    const int nblk = N / 32, kb = item / nblk, nb = item % nblk, k0 = 64 * kb, n0 = 32 * nb;
#pragma unroll 8
    for (int i = 0; i < 32; ++i) { const int kk = 2 * i + (lane >> 5); scr[kk * 33 + (lane & 31)] = W[(size_t)(k0 + kk) * N + n0 + (lane & 31)]; }
    asm volatile("s_waitcnt lgkmcnt(0)" ::: "memory");
    const int c = lane & 7; const bool pr = n0 < perm_below;
#pragma unroll
    for (int j = 0; j < 4; ++j) { const int n = (lane >> 3) + 8 * j; const int ns = pr ? pg8::perm32inv(n) : n; const LAS float* s = scr + (8 * c) * 33 + ns;
        u32x4 o; o.x = cvtpk(s[0 * 33], s[1 * 33]); o.y = cvtpk(s[2 * 33], s[3 * 33]); o.z = cvtpk(s[4 * 33], s[5 * 33]); o.w = cvtpk(s[6 * 33], s[7 * 33]);
        *(u32x4*)(WT + (size_t)(n0 + n) * K + k0 + 8 * c) = o; }
    asm volatile("s_waitcnt lgkmcnt(0)" ::: "memory");
}

__global__ void __launch_bounds__(512, 2) fwd_megakernel(Params p) {
    extern __shared__ __attribute__((aligned(16))) unsigned char lds[];
    cg::grid_group grid = cg::this_grid();
    const int tid = threadIdx.x, lane = tid & 63, wid = __builtin_amdgcn_readfirstlane(tid >> 6);
    const int bid = blockIdx.x, G = gridDim.x;
#define WSPTRS() unsigned char* ws = p.ws; asm volatile("" : "+s"(ws)); \
    float* mod = (float*)(ws + WS_MOD); float* lamp = (float*)(ws + WS_LAM); float* rope = (float*)(ws + WS_ROPE); \
    bf16_t* WinT = (bf16_t*)(ws + WS_WIN); bf16_t* WoutT = (bf16_t*)(ws + WS_WOUT); bf16_t* HX = (bf16_t*)(ws + WS_HX); \
    bf16_t* QA = (bf16_t*)(ws + WS_QA); bf16_t* KA = (bf16_t*)(ws + WS_KA); bf16_t* VA = (bf16_t*)(ws + WS_VA); \
    bf16_t* QB = (bf16_t*)(ws + WS_QB); bf16_t* KB = (bf16_t*)(ws + WS_KB); bf16_t* VB = (bf16_t*)(ws + WS_VB); \
    bf16_t* GB = (bf16_t*)(ws + WS_G); bf16_t* MIX = (bf16_t*)(ws + WS_MIX); \
    (void)mod; (void)lamp; (void)rope; (void)WinT; (void)WoutT; (void)HX; (void)QA; (void)KA; (void)VA; (void)QB; (void)KB; (void)VB; (void)GB; (void)MIX;
    { WSPTRS();
    if (bid < 192) {
        const int cgp = bid % 12, kc = bid / 12;
        float* sl = (float*)lds;
        for (int i = tid; i < 640; i += 512) { const int bb = i >> 7, k = kc * 128 + (i & 127); const float v = bb < 4 ? p.c[bb * DM + k] : p.c_ctx[k]; sl[i] = v / (1.f + expf(-v)); }
        __syncthreads();
        const int col = cgp * 512 + tid;
        float a0 = 0.f, a1 = 0.f, a2 = 0.f, a3 = 0.f, a4 = 0.f;
        const float* wp = p.w_mod + (size_t)(kc * 128) * 6144 + col;
#pragma unroll 8
        for (int k = 0; k < 128; ++k) { const float w = wp[(size_t)k * 6144]; a0 += sl[k] * w; a1 += sl[128 + k] * w; a2 += sl[256 + k] * w; a3 += sl[384 + k] * w; a4 += sl[512 + k] * w; }
        if (kc == 0) { const float bm = p.b_mod[col]; a0 += bm; a1 += bm; a2 += bm; a3 += bm; a4 += bm; }
        atomicAdd(mod + col, a0); atomicAdd(mod + 6144 + col, a1); atomicAdd(mod + 2 * 6144 + col, a2); atomicAdd(mod + 3 * 6144 + col, a3); atomicAdd(mod + 4 * 6144 + col, a4);
        __syncthreads();
    } else if (bid < 196) {
        const int idx = (bid - 192) * 512 + tid, pos = idx >> 4, i = idx & 15;
        const float inv = powf(10000.f, -(float)i / 16.f), ang = (float)pos * inv;
        rope[2 * idx] = cosf(ang); rope[2 * idx + 1] = sinf(ang);
    } else if (bid == 196 && wid == 0) {
        const float d1 = wave_sum(p.lq1[lane] * p.lk1[lane]), d2 = wave_sum(p.lq2[lane] * p.lk2[lane]);
        if (lane == 0) lamp[0] = expf(d1) - expf(d2) + 0.2f;
    }
    {
        LAS float* scr = (LAS float*)((LAS unsigned char*)lds + wid * 16384);
        const int gw = bid * 8 + wid, NGW = G * 8;
        constexpr int I_IN = (DM / 64) * (INC / 32), I_OUT = (DM / 64) * (DM / 32);
        for (int it = gw; it < I_IN + I_OUT; it += NGW) {
            if (it < I_IN) transpose_item(p.w_in, DM, INC, WinT, scr, it, lane, 2048);
            else transpose_item(p.w_out, DM, DM, WoutT, scr, it - I_IN, lane, 0);
        }
    }
    }
    grid.sync();

    { WSPTRS();
        const int gw = bid * 8 + wid, NGW = G * 8;
        for (int R = gw; R < NTOK + NCTX; R += NGW) {
            const float* src = R < NTOK ? p.x + (size_t)R * DM : p.ctx + (size_t)(R - NTOK) * DM;
            const float* mr = mod + (R < NTOK ? (R >> 13) : 4) * 6144;
            f32x4 v[8]; float ss = 0.f;
#pragma unroll
            for (int j = 0; j < 8; ++j) { v[j] = *(const f32x4*)(src + j * 256 + lane * 4); ss += (v[j].x * v[j].x + v[j].y * v[j].y) + (v[j].z * v[j].z + v[j].w * v[j].w); }
            const float rstd = rsqrtf(wave_sum(ss) * (1.f / DM) + 1e-6f);
            bf16_t* orow = HX + (size_t)R * DM;
#pragma unroll
            for (int j = 0; j < 8; ++j) { const int k = j * 256 + lane * 4;
                const f32x4 g4 = *(const f32x4*)(p.norm_g + k), sh = *(const f32x4*)(mr + k), sc4 = *(const f32x4*)(mr + 2048 + k);
                const f32x4 y = v[j] * rstd * g4 * (sc4 + 1.f) + sh;
                uint2 w; w.x = cvtpk(y.x, y.y); w.y = cvtpk(y.z, y.w); *(uint2*)(orow + k) = w; }
        }
    }
    grid.sync();

    { WSPTRS();
        pg8::Gemm g{HX, WinT, DM}; pg8::Order S; S.init(NTOK / 256, INC / 256, G, bid, 64);
        EpiIn E{QA, KA, VA, QB, KB, VB, GB, rope};
        pg8::gemm_phase<EpiIn>((LAS unsigned char*)lds, g, S, E);
    }
    grid.sync();

    { WSPTRS();
        AttnP ap{QA, KA, VA, QB, KB, VB, GB, MIX, p.subln_g, p.rpb, lamp};
        for (int L = bid; L < 1024; L += G) { const int xcd = L & 7, rest = L >> 3, blk = rest & 31, bh = xcd + 8 * (rest >> 5); attn_item<0>(ap, bh >> 3, bh & 7, blk, (char*)lds); }
    }
    { WSPTRS();
        AttnP ap{QA, KA, VA, QB, KB, VB, GB, MIX, p.subln_g, p.rpb, lamp};
        for (int L = bid; L < 1024; L += G) { const int xcd = L & 7, rest = L >> 3, blk = rest & 31, bh = xcd + 8 * (rest >> 5); attn_item<1>(ap, bh >> 3, bh & 7, blk, (char*)lds); }
    }
    grid.sync();

    { WSPTRS();
        pg8::Gemm g{MIX, WoutT, DM}; pg8::Order S; S.init(NTOK / 256, DM / 256, G, bid, 0);
        EpiOut E{p.x, mod, p.out};
        pg8::gemm_phase<EpiOut>((LAS unsigned char*)lds, g, S, E);
    }
    grid.sync();

    {
        const int gw = bid * 8 + wid, NGW = G * 8;
        for (int R = gw; R < NTOK; R += NGW) {
            float* row = p.out + (size_t)R * DM;
            f32x4 v[8]; float ss = 0.f;
#pragma unroll
            for (int j = 0; j < 8; ++j) { v[j] = *(const f32x4*)(row + j * 256 + lane * 4); ss += (v[j].x * v[j].x + v[j].y * v[j].y) + (v[j].z * v[j].z + v[j].w * v[j].w); }
            const float rstd = rsqrtf(wave_sum(ss) * (1.f / DM) + 1e-6f);
#pragma unroll
            for (int j = 0; j < 8; ++j) { const int k = j * 256 + lane * 4; const f32x4 g4 = *(const f32x4*)(p.final_g + k); *(f32x4*)(row + k) = v[j] * rstd * g4; }
        }
    }
}

extern "C" void kernel_launch(void* const* d_in, const int* in_sizes, int n_in, void* d_out, int out_size, void* d_ws, size_t ws_size, hipStream_t stream) {
    static int grid_blocks = 0;
    if (grid_blocks == 0) {
        if (n_in != 16 || in_sizes[0] != NTOK * DM || out_size != NTOK * DM || ws_size < WS_END) {
            fprintf(stderr, "kernel_launch: shape mismatch (n_in %d in0 %d out %d ws %zu)\n", n_in, n_in > 0 ? in_sizes[0] : -1, out_size, ws_size); grid_blocks = -1; return; }
        int dev = 0, cus = 0, per_cu = 0;
        hipGetDevice(&dev);
        hipDeviceGetAttribute(&cus, hipDeviceAttributeMultiprocessorCount, dev);
        if (hipFuncSetAttribute((const void*)fwd_megakernel, hipFuncAttributeMaxDynamicSharedMemorySize, LDS_BYTES) != hipSuccess) { fprintf(stderr, "kernel_launch: hipFuncSetAttribute failed\n"); grid_blocks = -1; return; }
        hipOccupancyMaxActiveBlocksPerMultiprocessor(&per_cu, (const void*)fwd_megakernel, 512, LDS_BYTES);
        if (per_cu < 1) { fprintf(stderr, "kernel_launch: occupancy query returned %d\n", per_cu); per_cu = 1; }
        (void)hipGetLastError();
        grid_blocks = cus;
    }
    if (grid_blocks < 0) return;
    hipMemsetAsync((char*)d_ws + WS_MOD, 0, 128 * 1024, stream);
    Params p{};
    p.x = (const float*)d_in[0]; p.c = (const float*)d_in[1]; p.ctx = (const float*)d_in[2]; p.c_ctx = (const float*)d_in[3]; p.norm_g = (const float*)d_in[4];
    p.w_mod = (const float*)d_in[5]; p.b_mod = (const float*)d_in[6]; p.w_in = (const float*)d_in[7]; p.w_out = (const float*)d_in[8];
    p.lq1 = (const float*)d_in[9]; p.lk1 = (const float*)d_in[10]; p.lq2 = (const float*)d_in[11]; p.lk2 = (const float*)d_in[12];
    p.subln_g = (const float*)d_in[13]; p.rpb = (const float*)d_in[14]; p.final_g = (const float*)d_in[15];
    p.out = (float*)d_out; p.ws = (unsigned char*)d_ws;
    void* args[] = {&p};
    hipError_t e = hipLaunchCooperativeKernel((const void*)fwd_megakernel, dim3(grid_blocks), dim3(512), args, LDS_BYTES, stream);
    if (e != hipSuccess) fprintf(stderr, "cooperative launch failed: %s (grid %d)\n", hipGetErrorString(e), grid_blocks);
}
```

```cpp
#include <hip/hip_runtime.h>
#include <hip/hip_cooperative_groups.h>
#include <cstdio>
#include <cstdint>
namespace cg = cooperative_groups;

#define LAS __attribute__((address_space(3)))
typedef unsigned short bf16_t;
typedef short bf16x8 __attribute__((ext_vector_type(8)));
typedef short s16x4 __attribute__((ext_vector_type(4)));
typedef float f32x4 __attribute__((ext_vector_type(4)));
typedef float f32x16 __attribute__((ext_vector_type(16)));
typedef unsigned u32x4 __attribute__((ext_vector_type(4)));

constexpr int DM = 2048, NB = 4, SEQ = 8192, CTX = 256, NTOK = NB * SEQ, NCTX = NB * CTX, INC = 8192, SKV = SEQ + CTX;
constexpr float LOG2E = 1.4426950408889634f;
constexpr float C2A = 0.125f * LOG2E;
constexpr float C2B = 0.08838834764831845f * LOG2E;
constexpr size_t MiB = 1u << 20;
constexpr size_t WS_MOD = 0, WS_LAM = 128 * 1024, WS_ROPE = 192 * 1024, WS_WIN = 1 * MiB, WS_WOUT = 33 * MiB, WS_HX = 48 * MiB;
constexpr size_t WS_QA = 192 * MiB, WS_KA = 256 * MiB, WS_VA = 328 * MiB, WS_QB = 400 * MiB, WS_KB = 464 * MiB, WS_VB = 536 * MiB;
constexpr size_t WS_G = 608 * MiB, WS_MIX = 736 * MiB, WS_END = 864 * MiB;
constexpr int LDS_BYTES = 135168;

__device__ __forceinline__ unsigned cvtpk(float lo, float hi) { unsigned r; asm volatile("v_cvt_pk_bf16_f32 %0, %1, %2" : "=v"(r) : "v"(lo), "v"(hi)); return r; }
__device__ __forceinline__ float bf2f(bf16_t v) { return __uint_as_float((unsigned)v << 16); }
__device__ __forceinline__ float silu_f(float v) { return v * __builtin_amdgcn_rcpf(1.f + __builtin_amdgcn_exp2f(-v * LOG2E)); }
__device__ __forceinline__ float wave_sum(float v) {
#pragma unroll
    for (int o = 1; o < 64; o <<= 1) v += __shfl_xor(v, o);
    return v;
}

namespace pg8 {
constexpr int BM = 256, BK = 64, HALF = 128, HTB = HALF * BK * 2, NXCD = 8, WGM = 8;
__host__ __device__ __forceinline__ int lds_byte(int r, int c) { const int st = (r >> 4) * 2 + (c >> 5), rr = r & 15, cc = c & 31, ob = rr * 64 + cc * 2; return st * 1024 + (ob ^ (((ob >> 9) & 1) << 5)); }
__host__ __device__ __forceinline__ void stage_rc(int b, int& R, int& C) { const int st = b / 1024, sb = b % 1024, swz = sb ^ (((sb >> 9) & 1) << 5); R = (st >> 1) * 16 + swz / 64; C = (st & 1) * 32 + (swz % 64) / 2; }
__host__ __device__ __forceinline__ int perm32(int rho) { const int n = rho >> 4, i = rho & 15; return 8 * (i >> 2) + 4 * n + (i & 3); }
__host__ __device__ __forceinline__ int perm32inv(int q) { return 16 * ((q >> 2) & 1) + 4 * (q >> 3) + (q & 3); }
struct Unit { int pm, pn; };
struct Gemm { const bf16_t* A; const bf16_t* Bt; int K; };

struct Order {
    int nM, nN, nwg, G, c, nX;
    __device__ void init(int nM_, int nN_, int G_, int c_, int nX_) { nM = nM_; nN = nN_; nwg = nM * nN; G = G_; c = c_; nX = nX_; }
    __device__ bool next(int i, Unit& u) const {
        const int L = i * G + c; if (L >= nwg + nX) return false;
        if (L >= nwg) { const int e = L - nwg; u.pm = nM + (e >> 4); const int q = e & 15; u.pn = q < 8 ? 4 + q : 12 + q; return true; }
        int wgid = L; { const int q = nwg / NXCD, r = nwg % NXCD, xcd = wgid % NXCD, off = wgid / NXCD; wgid = (xcd < r ? xcd * (q + 1) : r * (q + 1) + (xcd - r) * q) + off; }
        const int nig = WGM * nN, gid = wgid / nig, fm = gid * WGM, gsz = (nM - fm) < WGM ? (nM - fm) : WGM;
        u.pm = fm + ((wgid % nig) % gsz); u.pn = (wgid % nig) / gsz; return true;
    }
};

template <class Epi>
__device__ __forceinline__ void gemm_phase(LAS unsigned char* lds, const Gemm g, const Order& S, const Epi& E) {
    int tid = threadIdx.x; asm volatile("" : "+v"(tid));
    const int wid = __builtin_amdgcn_readfirstlane(tid >> 6), lane = tid & 63, wr = wid >> 2, wc = wid & 3, fr = lane & 15, fq = lane >> 4;
    const int K = g.K, nt = K / BK;
    unsigned voffA[2], voffB[2];
#pragma unroll
    for (int i = 0; i < 2; ++i) { int R, C; stage_rc(tid * 16 + i * 8192, R, C); const int Rb = (R & ~31) + perm32(R & 31);
        voffA[i] = (unsigned)(R * K + C) * 2u; voffB[i] = (unsigned)(Rb * K + C) * 2u; }
    const size_t kstep = (size_t)(BK * 2);
    const size_t hstep = (size_t)HALF * K * 2;
    const size_t tstep = 2 * hstep;
    const unsigned ldsw = (unsigned)wid * 1024u;
    const int aoff = lds_byte(wr * 64 + fr, fq * 8), boff = lds_byte(wc * 32 + fr, fq * 8);
#define PG8_SA(b, h) (((b) * 2 + (h)) * HTB)
#define PG8_SB(b, h) ((4 + (b) * 2 + (h)) * HTB)
#define PG8_STAGE(bufoff, gbase, voff) do { _Pragma("unroll") for (int _i = 0; _i < 2; ++_i) \
        __builtin_amdgcn_global_load_lds((const unsigned*)((const char*)(gbase) + (voff)[_i]), (LAS unsigned*)(lds + (bufoff) + ldsw + _i * 8192), 16, 0, 0); } while (0)
#define PG8_LDA(dst, b, h) do { _Pragma("unroll") for (int m = 0; m < 4; ++m) _Pragma("unroll") for (int k = 0; k < 2; ++k) dst[m][k] = *(const LAS bf16x8*)(lds + PG8_SA(b, h) + aoff + m * 2048 + k * 1024); } while (0)
#define PG8_LDB(dst, b, h) do { _Pragma("unroll") for (int n = 0; n < 2; ++n) _Pragma("unroll") for (int k = 0; k < 2; ++k) dst[n][k] = *(const LAS bf16x8*)(lds + PG8_SB(b, h) + boff + n * 2048 + k * 1024); } while (0)
#define PG8_MMA(ai, bj, At, Bt) do { __builtin_amdgcn_s_setprio(1); _Pragma("unroll") for (int m = 0; m < 4; ++m) _Pragma("unroll") for (int n = 0; n < 2; ++n) _Pragma("unroll") for (int k = 0; k < 2; ++k) \
        acc[ai][bj][m][n] = __builtin_amdgcn_mfma_f32_16x16x32_bf16(Bt[n][k], At[m][k], acc[ai][bj][m][n], 0, 0, 0); __builtin_amdgcn_s_setprio(0); } while (0)
#define PG8_WAIT_V(n) asm volatile("s_waitcnt vmcnt(" #n ")" ::: "memory")
#define PG8_WAIT_L(n) asm volatile("s_waitcnt lgkmcnt(" #n ")" ::: "memory")
#define PG8_BAR __builtin_amdgcn_s_barrier()
#define PG8_SCHED __builtin_amdgcn_sched_barrier(0)
    Unit cur, nxt; int ui = 0;
    if (!S.next(0, cur)) return;
    f32x4 acc[2][2][4][2];
#pragma unroll
    for (int a = 0; a < 2; ++a)
#pragma unroll
        for (int b = 0; b < 2; ++b)
#pragma unroll
            for (int m = 0; m < 4; ++m)
#pragma unroll
                for (int n = 0; n < 2; ++n) acc[a][b][m][n] = (f32x4){0.f, 0.f, 0.f, 0.f};
    bf16x8 At[4][2], B0[2][2], B1[2][2];
    const char* cA = (const char*)g.A + (size_t)cur.pm * tstep; const char* cB = (const char*)g.Bt + (size_t)cur.pn * tstep;
    PG8_STAGE(PG8_SB(0, 0), cB, voffB); PG8_STAGE(PG8_SB(0, 1), cB + hstep, voffB); PG8_STAGE(PG8_SA(0, 0), cA, voffA); PG8_STAGE(PG8_SA(0, 1), cA + hstep, voffA);
    if (wr == 1) PG8_BAR;
    PG8_WAIT_V(2); PG8_BAR;
    PG8_STAGE(PG8_SB(1, 0), cB + kstep, voffB); PG8_STAGE(PG8_SA(1, 0), cA + kstep, voffA); PG8_STAGE(PG8_SB(1, 1), cB + hstep + kstep, voffB);
    PG8_WAIT_V(6); PG8_BAR;
    for (;;) {
        const bool has_next = S.next(ui + 1, nxt);
        const char* nA = has_next ? (const char*)g.A + (size_t)nxt.pm * tstep : cA; const char* nB = has_next ? (const char*)g.Bt + (size_t)nxt.pn * tstep : cB;
        for (int t = 0; t < nt; t += 2) {
            const bool last = (t == nt - 2);
            const char* a1 = cA + (size_t)(t + 1) * kstep;
            const char* a2 = last ? nA : cA + (size_t)(t + 2) * kstep; const char* b2 = last ? nB : cB + (size_t)(t + 2) * kstep;
            const char* a3 = a2 + kstep; const char* b3 = b2 + kstep;
            PG8_LDB(B0, 0, 0); PG8_LDB(B1, 0, 1); PG8_SCHED; PG8_LDA(At, 0, 0); PG8_STAGE(PG8_SA(1, 1), a1 + hstep, voffA);
            PG8_WAIT_V(8); PG8_WAIT_L(0); PG8_BAR; PG8_MMA(0, 0, At, B0); PG8_MMA(0, 1, At, B1); PG8_BAR; PG8_SCHED;
            PG8_LDA(At, 0, 1); PG8_STAGE(PG8_SB(0, 0), b2, voffB); PG8_STAGE(PG8_SB(0, 1), b2 + hstep, voffB); PG8_STAGE(PG8_SA(0, 0), a2, voffA);
            PG8_WAIT_V(8); PG8_WAIT_L(0); PG8_BAR; PG8_MMA(1, 0, At, B0); PG8_MMA(1, 1, At, B1); PG8_BAR; PG8_SCHED;
            PG8_LDB(B0, 1, 0); PG8_LDB(B1, 1, 1); PG8_SCHED; PG8_LDA(At, 1, 0); PG8_STAGE(PG8_SA(0, 1), a2 + hstep, voffA);
            PG8_WAIT_V(8); PG8_WAIT_L(0); PG8_BAR; PG8_MMA(0, 0, At, B0); PG8_MMA(0, 1, At, B1); PG8_BAR; PG8_SCHED;
            PG8_LDA(At, 1, 1); PG8_STAGE(PG8_SB(1, 0), b3, voffB); PG8_STAGE(PG8_SB(1, 1), b3 + hstep, voffB); PG8_STAGE(PG8_SA(1, 0), a3, voffA);
            PG8_WAIT_V(8); PG8_WAIT_L(0); PG8_BAR; PG8_MMA(1, 0, At, B0); PG8_MMA(1, 1, At, B1); PG8_BAR; PG8_SCHED;
        }
        if (wr == 0) PG8_BAR;
        E(acc, cur, wr, wc, fr, fq);
        if (!has_next) break;
#pragma unroll
        for (int a = 0; a < 2; ++a)
#pragma unroll
            for (int b = 0; b < 2; ++b)
#pragma unroll
                for (int m = 0; m < 4; ++m)
#pragma unroll
                    for (int n = 0; n < 2; ++n) acc[a][b][m][n] = (f32x4){0.f, 0.f, 0.f, 0.f};
        cur = nxt; cA = nA; cB = nB; ++ui;
        if (wr == 1) PG8_BAR;
    }
    PG8_WAIT_V(0);
    PG8_BAR;
#undef PG8_SA
#undef PG8_SB
#undef PG8_STAGE
#undef PG8_LDA
#undef PG8_LDB
#undef PG8_MMA
#undef PG8_WAIT_V
#undef PG8_WAIT_L
#undef PG8_BAR
#undef PG8_SCHED
}
}

struct EpiIn {
    static constexpr bool PERM = true;
    bf16_t *QA, *KA, *VA, *QB, *KB, *VB, *G; const float* rope;
    __device__ __forceinline__ void operator()(const f32x4 (&acc)[2][2][4][2], const pg8::Unit& u, int wr, int wc, int fr, int fq) const {
        const int type = u.pn >> 2, hb = (u.pn & 3) * 2;
        const bool isctx = u.pm >= 128;
        const int b = isctx ? u.pm - 128 : (u.pm >> 5);
        const int sbase = (isctx ? SEQ : (u.pm & 31) * 256) + wr * 64 + fr;
        const int dcol = wc * 32 + 8 * fq;
        if (type == 3 || type == 7) {
            bf16_t* gp = G + ((size_t)b * SEQ + sbase) * DM + (type == 7 ? 1024 : 0) + hb * 128 + dcol;
#pragma unroll
            for (int ai = 0; ai < 2; ++ai)
#pragma unroll
                for (int m = 0; m < 4; ++m)
#pragma unroll
                    for (int bj = 0; bj < 2; ++bj) {
                        const f32x4 v0 = acc[ai][bj][m][0], v1 = acc[ai][bj][m][1];
                        u32x4 w; w.x = cvtpk(silu_f(v0[0]), silu_f(v0[1])); w.y = cvtpk(silu_f(v0[2]), silu_f(v0[3]));
                        w.z = cvtpk(silu_f(v1[0]), silu_f(v1[1])); w.w = cvtpk(silu_f(v1[2]), silu_f(v1[3]));
                        *(u32x4*)(gp + (size_t)(ai * 128 + m * 16) * DM + bj * 128) = w;
                    }
            return;
        }
        bf16_t* base; int SK; float sc = 1.f;
        switch (type) {
            case 0: base = QA; SK = SEQ; sc = C2A; break;
            case 1: base = KA; SK = SKV; break;
            case 2: base = VA; SK = SKV; break;
            case 4: base = QB; SK = SEQ; sc = C2B; break;
            case 5: base = KB; SK = SKV; break;
            default: base = VB; SK = SKV; break;
        }
        const bool dorope = (type <= 1) && !isctx;
        bf16_t* op = base + ((size_t)(b * 8 + hb) * SK + sbase) * 128 + dcol;
        const size_t hstride = (size_t)SK * 128;
#pragma unroll
        for (int ai = 0; ai < 2; ++ai)
#pragma unroll
            for (int m = 0; m < 4; ++m) {
                f32x4 cs0 = {1.f, 0.f, 1.f, 0.f}, cs1 = {1.f, 0.f, 1.f, 0.f};
                if (dorope) { const int s = sbase + ai * 128 + m * 16; const int pos = (wc & 1) ? (s & 63) : (s >> 6);
                    const f32x4* rp = (const f32x4*)(rope + (size_t)(pos * 16 + 4 * fq) * 2); cs0 = rp[0]; cs1 = rp[1]; }
#pragma unroll
                for (int bj = 0; bj < 2; ++bj) {
                    const f32x4 x1 = acc[ai][bj][m][0], x2 = acc[ai][bj][m][1];
                    f32x4 y1, y2;
                    y1[0] = x1[0] * cs0[0] - x2[0] * cs0[1]; y2[0] = x2[0] * cs0[0] + x1[0] * cs0[1];
                    y1[1] = x1[1] * cs0[2] - x2[1] * cs0[3]; y2[1] = x2[1] * cs0[2] + x1[1] * cs0[3];
                    y1[2] = x1[2] * cs1[0] - x2[2] * cs1[1]; y2[2] = x2[2] * cs1[0] + x1[2] * cs1[1];
                    y1[3] = x1[3] * cs1[2] - x2[3] * cs1[3]; y2[3] = x2[3] * cs1[2] + x1[3] * cs1[3];
                    y1 = y1 * sc; y2 = y2 * sc;
                    u32x4 w; w.x = cvtpk(y1[0], y1[1]); w.y = cvtpk(y1[2], y1[3]); w.z = cvtpk(y2[0], y2[1]); w.w = cvtpk(y2[2], y2[3]);
                    *(u32x4*)(op + (size_t)(ai * 128 + m * 16) * 128 + bj * hstride) = w;
                }
            }
    }
};
struct EpiOut {
    static constexpr bool PERM = true;
    const float* x; const float* mod; float* out;
    __device__ __forceinline__ void operator()(const f32x4 (&acc)[2][2][4][2], const pg8::Unit& u, int wr, int wc, int fr, int fq) const {
        const int row0 = u.pm * 256 + wr * 64 + fr, b = u.pm >> 5, col0 = u.pn * 256 + wc * 32 + 8 * fq;
        f32x4 gv[2][2];
#pragma unroll
        for (int bj = 0; bj < 2; ++bj)
#pragma unroll
            for (int n = 0; n < 2; ++n) gv[bj][n] = *(const f32x4*)(mod + b * 6144 + 4096 + col0 + bj * 128 + 4 * n);
#pragma unroll
        for (int ai = 0; ai < 2; ++ai)
#pragma unroll
            for (int m = 0; m < 4; ++m) {
                const size_t ro = (size_t)(row0 + ai * 128 + m * 16) * DM + col0;
#pragma unroll
                for (int bj = 0; bj < 2; ++bj) {
                    const f32x4 x0 = *(const f32x4*)(x + ro + bj * 128), x1 = *(const f32x4*)(x + ro + bj * 128 + 4);
                    *(f32x4*)(out + ro + bj * 128) = x0 + gv[bj][0] * acc[ai][bj][m][0];
                    *(f32x4*)(out + ro + bj * 128 + 4) = x1 + gv[bj][1] * acc[ai][bj][m][1];
                }
            }
    }
};

#define KSWZ(row, colB) ((row) * 256 + ((colB) ^ (((row) & 7) << 4)))
#define SBAR() __builtin_amdgcn_sched_barrier(0)
__device__ __forceinline__ int crow(int r, int hi) { return (r & 3) + 8 * (r >> 2) + 4 * hi; }
__device__ __forceinline__ int v_st(int k, int c) { const int kk = (k & ~0xC) | ((k & 4) << 1) | ((k & 8) >> 1); return ((kk >> 3) * 4 + (c >> 5)) * 512 + ((kk & 7) * 32 + (c & 31)) * 2; }
__device__ __forceinline__ int v_rd_base(int lane) { return ((lane & 3) << 3) | (((lane >> 2) & 3) << 6) | (((lane >> 4) & 1) << 5) | (((lane >> 5) & 1) << 8); }
constexpr int v_rd_off(int d0, int ks, int half) { return d0 * 512 + ks * 4096 + half * 2048; }
template <int OFF> __device__ __forceinline__ s16x4 tr_read(int vb) {
    s16x4 r; asm volatile("ds_read_b64_tr_b16 %0, %1 offset:%2" : "=&v"(r) : "v"(vb), "i"(OFF) : "memory"); return r;
}
template <int D0> __device__ __forceinline__ void pv_one(f32x16& od, int vb, bf16x8 pa0, bf16x8 pa1, bf16x8 pa2, bf16x8 pa3) {
    const s16x4 l0 = tr_read<v_rd_off(D0, 0, 0)>(vb), h0 = tr_read<v_rd_off(D0, 0, 1)>(vb), l1 = tr_read<v_rd_off(D0, 1, 0)>(vb), h1 = tr_read<v_rd_off(D0, 1, 1)>(vb);
    const s16x4 l2 = tr_read<v_rd_off(D0, 2, 0)>(vb), h2 = tr_read<v_rd_off(D0, 2, 1)>(vb), l3 = tr_read<v_rd_off(D0, 3, 0)>(vb), h3 = tr_read<v_rd_off(D0, 3, 1)>(vb);
    asm volatile("s_waitcnt lgkmcnt(0)" ::: "memory"); SBAR();
#define PK(L, H) (bf16x8){L[0], L[1], L[2], L[3], H[0], H[1], H[2], H[3]}
    od = __builtin_amdgcn_mfma_f32_32x32x16_bf16(pa0, PK(l0, h0), od, 0, 0, 0);
    od = __builtin_amdgcn_mfma_f32_32x32x16_bf16(pa1, PK(l1, h1), od, 0, 0, 0);
    od = __builtin_amdgcn_mfma_f32_32x32x16_bf16(pa2, PK(l2, h2), od, 0, 0, 0);
    od = __builtin_amdgcn_mfma_f32_32x32x16_bf16(pa3, PK(l3, h3), od, 0, 0, 0);
#undef PK
}

template <int NMAP, int D0> __device__ __forceinline__ void pv_all(f32x16 (&o)[NMAP][4], int vb, const bf16x8 (&pa)[NMAP][4]) {
    const s16x4 l0 = tr_read<v_rd_off(D0, 0, 0)>(vb), h0 = tr_read<v_rd_off(D0, 0, 1)>(vb), l1 = tr_read<v_rd_off(D0, 1, 0)>(vb), h1 = tr_read<v_rd_off(D0, 1, 1)>(vb);
    const s16x4 l2 = tr_read<v_rd_off(D0, 2, 0)>(vb), h2 = tr_read<v_rd_off(D0, 2, 1)>(vb), l3 = tr_read<v_rd_off(D0, 3, 0)>(vb), h3 = tr_read<v_rd_off(D0, 3, 1)>(vb);
    asm volatile("s_waitcnt lgkmcnt(0)" ::: "memory"); SBAR();
#define PK(L, H) (bf16x8){L[0], L[1], L[2], L[3], H[0], H[1], H[2], H[3]}
    const bf16x8 v0 = PK(l0, h0), v1 = PK(l1, h1), v2 = PK(l2, h2), v3 = PK(l3, h3);
#undef PK
#pragma unroll
    for (int mp = 0; mp < NMAP; ++mp) {
        o[mp][D0] = __builtin_amdgcn_mfma_f32_32x32x16_bf16(pa[mp][0], v0, o[mp][D0], 0, 0, 0);
        o[mp][D0] = __builtin_amdgcn_mfma_f32_32x32x16_bf16(pa[mp][1], v1, o[mp][D0], 0, 0, 0);
        o[mp][D0] = __builtin_amdgcn_mfma_f32_32x32x16_bf16(pa[mp][2], v2, o[mp][D0], 0, 0, 0);
        o[mp][D0] = __builtin_amdgcn_mfma_f32_32x32x16_bf16(pa[mp][3], v3, o[mp][D0], 0, 0, 0);
    }
}

struct AttnP { const bf16_t *QA, *KA, *VA, *QB, *KB, *VB, *G; bf16_t* MIX; const float *subln_g, *rpb, *lam; };

template <int MODE, bool FAST>
__device__ __forceinline__ int attn_item(const AttnP& a, int b, int h, int blk, char* lds) {
    constexpr int NMAP = MODE == 0 ? 2 : 1, KD0 = MODE == 0 ? 4 : 8, NT = MODE == 0 ? SKV / 64 : 16;
    constexpr float THR = 8.f;
    int tid = threadIdx.x; asm volatile("" : "+v"(tid));
    const int wid = __builtin_amdgcn_readfirstlane(tid >> 6), lane = tid & 63, r32 = lane & 31, hi = lane >> 5;
    char* V_lds = lds; char* K_lds = lds + 32768;
    float* wsf = (float*)(lds + 65536) + wid * 64;
    float* rpbs = (float*)(lds + 65536 + 2048);
    char* Qw = lds + 69632 + wid * 8192;
    const size_t bh = (size_t)(b * 8 + h);
    const int qrow = 4 * blk + (wid >> 1), half = wid & 1;
    const int qtok = MODE == 0 ? blk * 256 + wid * 32 : qrow * 64 + half * 32;
    const int ulo = min(max(4 * blk - 4, 0), 116), r0w = min(max(qrow - 4, 0), 120);
    {
        const bf16_t* Qg = (MODE == 0 ? a.QA : a.QB) + (bh * SEQ + qtok) * 128;
#pragma unroll
        for (int i = 0; i < 8; ++i) { const int row = i * 4 + (lane >> 4), c16 = lane & 15;
            const bf16x8 qv = *(const bf16x8*)(Qg + (size_t)row * 128 + c16 * 8);
            *(bf16x8*)(Qw + KSWZ(row, c16 * 16)) = qv; }
    }
    const char* Kh = (const char*)((MODE == 0 ? a.KA : a.KB) + bh * SKV * 128);
    const char* Vh = (const char*)((MODE == 0 ? a.VA : a.VB) + bh * SKV * 128);
    unsigned voffK, voffV;
    {
        const int krow = 4 * wid + (lane >> 4), kch = (lane & 15) ^ (krow & 7);
        voffK = (unsigned)(krow * 256 + kch * 16);
        const int sub = 2 * wid + (lane >> 5), kk = (sub >> 2) * 8 + ((lane & 31) >> 2), cblk = sub & 3;
        const int kreal = (kk & ~0xC) | ((kk & 4) << 1) | ((kk & 8) >> 1);
        voffV = (unsigned)(kreal * 256 + (cblk * 32 + (lane & 3) * 8) * 2);
    }
    const int vb0 = (int)(uintptr_t)V_lds + v_rd_base(lane);
    int koff[4];
#pragma unroll
    for (int i = 0; i < 4; ++i) koff[i] = r32 * 256 + (((2 * i + hi) ^ (r32 & 7)) << 4);
    if (MODE == 1) { for (int i = tid; i < 465; i += 512) rpbs[i] = a.rpb[h * 465 + i] * LOG2E; }
    f32x16 o[NMAP][4]; float m_reg[NMAP], l_reg[NMAP];
#pragma unroll
    for (int mp = 0; mp < NMAP; ++mp) { m_reg[mp] = -1e30f; l_reg[mp] = 0.f;
#pragma unroll
        for (int d = 0; d < 4; ++d) o[mp][d] = f32x16{}; }
#define TROW(t) (MODE == 0 ? (t) * 64 : ((t) < 4 ? SEQ + (t) * 64 : (ulo + (t) - 4) * 64))
#define STAGE(t, bi) do { const size_t g0_ = (size_t)TROW(t) * 256; _Pragma("unroll") for (int ii_ = 0; ii_ < 2; ++ii_) { \
        __builtin_amdgcn_global_load_lds((const unsigned*)(Kh + g0_ + ii_ * 8192 + voffK), (LAS unsigned*)((LAS unsigned char*)K_lds + (bi) * 16384 + wid * 1024 + ii_ * 8192), 16, 0, 0); \
        __builtin_amdgcn_global_load_lds((const unsigned*)(Vh + g0_ + ii_ * 8192 + voffV), (LAS unsigned*)((LAS unsigned char*)V_lds + (bi) * 16384 + wid * 1024 + ii_ * 8192), 16, 0, 0); } } while (0)
    STAGE(0, 0);
    asm volatile("s_waitcnt vmcnt(0) lgkmcnt(0)" ::: "memory");
    __syncthreads();
#pragma nounroll
    for (int t = 0; t < NT; ++t) {
        const int cur = t & 1;
        if (t + 1 < NT) STAGE(t + 1, cur ^ 1);
        bool active = true; int br = 0;
        if (MODE == 1 && t >= 4) { br = ulo + t - 4; active = (br >= r0w) && (br <= r0w + 7); }
        if (active) {
            const char* Kc = K_lds + cur * 16384; const int vb = vb0 + cur * 16384;
            bf16x8 pa[NMAP][4];
#pragma unroll
            for (int mp = 0; mp < NMAP; ++mp) {
                SBAR();
                f32x16 p0 = f32x16{}, p1 = f32x16{};
#pragma unroll
                for (int d0 = 0; d0 < KD0; ++d0) { const int dd = (MODE == 0 ? mp * 4 : 0) + d0; const int off = koff[dd & 3] + (dd >> 2) * 128;
                    const bf16x8 k0 = *(const bf16x8*)(Kc + off); const bf16x8 k1 = *(const bf16x8*)(Kc + off + 8192);
                    const bf16x8 qf = *(const bf16x8*)(Qw + off);
                    p0 = __builtin_amdgcn_mfma_f32_32x32x16_bf16(k0, qf, p0, 0, 0, 0);
                    p1 = __builtin_amdgcn_mfma_f32_32x32x16_bf16(k1, qf, p1, 0, 0, 0);
                    if ((d0 & 1) == 1) SBAR(); }
                if (MODE == 1 && t >= 4) {
                    const int j = half * 32 + r32, c0 = min(max(j - 8, 0), 48);
                    const float* bp = rpbs + (br - qrow + 7) * 31 + 15 - j;
#pragma unroll
                    for (int r = 0; r < 16; ++r) { const int kc = crow(r, hi); const bool ok = (unsigned)(kc - c0) < 16u; const float bv = bp[ok ? kc : j];
                        p0[r] = ok ? p0[r] + bv : -1e30f; }
#pragma unroll
                    for (int r = 0; r < 16; ++r) { const int kc = 32 + crow(r, hi); const bool ok = (unsigned)(kc - c0) < 16u; const float bv = bp[ok ? kc : j];
                        p1[r] = ok ? p1[r] + bv : -1e30f; }
                }
                float alpha = 1.f;
                if (FAST) {
                    float psa = 0.f, psb = 0.f;
#pragma unroll
                    for (int r = 0; r < 16; ++r) { p0[r] = __builtin_amdgcn_exp2f(p0[r]); psa += p0[r]; }
#pragma unroll
                    for (int r = 0; r < 16; ++r) { p1[r] = __builtin_amdgcn_exp2f(p1[r]); psb += p1[r]; }
                    l_reg[mp] += psa + psb;
                } else {
                float pmax = p0[0];
#pragma unroll
                for (int r = 1; r < 16; ++r) pmax = fmaxf(pmax, p0[r]);
#pragma unroll
                for (int r = 0; r < 16; ++r) pmax = fmaxf(pmax, p1[r]);
                { auto rr = __builtin_amdgcn_permlane32_swap(__float_as_uint(pmax), __float_as_uint(pmax), false, false);
                  pmax = fmaxf(__uint_as_float(rr[0]), __uint_as_float(rr[1])); }
                float mn = m_reg[mp];
                if (!__all(pmax - m_reg[mp] <= THR)) { mn = fmaxf(m_reg[mp], pmax); alpha = __builtin_amdgcn_exp2f(m_reg[mp] - mn); m_reg[mp] = mn; }
                float ps = 0.f;
#pragma unroll
                for (int r = 0; r < 16; ++r) { p0[r] = __builtin_amdgcn_exp2f(p0[r] - mn); ps += p0[r]; }
#pragma unroll
                for (int r = 0; r < 16; ++r) { p1[r] = __builtin_amdgcn_exp2f(p1[r] - mn); ps += p1[r]; }
                { auto rr = __builtin_amdgcn_permlane32_swap(__float_as_uint(ps), __float_as_uint(ps), false, false);
                  ps = __uint_as_float(rr[0]) + __uint_as_float(rr[1]); }
                l_reg[mp] = l_reg[mp] * alpha + ps;
                }
#define PK4(P, BASE, OUT) do { unsigned a0 = cvtpk(P[BASE + 0], P[BASE + 1]), a1 = cvtpk(P[BASE + 2], P[BASE + 3]);   \
    unsigned b0 = cvtpk(P[BASE + 4], P[BASE + 5]), b1 = cvtpk(P[BASE + 6], P[BASE + 7]);                              \
    auto r0 = __builtin_amdgcn_permlane32_swap(a0, b0, false, false); auto r1 = __builtin_amdgcn_permlane32_swap(a1, b1, false, false); \
    u32x4 w = {r0[0], r1[0], r0[1], r1[1]}; OUT = *reinterpret_cast<bf16x8*>(&w); } while (0)
                PK4(p0, 0, pa[mp][0]); PK4(p0, 8, pa[mp][1]); PK4(p1, 0, pa[mp][2]); PK4(p1, 8, pa[mp][3]);
#undef PK4
                if (!FAST && __any(alpha < 1.f)) {
                    if (hi == 0) wsf[r32] = alpha;
                    asm volatile("s_waitcnt lgkmcnt(0)" ::: "memory");
#pragma unroll
                    for (int r = 0; r < 16; ++r) { const float al = wsf[crow(r, hi)];
#pragma unroll
                        for (int d = 0; d < 4; ++d) o[mp][d][r] *= al; }
                }
            }
            SBAR();
            pv_all<NMAP, 0>(o, vb, pa); pv_all<NMAP, 1>(o, vb, pa); pv_all<NMAP, 2>(o, vb, pa); pv_all<NMAP, 3>(o, vb, pa);
        }
        asm volatile("s_waitcnt vmcnt(0)" ::: "memory");
        __syncthreads();
    }
#undef TROW
#undef STAGE
    if (FAST) {
        bool bad = false;
#pragma unroll
        for (int mp = 0; mp < NMAP; ++mp) { auto rr = __builtin_amdgcn_permlane32_swap(__float_as_uint(l_reg[mp]), __float_as_uint(l_reg[mp]), false, false);
            l_reg[mp] = __uint_as_float(rr[0]) + __uint_as_float(rr[1]); bad = bad || !(l_reg[mp] <= 1.0e30f); }
        if (lane == 0) rpbs[wid] = __any(bad) ? 1.f : 0.f;
        __syncthreads();
        float anyb = 0.f;
#pragma unroll
        for (int w = 0; w < 8; ++w) anyb += rpbs[w];
        __syncthreads();
        if (anyb != 0.f) return 1;
    }
    const float lam = MODE == 0 ? a.lam[0] : 0.f;
    if (hi == 0) { wsf[r32] = 1.f / l_reg[0]; if (MODE == 0) wsf[32 + r32] = lam / l_reg[NMAP - 1]; }
    asm volatile("s_waitcnt lgkmcnt(0)" ::: "memory");
    const size_t obase = ((size_t)b * SEQ + qtok) * DM + (MODE == 0 ? 0 : 1024) + h * 128 + r32;
    float sg[4];
#pragma unroll
    for (int d = 0; d < 4; ++d) sg[d] = MODE == 0 ? a.subln_g[d * 32 + r32] * 0.8f : 1.f;
#pragma unroll
    for (int r = 0; r < 16; ++r) {
        const int cr = crow(r, hi);
        const float ra = wsf[cr];
        float v[4];
        if (MODE == 0) {
            const float rb = wsf[32 + cr];
            float ss = 0.f;
#pragma unroll
            for (int d = 0; d < 4; ++d) { v[d] = o[0][d][r] * ra - o[NMAP - 1][d][r] * rb; ss += v[d] * v[d]; }
            ss += __shfl_xor(ss, 1); ss += __shfl_xor(ss, 2); ss += __shfl_xor(ss, 4); ss += __shfl_xor(ss, 8); ss += __shfl_xor(ss, 16);
            const float rstd = rsqrtf(ss * (1.f / 128.f) + 1e-5f);
#pragma unroll
            for (int d = 0; d < 4; ++d) v[d] *= rstd * sg[d];
        } else {
#pragma unroll
            for (int d = 0; d < 4; ++d) v[d] = o[0][d][r] * ra;
        }
        const size_t ro = obase + (size_t)cr * DM;
#pragma unroll
        for (int d = 0; d < 4; ++d) { const float gg = bf2f(a.G[ro + d * 32]); a.MIX[ro + d * 32] = (bf16_t)(cvtpk(v[d] * gg, 0.f) & 0xffffu); }
    }
    return 0;
}

struct Params {
    const float *x, *c, *ctx, *c_ctx, *norm_g, *w_mod, *b_mod, *w_in, *w_out, *lq1, *lk1, *lq2, *lk2, *subln_g, *rpb, *final_g;
    float* out; unsigned char* ws;
};

__device__ __forceinline__ void transpose_item(const float* W, int K, int N, bf16_t* WT, LAS float* scr, int item, int lane, int perm_below) {
    const int nblk = N / 32, kb = item / nblk, nb = item % nblk, k0 = 64 * kb, n0 = 32 * nb;
#pragma unroll 8
    for (int i = 0; i < 32; ++i) { const int kk = 2 * i + (lane >> 5); scr[kk * 33 + (lane & 31)] = W[(size_t)(k0 + kk) * N + n0 + (lane & 31)]; }
    asm volatile("s_waitcnt lgkmcnt(0)" ::: "memory");
    const int c = lane & 7; const bool pr = n0 < perm_below;
#pragma unroll
    for (int j = 0; j < 4; ++j) { const int n = (lane >> 3) + 8 * j; const int ns = pr ? pg8::perm32inv(n) : n; const LAS float* s = scr + (8 * c) * 33 + ns;
        u32x4 o; o.x = cvtpk(s[0 * 33], s[1 * 33]); o.y = cvtpk(s[2 * 33], s[3 * 33]); o.z = cvtpk(s[4 * 33], s[5 * 33]); o.w = cvtpk(s[6 * 33], s[7 * 33]);
        *(u32x4*)(WT + (size_t)(n0 + n) * K + k0 + 8 * c) = o; }
    asm volatile("s_waitcnt lgkmcnt(0)" ::: "memory");
}

__global__ void __launch_bounds__(512, 2) fwd_megakernel(Params p) {
    extern __shared__ __attribute__((aligned(16))) unsigned char lds[];
    cg::grid_group grid = cg::this_grid();
    const int bid = blockIdx.x, G = gridDim.x;
#define TIDS() int tid = threadIdx.x; asm volatile("" : "+v"(tid)); const int lane = tid & 63, wid = __builtin_amdgcn_readfirstlane(tid >> 6); (void)lane; (void)wid;
#define WSPTRS() unsigned char* ws = p.ws; asm volatile("" : "+s"(ws)); \
    float* mod = (float*)(ws + WS_MOD); float* lamp = (float*)(ws + WS_LAM); float* rope = (float*)(ws + WS_ROPE); \
    bf16_t* WinT = (bf16_t*)(ws + WS_WIN); bf16_t* WoutT = (bf16_t*)(ws + WS_WOUT); bf16_t* HX = (bf16_t*)(ws + WS_HX); \
    bf16_t* QA = (bf16_t*)(ws + WS_QA); bf16_t* KA = (bf16_t*)(ws + WS_KA); bf16_t* VA = (bf16_t*)(ws + WS_VA); \
    bf16_t* QB = (bf16_t*)(ws + WS_QB); bf16_t* KB = (bf16_t*)(ws + WS_KB); bf16_t* VB = (bf16_t*)(ws + WS_VB); \
    bf16_t* GB = (bf16_t*)(ws + WS_G); bf16_t* MIX = (bf16_t*)(ws + WS_MIX); \
    (void)mod; (void)lamp; (void)rope; (void)WinT; (void)WoutT; (void)HX; (void)QA; (void)KA; (void)VA; (void)QB; (void)KB; (void)VB; (void)GB; (void)MIX;
    { WSPTRS(); TIDS();
    if (bid < 192) {
        const int cgp = bid % 12, kc = bid / 12;
        float* sl = (float*)lds;
        for (int i = tid; i < 640; i += 512) { const int bb = i >> 7, k = kc * 128 + (i & 127); const float v = bb < 4 ? p.c[bb * DM + k] : p.c_ctx[k]; sl[i] = v / (1.f + expf(-v)); }
        __syncthreads();
        const int col = cgp * 512 + tid;
        float a0 = 0.f, a1 = 0.f, a2 = 0.f, a3 = 0.f, a4 = 0.f;
        const float* wp = p.w_mod + (size_t)(kc * 128) * 6144 + col;
#pragma unroll 8
        for (int k = 0; k < 128; ++k) { const float w = wp[(size_t)k * 6144]; a0 += sl[k] * w; a1 += sl[128 + k] * w; a2 += sl[256 + k] * w; a3 += sl[384 + k] * w; a4 += sl[512 + k] * w; }
        if (kc == 0) { const float bm = p.b_mod[col]; a0 += bm; a1 += bm; a2 += bm; a3 += bm; a4 += bm; }
        atomicAdd(mod + col, a0); atomicAdd(mod + 6144 + col, a1); atomicAdd(mod + 2 * 6144 + col, a2); atomicAdd(mod + 3 * 6144 + col, a3); atomicAdd(mod + 4 * 6144 + col, a4);
        __syncthreads();
    } else if (bid < 196) {
        const int idx = (bid - 192) * 512 + tid, pos = idx >> 4, i = idx & 15;
        const float inv = powf(10000.f, -(float)i / 16.f), ang = (float)pos * inv;
        rope[2 * idx] = cosf(ang); rope[2 * idx + 1] = sinf(ang);
    } else if (bid == 196 && wid == 0) {
        const float d1 = wave_sum(p.lq1[lane] * p.lk1[lane]), d2 = wave_sum(p.lq2[lane] * p.lk2[lane]);
        if (lane == 0) lamp[0] = expf(d1) - expf(d2) + 0.2f;
    }
    {
        LAS float* scr = (LAS float*)((LAS unsigned char*)lds + wid * 16384);
        const int gw = bid * 8 + wid, NGW = G * 8;
        constexpr int I_IN = (DM / 64) * (INC / 32), I_OUT = (DM / 64) * (DM / 32);
        for (int it = gw; it < I_IN + I_OUT; it += NGW) {
            if (it < I_IN) transpose_item(p.w_in, DM, INC, WinT, scr, it, lane, 2048);
            else transpose_item(p.w_out, DM, DM, WoutT, scr, it - I_IN, lane, 0);
        }
    }
    }
    grid.sync();

    { WSPTRS(); TIDS();
        const int gw = bid * 8 + wid, NGW = G * 8;
        for (int R = gw; R < NTOK + NCTX; R += NGW) {
            const float* src = R < NTOK ? p.x + (size_t)R * DM : p.ctx + (size_t)(R - NTOK) * DM;
            const float* mr = mod + (R < NTOK ? (R >> 13) : 4) * 6144;
            f32x4 v[8]; float ss = 0.f;
#pragma unroll
            for (int j = 0; j < 8; ++j) { v[j] = *(const f32x4*)(src + j * 256 + lane * 4); ss += (v[j].x * v[j].x + v[j].y * v[j].y) + (v[j].z * v[j].z + v[j].w * v[j].w); }
            const float rstd = rsqrtf(wave_sum(ss) * (1.f / DM) + 1e-6f);
            bf16_t* orow = HX + (size_t)R * DM;
#pragma unroll
            for (int j = 0; j < 8; ++j) { const int k = j * 256 + lane * 4;
                const f32x4 g4 = *(const f32x4*)(p.norm_g + k), sh = *(const f32x4*)(mr + k), sc4 = *(const f32x4*)(mr + 2048 + k);
                const f32x4 y = v[j] * rstd * g4 * (sc4 + 1.f) + sh;
                uint2 w; w.x = cvtpk(y.x, y.y); w.y = cvtpk(y.z, y.w); *(uint2*)(orow + k) = w; }
        }
    }
    grid.sync();

    { WSPTRS();
        pg8::Gemm g{HX, WinT, DM}; pg8::Order S; S.init(NTOK / 256, INC / 256, G, bid, 64);
        EpiIn E{QA, KA, VA, QB, KB, VB, GB, rope};
        pg8::gemm_phase<EpiIn>((LAS unsigned char*)lds, g, S, E);
    }
    grid.sync();

    { WSPTRS();
        AttnP ap{QA, KA, VA, QB, KB, VB, GB, MIX, p.subln_g, p.rpb, lamp};
        unsigned badmask = 0u; int it = 0;
        for (int L = bid; L < 1024; L += G, ++it) { const int xcd = L & 7, rest = L >> 3, blk = rest & 31, bh = xcd + 8 * (rest >> 5);
            if (attn_item<0, true>(ap, bh >> 3, bh & 7, blk, (char*)lds)) badmask |= 1u << (it & 31); }
        badmask = __builtin_amdgcn_readfirstlane(badmask);
        if (badmask) { it = 0;
            for (int L = bid; L < 1024; L += G, ++it) { const int xcd = L & 7, rest = L >> 3, blk = rest & 31, bh = xcd + 8 * (rest >> 5);
                if ((badmask >> (it & 31)) & 1u) attn_item<0, false>(ap, bh >> 3, bh & 7, blk, (char*)lds); } }
    }
    { WSPTRS();
        AttnP ap{QA, KA, VA, QB, KB, VB, GB, MIX, p.subln_g, p.rpb, lamp};
        for (int L = bid; L < 1024; L += G) { const int xcd = L & 7, rest = L >> 3, blk = rest & 31, bh = xcd + 8 * (rest >> 5); attn_item<1, false>(ap, bh >> 3, bh & 7, blk, (char*)lds); }
    }
    grid.sync();

    { WSPTRS();
        pg8::Gemm g{MIX, WoutT, DM}; pg8::Order S; S.init(NTOK / 256, DM / 256, G, bid, 0);
        EpiOut E{p.x, mod, p.out};
        pg8::gemm_phase<EpiOut>((LAS unsigned char*)lds, g, S, E);
    }
    grid.sync();

    { TIDS();
        const int gw = bid * 8 + wid, NGW = G * 8;
        for (int R = gw; R < NTOK; R += NGW) {
            float* row = p.out + (size_t)R * DM;
            f32x4 v[8]; float ss = 0.f;
#pragma unroll
            for (int j = 0; j < 8; ++j) { v[j] = *(const f32x4*)(row + j * 256 + lane * 4); ss += (v[j].x * v[j].x + v[j].y * v[j].y) + (v[j].z * v[j].z + v[j].w * v[j].w); }
            const float rstd = rsqrtf(wave_sum(ss) * (1.f / DM) + 1e-6f);
#pragma unroll
            for (int j = 0; j < 8; ++j) { const int k = j * 256 + lane * 4; const f32x4 g4 = *(const f32x4*)(p.final_g + k); *(f32x4*)(row + k) = v[j] * rstd * g4; }
        }
    }
}

extern "C" void kernel_launch(void* const* d_in, const int* in_sizes, int n_in, void* d_out, int out_size, void* d_ws, size_t ws_size, hipStream_t stream) {
    static int grid_blocks = 0;
    if (grid_blocks == 0) {
        if (n_in != 16 || in_sizes[0] != NTOK * DM || out_size != NTOK * DM || ws_size < WS_END) {
            fprintf(stderr, "kernel_launch: shape mismatch (n_in %d in0 %d out %d ws %zu)\n", n_in, n_in > 0 ? in_sizes[0] : -1, out_size, ws_size); grid_blocks = -1; return; }
        int dev = 0, cus = 0, per_cu = 0;
        hipGetDevice(&dev);
        hipDeviceGetAttribute(&cus, hipDeviceAttributeMultiprocessorCount, dev);
        if (hipFuncSetAttribute((const void*)fwd_megakernel, hipFuncAttributeMaxDynamicSharedMemorySize, LDS_BYTES) != hipSuccess) { fprintf(stderr, "kernel_launch: hipFuncSetAttribute failed\n"); grid_blocks = -1; return; }
        hipOccupancyMaxActiveBlocksPerMultiprocessor(&per_cu, (const void*)fwd_megakernel, 512, LDS_BYTES);
        if (per_cu < 1) { fprintf(stderr, "kernel_launch: occupancy query returned %d\n", per_cu); per_cu = 1; }
        (void)hipGetLastError();
        grid_blocks = cus;
    }
    if (grid_blocks < 0) return;
    hipMemsetAsync((char*)d_ws + WS_MOD, 0, 128 * 1024, stream);
    Params p{};
    p.x = (const float*)d_in[0]; p.c = (const float*)d_in[1]; p.ctx = (const float*)d_in[2]; p.c_ctx = (const float*)d_in[3]; p.norm_g = (const float*)d_in[4];
    p.w_mod = (const float*)d_in[5]; p.b_mod = (const float*)d_in[6]; p.w_in = (const float*)d_in[7]; p.w_out = (const float*)d_in[8];
    p.lq1 = (const float*)d_in[9]; p.lk1 = (const float*)d_in[10]; p.lq2 = (const float*)d_in[11]; p.lk2 = (const float*)d_in[12];
    p.subln_g = (const float*)d_in[13]; p.rpb = (const float*)d_in[14]; p.final_g = (const float*)d_in[15];
    p.out = (float*)d_out; p.ws = (unsigned char*)d_ws;
    void* args[] = {&p};
    hipError_t e = hipLaunchCooperativeKernel((const void*)fwd_megakernel, dim3(grid_blocks), dim3(512), args, LDS_BYTES, stream);
    if (e != hipSuccess) fprintf(stderr, "cooperative launch failed: %s (grid %d)\n", hipGetErrorString(e), grid_blocks);
}
```

```cpp
#include <hip/hip_runtime.h>
#include <hip/hip_cooperative_groups.h>
#include <cstdio>
#include <cstdint>
namespace cg = cooperative_groups;

#define LAS __attribute__((address_space(3)))
typedef unsigned short bf16_t;
typedef short bf16x8 __attribute__((ext_vector_type(8)));
typedef short s16x4 __attribute__((ext_vector_type(4)));
typedef float f32x4 __attribute__((ext_vector_type(4)));
typedef float f32x16 __attribute__((ext_vector_type(16)));
typedef unsigned u32x4 __attribute__((ext_vector_type(4)));

constexpr int DM = 2048, NB = 4, SEQ = 8192, CTX = 256, NTOK = NB * SEQ, NCTX = NB * CTX, INC = 8192, SKV = SEQ + CTX;
constexpr float LOG2E = 1.4426950408889634f;
constexpr float C2A = 0.125f * LOG2E;
constexpr float C2B = 0.08838834764831845f * LOG2E;
constexpr size_t MiB = 1u << 20;
constexpr size_t WS_MOD = 0, WS_LAM = 128 * 1024, WS_ROPE = 192 * 1024, WS_WIN = 1 * MiB, WS_WOUT = 33 * MiB, WS_HX = 48 * MiB;
constexpr size_t WS_QA = 192 * MiB, WS_KA = 256 * MiB, WS_VA = 328 * MiB, WS_QB = 400 * MiB, WS_KB = 464 * MiB, WS_VB = 536 * MiB;
constexpr size_t WS_G = 608 * MiB, WS_MIX = 736 * MiB, WS_END = 864 * MiB;
constexpr int LDS_BYTES = 136192;

__device__ __forceinline__ unsigned cvtpk(float lo, float hi) { unsigned r; asm volatile("v_cvt_pk_bf16_f32 %0, %1, %2" : "=v"(r) : "v"(lo), "v"(hi)); return r; }
__device__ __forceinline__ float bf2f(bf16_t v) { return __uint_as_float((unsigned)v << 16); }
__device__ __forceinline__ float silu_f(float v) { return v * __builtin_amdgcn_rcpf(1.f + __builtin_amdgcn_exp2f(-v * LOG2E)); }
__device__ __forceinline__ float wave_sum(float v) {
#pragma unroll
    for (int o = 1; o < 64; o <<= 1) v += __shfl_xor(v, o);
    return v;
}

namespace pg8 {
constexpr int BM = 256, BK = 64, HALF = 128, HTB = HALF * BK * 2, NXCD = 8, WGM = 8;
__host__ __device__ __forceinline__ int lds_byte(int r, int c) { const int st = (r >> 4) * 2 + (c >> 5), rr = r & 15, cc = c & 31, ob = rr * 64 + cc * 2; return st * 1024 + (ob ^ (((ob >> 9) & 1) << 5)); }
__host__ __device__ __forceinline__ void stage_rc(int b, int& R, int& C) { const int st = b / 1024, sb = b % 1024, swz = sb ^ (((sb >> 9) & 1) << 5); R = (st >> 1) * 16 + swz / 64; C = (st & 1) * 32 + (swz % 64) / 2; }
__host__ __device__ __forceinline__ int perm32(int rho) { const int n = rho >> 4, i = rho & 15; return 8 * (i >> 2) + 4 * n + (i & 3); }
__host__ __device__ __forceinline__ int perm32inv(int q) { return 16 * ((q >> 2) & 1) + 4 * (q >> 3) + (q & 3); }
struct Unit { int pm, pn; };
struct Gemm { const bf16_t* A; const bf16_t* Bt; int K; };

struct Order {
    int nM, nN, nwg, G, c, nX;
    __device__ void init(int nM_, int nN_, int G_, int c_, int nX_) { nM = nM_; nN = nN_; nwg = nM * nN; G = G_; c = c_; nX = nX_; }
    __device__ bool next(int i, Unit& u) const {
        const int L = i * G + c; if (L >= nwg + nX) return false;
        if (L >= nwg) { const int e = L - nwg; u.pm = nM + (e >> 4); const int q = e & 15; u.pn = q < 8 ? 4 + q : 12 + q; return true; }
        int wgid = L; { const int q = nwg / NXCD, r = nwg % NXCD, xcd = wgid % NXCD, off = wgid / NXCD; wgid = (xcd < r ? xcd * (q + 1) : r * (q + 1) + (xcd - r) * q) + off; }
        const int nig = WGM * nN, gid = wgid / nig, fm = gid * WGM, gsz = (nM - fm) < WGM ? (nM - fm) : WGM;
        u.pm = fm + ((wgid % nig) % gsz); u.pn = (wgid % nig) / gsz; return true;
    }
};

template <class Epi>
__device__ __forceinline__ void gemm_phase(LAS unsigned char* lds, const Gemm g, const Order& S, const Epi& E) {
    int tid = threadIdx.x; asm volatile("" : "+v"(tid));
    const int wid = __builtin_amdgcn_readfirstlane(tid >> 6), lane = tid & 63, wr = wid >> 2, wc = wid & 3, fr = lane & 15, fq = lane >> 4;
    const int K = g.K, nt = K / BK;
    unsigned voffA[2], voffB[2];
#pragma unroll
    for (int i = 0; i < 2; ++i) { int R, C; stage_rc(tid * 16 + i * 8192, R, C); const int Rb = (R & ~31) + perm32(R & 31);
        voffA[i] = (unsigned)(R * K + C) * 2u; voffB[i] = (unsigned)(Rb * K + C) * 2u; }
    const size_t kstep = (size_t)(BK * 2);
    const size_t hstep = (size_t)HALF * K * 2;
    const size_t tstep = 2 * hstep;
    const unsigned ldsw = (unsigned)wid * 1024u;
    const int aoff = lds_byte(wr * 64 + fr, fq * 8), boff = lds_byte(wc * 32 + fr, fq * 8);
#define PG8_SA(b, h) (((b) * 2 + (h)) * HTB)
#define PG8_SB(b, h) ((4 + (b) * 2 + (h)) * HTB)
#define PG8_STAGE(bufoff, gbase, voff) do { _Pragma("unroll") for (int _i = 0; _i < 2; ++_i) \
        __builtin_amdgcn_global_load_lds((const unsigned*)((const char*)(gbase) + (voff)[_i]), (LAS unsigned*)(lds + (bufoff) + ldsw + _i * 8192), 16, 0, 0); } while (0)
#define PG8_LDA(dst, b, h) do { _Pragma("unroll") for (int m = 0; m < 4; ++m) _Pragma("unroll") for (int k = 0; k < 2; ++k) dst[m][k] = *(const LAS bf16x8*)(lds + PG8_SA(b, h) + aoff + m * 2048 + k * 1024); } while (0)
#define PG8_LDB(dst, b, h) do { _Pragma("unroll") for (int n = 0; n < 2; ++n) _Pragma("unroll") for (int k = 0; k < 2; ++k) dst[n][k] = *(const LAS bf16x8*)(lds + PG8_SB(b, h) + boff + n * 2048 + k * 1024); } while (0)
#define PG8_MMA(ai, bj, At, Bt) do { __builtin_amdgcn_s_setprio(1); _Pragma("unroll") for (int m = 0; m < 4; ++m) _Pragma("unroll") for (int n = 0; n < 2; ++n) _Pragma("unroll") for (int k = 0; k < 2; ++k) \
        acc[ai][bj][m][n] = __builtin_amdgcn_mfma_f32_16x16x32_bf16(Bt[n][k], At[m][k], acc[ai][bj][m][n], 0, 0, 0); __builtin_amdgcn_s_setprio(0); } while (0)
#define PG8_WAIT_V(n) asm volatile("s_waitcnt vmcnt(" #n ")" ::: "memory")
#define PG8_WAIT_L(n) asm volatile("s_waitcnt lgkmcnt(" #n ")" ::: "memory")
#define PG8_BAR __builtin_amdgcn_s_barrier()
#define PG8_SCHED __builtin_amdgcn_sched_barrier(0)
    Unit cur, nxt; int ui = 0;
    if (!S.next(0, cur)) return;
    f32x4 acc[2][2][4][2];
#pragma unroll
    for (int a = 0; a < 2; ++a)
#pragma unroll
        for (int b = 0; b < 2; ++b)
#pragma unroll
            for (int m = 0; m < 4; ++m)
#pragma unroll
                for (int n = 0; n < 2; ++n) acc[a][b][m][n] = (f32x4){0.f, 0.f, 0.f, 0.f};
    bf16x8 At[4][2], B0[2][2], B1[2][2];
    const char* cA = (const char*)g.A + (size_t)cur.pm * tstep; const char* cB = (const char*)g.Bt + (size_t)cur.pn * tstep;
    PG8_STAGE(PG8_SB(0, 0), cB, voffB); PG8_STAGE(PG8_SB(0, 1), cB + hstep, voffB); PG8_STAGE(PG8_SA(0, 0), cA, voffA); PG8_STAGE(PG8_SA(0, 1), cA + hstep, voffA);
    if (wr == 1) PG8_BAR;
    PG8_WAIT_V(2); PG8_BAR;
    PG8_STAGE(PG8_SB(1, 0), cB + kstep, voffB); PG8_STAGE(PG8_SA(1, 0), cA + kstep, voffA); PG8_STAGE(PG8_SB(1, 1), cB + hstep + kstep, voffB);
    PG8_WAIT_V(6); PG8_BAR;
    for (;;) {
        const bool has_next = S.next(ui + 1, nxt);
        const char* nA = has_next ? (const char*)g.A + (size_t)nxt.pm * tstep : cA; const char* nB = has_next ? (const char*)g.Bt + (size_t)nxt.pn * tstep : cB;
        for (int t = 0; t < nt; t += 2) {
            const bool last = (t == nt - 2);
            const char* a1 = cA + (size_t)(t + 1) * kstep;
            const char* a2 = last ? nA : cA + (size_t)(t + 2) * kstep; const char* b2 = last ? nB : cB + (size_t)(t + 2) * kstep;
            const char* a3 = a2 + kstep; const char* b3 = b2 + kstep;
            PG8_LDB(B0, 0, 0); PG8_LDB(B1, 0, 1); PG8_SCHED; PG8_LDA(At, 0, 0); PG8_STAGE(PG8_SA(1, 1), a1 + hstep, voffA);
            PG8_WAIT_V(8); PG8_WAIT_L(0); PG8_BAR; PG8_MMA(0, 0, At, B0); PG8_MMA(0, 1, At, B1); PG8_BAR; PG8_SCHED;
            PG8_LDA(At, 0, 1); PG8_STAGE(PG8_SB(0, 0), b2, voffB); PG8_STAGE(PG8_SB(0, 1), b2 + hstep, voffB); PG8_STAGE(PG8_SA(0, 0), a2, voffA);
            PG8_WAIT_V(8); PG8_WAIT_L(0); PG8_BAR; PG8_MMA(1, 0, At, B0); PG8_MMA(1, 1, At, B1); PG8_BAR; PG8_SCHED;
            PG8_LDB(B0, 1, 0); PG8_LDB(B1, 1, 1); PG8_SCHED; PG8_LDA(At, 1, 0); PG8_STAGE(PG8_SA(0, 1), a2 + hstep, voffA);
            PG8_WAIT_V(8); PG8_WAIT_L(0); PG8_BAR; PG8_MMA(0, 0, At, B0); PG8_MMA(0, 1, At, B1); PG8_BAR; PG8_SCHED;
            PG8_LDA(At, 1, 1); PG8_STAGE(PG8_SB(1, 0), b3, voffB); PG8_STAGE(PG8_SB(1, 1), b3 + hstep, voffB); PG8_STAGE(PG8_SA(1, 0), a3, voffA);
            PG8_WAIT_V(8); PG8_WAIT_L(0); PG8_BAR; PG8_MMA(1, 0, At, B0); PG8_MMA(1, 1, At, B1); PG8_BAR; PG8_SCHED;
        }
        if (wr == 0) PG8_BAR;
        E(acc, cur, wr, wc, fr, fq);
        if (!has_next) break;
#pragma unroll
        for (int a = 0; a < 2; ++a)
#pragma unroll
            for (int b = 0; b < 2; ++b)
#pragma unroll
                for (int m = 0; m < 4; ++m)
#pragma unroll
                    for (int n = 0; n < 2; ++n) acc[a][b][m][n] = (f32x4){0.f, 0.f, 0.f, 0.f};
        cur = nxt; cA = nA; cB = nB; ++ui;
        if (wr == 1) PG8_BAR;
    }
    PG8_WAIT_V(0);
    PG8_BAR;
#undef PG8_SA
#undef PG8_SB
#undef PG8_STAGE
#undef PG8_LDA
#undef PG8_LDB
#undef PG8_MMA
#undef PG8_WAIT_V
#undef PG8_WAIT_L
#undef PG8_BAR
#undef PG8_SCHED
}
}

struct EpiIn {
    static constexpr bool PERM = true;
    bf16_t *QA, *KA, *VA, *QB, *KB, *VB, *G; const float* rope;
    __device__ __forceinline__ void operator()(const f32x4 (&acc)[2][2][4][2], const pg8::Unit& u, int wr, int wc, int fr, int fq) const {
        const int type = u.pn >> 2, hb = (u.pn & 3) * 2;
        const bool isctx = u.pm >= 128;
        const int b = isctx ? u.pm - 128 : (u.pm >> 5);
        const int sbase = (isctx ? SEQ : (u.pm & 31) * 256) + wr * 64 + fr;
        const int dcol = wc * 32 + 8 * fq;
        if (type == 3 || type == 7) {
            bf16_t* gp = G + ((size_t)b * SEQ + sbase) * DM + (type == 7 ? 1024 : 0) + hb * 128 + dcol;
#pragma unroll
            for (int ai = 0; ai < 2; ++ai)
#pragma unroll
                for (int m = 0; m < 4; ++m)
#pragma unroll
                    for (int bj = 0; bj < 2; ++bj) {
                        const f32x4 v0 = acc[ai][bj][m][0], v1 = acc[ai][bj][m][1];
                        u32x4 w; w.x = cvtpk(silu_f(v0[0]), silu_f(v0[1])); w.y = cvtpk(silu_f(v0[2]), silu_f(v0[3]));
                        w.z = cvtpk(silu_f(v1[0]), silu_f(v1[1])); w.w = cvtpk(silu_f(v1[2]), silu_f(v1[3]));
                        *(u32x4*)(gp + (size_t)(ai * 128 + m * 16) * DM + bj * 128) = w;
                    }
            return;
        }
        bf16_t* base; int SK; float sc = 1.f;
        switch (type) {
            case 0: base = QA; SK = SEQ; sc = C2A; break;
            case 1: base = KA; SK = SKV; break;
            case 2: base = VA; SK = SKV; break;
            case 4: base = QB; SK = SEQ; sc = C2B; break;
            case 5: base = KB; SK = SKV; break;
            default: base = VB; SK = SKV; break;
        }
        const bool dorope = (type <= 1) && !isctx;
        bf16_t* op = base + ((size_t)(b * 8 + hb) * SK + sbase) * 128 + dcol;
        const size_t hstride = (size_t)SK * 128;
#pragma unroll
        for (int ai = 0; ai < 2; ++ai)
#pragma unroll
            for (int m = 0; m < 4; ++m) {
                f32x4 cs0 = {1.f, 0.f, 1.f, 0.f}, cs1 = {1.f, 0.f, 1.f, 0.f};
                if (dorope) { const int s = sbase + ai * 128 + m * 16; const int pos = (wc & 1) ? (s & 63) : (s >> 6);
                    const f32x4* rp = (const f32x4*)(rope + (size_t)(pos * 16 + 4 * fq) * 2); cs0 = rp[0]; cs1 = rp[1]; }
#pragma unroll
                for (int bj = 0; bj < 2; ++bj) {
                    const f32x4 x1 = acc[ai][bj][m][0], x2 = acc[ai][bj][m][1];
                    f32x4 y1, y2;
                    y1[0] = x1[0] * cs0[0] - x2[0] * cs0[1]; y2[0] = x2[0] * cs0[0] + x1[0] * cs0[1];
                    y1[1] = x1[1] * cs0[2] - x2[1] * cs0[3]; y2[1] = x2[1] * cs0[2] + x1[1] * cs0[3];
                    y1[2] = x1[2] * cs1[0] - x2[2] * cs1[1]; y2[2] = x2[2] * cs1[0] + x1[2] * cs1[1];
                    y1[3] = x1[3] * cs1[2] - x2[3] * cs1[3]; y2[3] = x2[3] * cs1[2] + x1[3] * cs1[3];
                    y1 = y1 * sc; y2 = y2 * sc;
                    u32x4 w; w.x = cvtpk(y1[0], y1[1]); w.y = cvtpk(y1[2], y1[3]); w.z = cvtpk(y2[0], y2[1]); w.w = cvtpk(y2[2], y2[3]);
                    *(u32x4*)(op + (size_t)(ai * 128 + m * 16) * 128 + bj * hstride) = w;
                }
            }
    }
};
struct EpiOut {
    static constexpr bool PERM = true;
    const float* x; const float* mod; float* out;
    __device__ __forceinline__ void operator()(const f32x4 (&acc)[2][2][4][2], const pg8::Unit& u, int wr, int wc, int fr, int fq) const {
        const int row0 = u.pm * 256 + wr * 64 + fr, b = u.pm >> 5, col0 = u.pn * 256 + wc * 32 + 8 * fq;
        f32x4 gv[2][2];
#pragma unroll
        for (int bj = 0; bj < 2; ++bj)
#pragma unroll
            for (int n = 0; n < 2; ++n) gv[bj][n] = *(const f32x4*)(mod + b * 6144 + 4096 + col0 + bj * 128 + 4 * n);
#pragma unroll
        for (int ai = 0; ai < 2; ++ai)
#pragma unroll
            for (int m = 0; m < 4; ++m) {
                const size_t ro = (size_t)(row0 + ai * 128 + m * 16) * DM + col0;
#pragma unroll
                for (int bj = 0; bj < 2; ++bj) {
                    const f32x4 x0 = *(const f32x4*)(x + ro + bj * 128), x1 = *(const f32x4*)(x + ro + bj * 128 + 4);
                    *(f32x4*)(out + ro + bj * 128) = x0 + gv[bj][0] * acc[ai][bj][m][0];
                    *(f32x4*)(out + ro + bj * 128 + 4) = x1 + gv[bj][1] * acc[ai][bj][m][1];
                }
            }
    }
};

#define KSWZ(row, colB) ((row) * 256 + ((colB) ^ (((row) & 7) << 4)))
#define SBAR() __builtin_amdgcn_sched_barrier(0)
__device__ __forceinline__ int crow(int r, int hi) { return (r & 3) + 8 * (r >> 2) + 4 * hi; }
__device__ __forceinline__ int v_st(int k, int c) { const int kk = (k & ~0xC) | ((k & 4) << 1) | ((k & 8) >> 1); return ((kk >> 3) * 4 + (c >> 5)) * 512 + ((kk & 7) * 32 + (c & 31)) * 2; }
__device__ __forceinline__ int v_rd_base(int lane) { return ((lane & 3) << 3) | (((lane >> 2) & 3) << 6) | (((lane >> 4) & 1) << 5) | (((lane >> 5) & 1) << 8); }
constexpr int v_rd_off(int d0, int ks, int half) { return d0 * 512 + ks * 4096 + half * 2048; }
template <int OFF> __device__ __forceinline__ s16x4 tr_read(int vb) {
    s16x4 r; asm volatile("ds_read_b64_tr_b16 %0, %1 offset:%2" : "=&v"(r) : "v"(vb), "i"(OFF) : "memory"); return r;
}
template <int D0> __device__ __forceinline__ void pv_one(f32x16& od, int vb, bf16x8 pa0, bf16x8 pa1, bf16x8 pa2, bf16x8 pa3) {
    const s16x4 l0 = tr_read<v_rd_off(D0, 0, 0)>(vb), h0 = tr_read<v_rd_off(D0, 0, 1)>(vb), l1 = tr_read<v_rd_off(D0, 1, 0)>(vb), h1 = tr_read<v_rd_off(D0, 1, 1)>(vb);
    const s16x4 l2 = tr_read<v_rd_off(D0, 2, 0)>(vb), h2 = tr_read<v_rd_off(D0, 2, 1)>(vb), l3 = tr_read<v_rd_off(D0, 3, 0)>(vb), h3 = tr_read<v_rd_off(D0, 3, 1)>(vb);
    asm volatile("s_waitcnt lgkmcnt(0)" ::: "memory"); SBAR();
#define PK(L, H) (bf16x8){L[0], L[1], L[2], L[3], H[0], H[1], H[2], H[3]}
    od = __builtin_amdgcn_mfma_f32_32x32x16_bf16(pa0, PK(l0, h0), od, 0, 0, 0);
    od = __builtin_amdgcn_mfma_f32_32x32x16_bf16(pa1, PK(l1, h1), od, 0, 0, 0);
    od = __builtin_amdgcn_mfma_f32_32x32x16_bf16(pa2, PK(l2, h2), od, 0, 0, 0);
    od = __builtin_amdgcn_mfma_f32_32x32x16_bf16(pa3, PK(l3, h3), od, 0, 0, 0);
#undef PK
}

template <int NMAP, int D0> __device__ __forceinline__ void pv_all(f32x16 (&o)[NMAP][4], int vb, const bf16x8 (&pa)[NMAP][4]) {
    const s16x4 l0 = tr_read<v_rd_off(D0, 0, 0)>(vb), h0 = tr_read<v_rd_off(D0, 0, 1)>(vb), l1 = tr_read<v_rd_off(D0, 1, 0)>(vb), h1 = tr_read<v_rd_off(D0, 1, 1)>(vb);
    const s16x4 l2 = tr_read<v_rd_off(D0, 2, 0)>(vb), h2 = tr_read<v_rd_off(D0, 2, 1)>(vb), l3 = tr_read<v_rd_off(D0, 3, 0)>(vb), h3 = tr_read<v_rd_off(D0, 3, 1)>(vb);
    asm volatile("s_waitcnt lgkmcnt(0)" ::: "memory"); SBAR();
#define PK(L, H) (bf16x8){L[0], L[1], L[2], L[3], H[0], H[1], H[2], H[3]}
    const bf16x8 v0 = PK(l0, h0), v1 = PK(l1, h1), v2 = PK(l2, h2), v3 = PK(l3, h3);
#undef PK
#pragma unroll
    for (int mp = 0; mp < NMAP; ++mp) {
        o[mp][D0] = __builtin_amdgcn_mfma_f32_32x32x16_bf16(pa[mp][0], v0, o[mp][D0], 0, 0, 0);
        o[mp][D0] = __builtin_amdgcn_mfma_f32_32x32x16_bf16(pa[mp][1], v1, o[mp][D0], 0, 0, 0);
        o[mp][D0] = __builtin_amdgcn_mfma_f32_32x32x16_bf16(pa[mp][2], v2, o[mp][D0], 0, 0, 0);
        o[mp][D0] = __builtin_amdgcn_mfma_f32_32x32x16_bf16(pa[mp][3], v3, o[mp][D0], 0, 0, 0);
    }
}

struct AttnP { const bf16_t *QA, *KA, *VA, *QB, *KB, *VB, *G; bf16_t* MIX; const float *subln_g, *rpb, *lam; };

template <int MODE, bool FAST>
__device__ __forceinline__ int attn_item(const AttnP& a, int b, int h, int blk, char* lds) {
    constexpr int NMAP = MODE == 0 ? 2 : 1, KD0 = MODE == 0 ? 4 : 8, NT = MODE == 0 ? SKV / 64 : 16;
    constexpr float THR = 8.f;
    int tid = threadIdx.x; asm volatile("" : "+v"(tid));
    const int wid = __builtin_amdgcn_readfirstlane(tid >> 6), lane = tid & 63, r32 = lane & 31, hi = lane >> 5;
    char* V_lds = lds; char* K_lds = lds + 32768;
    float* wsf = (float*)(lds + 65536) + wid * 64;
    float* rpbz = (float*)(lds + 65536 + 2048);
    float* rpbs = rpbz + 128;
    char* Qw = lds + 70656 + wid * 8192;
    const size_t bh = (size_t)(b * 8 + h);
    const int qrow = 4 * blk + (wid >> 1), half = wid & 1;
    const int qtok = MODE == 0 ? blk * 256 + wid * 32 : qrow * 64 + half * 32;
    const int ulo = min(max(4 * blk - 4, 0), 116), r0w = min(max(qrow - 4, 0), 120);
    {
        const bf16_t* Qg = (MODE == 0 ? a.QA : a.QB) + (bh * SEQ + qtok) * 128;
#pragma unroll
        for (int i = 0; i < 8; ++i) { const int row = i * 4 + (lane >> 4), c16 = lane & 15;
            const bf16x8 qv = *(const bf16x8*)(Qg + (size_t)row * 128 + c16 * 8);
            *(bf16x8*)(Qw + KSWZ(row, c16 * 16)) = qv; }
    }
    const char* Kh = (const char*)((MODE == 0 ? a.KA : a.KB) + bh * SKV * 128);
    const char* Vh = (const char*)((MODE == 0 ? a.VA : a.VB) + bh * SKV * 128);
    unsigned voffK, voffV;
    {
        const int krow = 4 * wid + (lane >> 4), kch = (lane & 15) ^ (krow & 7);
        voffK = (unsigned)(krow * 256 + kch * 16);
        const int sub = 2 * wid + (lane >> 5), kk = (sub >> 2) * 8 + ((lane & 31) >> 2), cblk = sub & 3;
        const int kreal = (kk & ~0xC) | ((kk & 4) << 1) | ((kk & 8) >> 1);
        voffV = (unsigned)(kreal * 256 + (cblk * 32 + (lane & 3) * 8) * 2);
    }
    const int vb0 = (int)(uintptr_t)V_lds + v_rd_base(lane);
    int koff[4];
#pragma unroll
    for (int i = 0; i < 4; ++i) koff[i] = r32 * 256 + (((2 * i + hi) ^ (r32 & 7)) << 4);
    if (MODE == 1) { for (int i = tid; i < 768; i += 512) { const int k = i - 128; rpbz[i] = (k >= 0 && k < 465) ? a.rpb[h * 465 + k] * LOG2E : 0.f; } }
    f32x16 negm0 = f32x16{}, negm1 = f32x16{};
    if (MODE == 1 && FAST) { const int j = half * 32 + r32, c0 = min(max(j - 8, 0), 48);
#pragma unroll
        for (int r = 0; r < 16; ++r) { const int kc = crow(r, hi); negm0[r] = ((unsigned)(kc - c0) < 16u) ? 0.f : -1e30f; negm1[r] = ((unsigned)(kc + 32 - c0) < 16u) ? 0.f : -1e30f; } }
    f32x16 o[NMAP][4]; float m_reg[NMAP], l_reg[NMAP];
#pragma unroll
    for (int mp = 0; mp < NMAP; ++mp) { m_reg[mp] = -1e30f; l_reg[mp] = 0.f;
#pragma unroll
        for (int d = 0; d < 4; ++d) o[mp][d] = f32x16{}; }
#define TROW(t) (MODE == 0 ? (t) * 64 : ((t) < 4 ? SEQ + (t) * 64 : (ulo + (t) - 4) * 64))
#define STAGE(t, bi) do { const size_t g0_ = (size_t)TROW(t) * 256; _Pragma("unroll") for (int ii_ = 0; ii_ < 2; ++ii_) { \
        __builtin_amdgcn_global_load_lds((const unsigned*)(Kh + g0_ + ii_ * 8192 + voffK), (LAS unsigned*)((LAS unsigned char*)K_lds + (bi) * 16384 + wid * 1024 + ii_ * 8192), 16, 0, 0); \
        __builtin_amdgcn_global_load_lds((const unsigned*)(Vh + g0_ + ii_ * 8192 + voffV), (LAS unsigned*)((LAS unsigned char*)V_lds + (bi) * 16384 + wid * 1024 + ii_ * 8192), 16, 0, 0); } } while (0)
    STAGE(0, 0);
    asm volatile("s_waitcnt vmcnt(0) lgkmcnt(0)" ::: "memory");
    __syncthreads();
#pragma nounroll
    for (int t = 0; t < NT; ++t) {
        const int cur = t & 1;
        if (t + 1 < NT) STAGE(t + 1, cur ^ 1);
        bool active = true; int br = 0;
        if (MODE == 1 && t >= 4) { br = ulo + t - 4; active = (br >= r0w) && (br <= r0w + 7); }
        if (active) {
            const char* Kc = K_lds + cur * 16384; const int vb = vb0 + cur * 16384;
            bf16x8 pa[NMAP][4];
#pragma unroll
            for (int mp = 0; mp < NMAP; ++mp) {
                SBAR();
                f32x16 p0 = f32x16{}, p1 = f32x16{};
                if (MODE == 1 && FAST && t >= 4) { p0 = negm0; p1 = negm1; }
#pragma unroll
                for (int d0 = 0; d0 < KD0; ++d0) { const int dd = (MODE == 0 ? mp * 4 : 0) + d0; const int off = koff[dd & 3] + (dd >> 2) * 128;
                    const bf16x8 k0 = *(const bf16x8*)(Kc + off); const bf16x8 k1 = *(const bf16x8*)(Kc + off + 8192);
                    const bf16x8 qf = *(const bf16x8*)(Qw + off);
                    p0 = __builtin_amdgcn_mfma_f32_32x32x16_bf16(k0, qf, p0, 0, 0, 0);
                    p1 = __builtin_amdgcn_mfma_f32_32x32x16_bf16(k1, qf, p1, 0, 0, 0);
                    if ((d0 & 1) == 1) SBAR(); }
                if (MODE == 1 && FAST && t >= 4) {
                    const float* bp = rpbs + (br - qrow + 7) * 31 + 15 - (half * 32 + r32) + 4 * hi;
#pragma unroll
                    for (int r = 0; r < 16; ++r) { p0[r] += bp[(r & 3) + 8 * (r >> 2)]; p1[r] += bp[32 + (r & 3) + 8 * (r >> 2)]; }
                }
                if (MODE == 1 && !FAST && t >= 4) {
                    const int j = half * 32 + r32, c0 = min(max(j - 8, 0), 48);
                    const float* bp = rpbs + (br - qrow + 7) * 31 + 15 - j;
#pragma unroll
                    for (int r = 0; r < 16; ++r) { const int kc = crow(r, hi); const bool ok = (unsigned)(kc - c0) < 16u; const float bv = bp[ok ? kc : j];
                        p0[r] = ok ? p0[r] + bv : -1e30f; }
#pragma unroll
                    for (int r = 0; r < 16; ++r) { const int kc = 32 + crow(r, hi); const bool ok = (unsigned)(kc - c0) < 16u; const float bv = bp[ok ? kc : j];
                        p1[r] = ok ? p1[r] + bv : -1e30f; }
                }
                float alpha = 1.f;
                if (FAST) {
                    float psa = 0.f, psb = 0.f;
#pragma unroll
                    for (int r = 0; r < 16; ++r) { p0[r] = __builtin_amdgcn_exp2f(p0[r]); psa += p0[r]; }
#pragma unroll
                    for (int r = 0; r < 16; ++r) { p1[r] = __builtin_amdgcn_exp2f(p1[r]); psb += p1[r]; }
                    l_reg[mp] += psa + psb;
                } else {
                float pmax = p0[0];
#pragma unroll
                for (int r = 1; r < 16; ++r) pmax = fmaxf(pmax, p0[r]);
#pragma unroll
                for (int r = 0; r < 16; ++r) pmax = fmaxf(pmax, p1[r]);
                { auto rr = __builtin_amdgcn_permlane32_swap(__float_as_uint(pmax), __float_as_uint(pmax), false, false);
                  pmax = fmaxf(__uint_as_float(rr[0]), __uint_as_float(rr[1])); }
                float mn = m_reg[mp];
                if (!__all(pmax - m_reg[mp] <= THR)) { mn = fmaxf(m_reg[mp], pmax); alpha = __builtin_amdgcn_exp2f(m_reg[mp] - mn); m_reg[mp] = mn; }
                float ps = 0.f;
#pragma unroll
                for (int r = 0; r < 16; ++r) { p0[r] = __builtin_amdgcn_exp2f(p0[r] - mn); ps += p0[r]; }
#pragma unroll
                for (int r = 0; r < 16; ++r) { p1[r] = __builtin_amdgcn_exp2f(p1[r] - mn); ps += p1[r]; }
                { auto rr = __builtin_amdgcn_permlane32_swap(__float_as_uint(ps), __float_as_uint(ps), false, false);
                  ps = __uint_as_float(rr[0]) + __uint_as_float(rr[1]); }
                l_reg[mp] = l_reg[mp] * alpha + ps;
                }
#define PK4(P, BASE, OUT) do { unsigned a0 = cvtpk(P[BASE + 0], P[BASE + 1]), a1 = cvtpk(P[BASE + 2], P[BASE + 3]);   \
    unsigned b0 = cvtpk(P[BASE + 4], P[BASE + 5]), b1 = cvtpk(P[BASE + 6], P[BASE + 7]);                              \
    auto r0 = __builtin_amdgcn_permlane32_swap(a0, b0, false, false); auto r1 = __builtin_amdgcn_permlane32_swap(a1, b1, false, false); \
    u32x4 w = {r0[0], r1[0], r0[1], r1[1]}; OUT = *reinterpret_cast<bf16x8*>(&w); } while (0)
                PK4(p0, 0, pa[mp][0]); PK4(p0, 8, pa[mp][1]); PK4(p1, 0, pa[mp][2]); PK4(p1, 8, pa[mp][3]);
#undef PK4
                if (!FAST && __any(alpha < 1.f)) {
                    if (hi == 0) wsf[r32] = alpha;
                    asm volatile("s_waitcnt lgkmcnt(0)" ::: "memory");
#pragma unroll
                    for (int r = 0; r < 16; ++r) { const float al = wsf[crow(r, hi)];
#pragma unroll
                        for (int d = 0; d < 4; ++d) o[mp][d][r] *= al; }
                }
            }
            SBAR();
            pv_all<NMAP, 0>(o, vb, pa); pv_all<NMAP, 1>(o, vb, pa); pv_all<NMAP, 2>(o, vb, pa); pv_all<NMAP, 3>(o, vb, pa);
        }
        asm volatile("s_waitcnt vmcnt(0)" ::: "memory");
        __syncthreads();
    }
#undef TROW
#undef STAGE
    if (FAST) {
        bool bad = false;
#pragma unroll
        for (int mp = 0; mp < NMAP; ++mp) { auto rr = __builtin_amdgcn_permlane32_swap(__float_as_uint(l_reg[mp]), __float_as_uint(l_reg[mp]), false, false);
            l_reg[mp] = __uint_as_float(rr[0]) + __uint_as_float(rr[1]); bad = bad || !(l_reg[mp] <= 1.0e30f); }
        if (lane == 0) rpbz[wid] = __any(bad) ? 1.f : 0.f;
        __syncthreads();
        float anyb = 0.f;
#pragma unroll
        for (int w = 0; w < 8; ++w) anyb += rpbz[w];
        __syncthreads();
        if (anyb != 0.f) return 1;
    }
    const float lam = MODE == 0 ? a.lam[0] : 0.f;
    if (hi == 0) { wsf[r32] = 1.f / l_reg[0]; if (MODE == 0) wsf[32 + r32] = lam / l_reg[NMAP - 1]; }
    asm volatile("s_waitcnt lgkmcnt(0)" ::: "memory");
    const size_t obase = ((size_t)b * SEQ + qtok) * DM + (MODE == 0 ? 0 : 1024) + h * 128 + r32;
    float sg[4];
#pragma unroll
    for (int d = 0; d < 4; ++d) sg[d] = MODE == 0 ? a.subln_g[d * 32 + r32] * 0.8f : 1.f;
#pragma unroll
    for (int r = 0; r < 16; ++r) {
        const int cr = crow(r, hi);
        const float ra = wsf[cr];
        float v[4];
        if (MODE == 0) {
            const float rb = wsf[32 + cr];
            float ss = 0.f;
#pragma unroll
            for (int d = 0; d < 4; ++d) { v[d] = o[0][d][r] * ra - o[NMAP - 1][d][r] * rb; ss += v[d] * v[d]; }
            ss += __shfl_xor(ss, 1); ss += __shfl_xor(ss, 2); ss += __shfl_xor(ss, 4); ss += __shfl_xor(ss, 8); ss += __shfl_xor(ss, 16);
            const float rstd = rsqrtf(ss * (1.f / 128.f) + 1e-5f);
#pragma unroll
            for (int d = 0; d < 4; ++d) v[d] *= rstd * sg[d];
        } else {
#pragma unroll
            for (int d = 0; d < 4; ++d) v[d] = o[0][d][r] * ra;
        }
        const size_t ro = obase + (size_t)cr * DM;
#pragma unroll
        for (int d = 0; d < 4; ++d) { const float gg = bf2f(a.G[ro + d * 32]); a.MIX[ro + d * 32] = (bf16_t)(cvtpk(v[d] * gg, 0.f) & 0xffffu); }
    }
    return 0;
}

struct Params {
    const float *x, *c, *ctx, *c_ctx, *norm_g, *w_mod, *b_mod, *w_in, *w_out, *lq1, *lk1, *lq2, *lk2, *subln_g, *rpb, *final_g;
    float* out; unsigned char* ws;
};

__device__ __forceinline__ void transpose_item(const float* W, int K, int N, bf16_t* WT, LAS float* scr, int item, int lane, int perm_below) {
    const int nblk = N / 32, kb = item / nblk, nb = item % nblk, k0 = 64 * kb, n0 = 32 * nb;
#pragma unroll 8
    for (int i = 0; i < 32; ++i) { const int kk = 2 * i + (lane >> 5); scr[kk * 33 + (lane & 31)] = W[(size_t)(k0 + kk) * N + n0 + (lane & 31)]; }
    asm volatile("s_waitcnt lgkmcnt(0)" ::: "memory");
    const int c = lane & 7; const bool pr = n0 < perm_below;
#pragma unroll
    for (int j = 0; j < 4; ++j) { const int n = (lane >> 3) + 8 * j; const int ns = pr ? pg8::perm32inv(n) : n; const LAS float* s = scr + (8 * c) * 33 + ns;
        u32x4 o; o.x = cvtpk(s[0 * 33], s[1 * 33]); o.y = cvtpk(s[2 * 33], s[3 * 33]); o.z = cvtpk(s[4 * 33], s[5 * 33]); o.w = cvtpk(s[6 * 33], s[7 * 33]);
        *(u32x4*)(WT + (size_t)(n0 + n) * K + k0 + 8 * c) = o; }
    asm volatile("s_waitcnt lgkmcnt(0)" ::: "memory");
}

__global__ void __launch_bounds__(512, 2) fwd_megakernel(Params p) {
    extern __shared__ __attribute__((aligned(16))) unsigned char lds[];
    cg::grid_group grid = cg::this_grid();
    const int bid = blockIdx.x, G = gridDim.x;
#define TIDS() int tid = threadIdx.x; asm volatile("" : "+v"(tid)); const int lane = tid & 63, wid = __builtin_amdgcn_readfirstlane(tid >> 6); (void)lane; (void)wid;
#define WSPTRS() unsigned char* ws = p.ws; asm volatile("" : "+s"(ws)); \
    float* mod = (float*)(ws + WS_MOD); float* lamp = (float*)(ws + WS_LAM); float* rope = (float*)(ws + WS_ROPE); \
    bf16_t* WinT = (bf16_t*)(ws + WS_WIN); bf16_t* WoutT = (bf16_t*)(ws + WS_WOUT); bf16_t* HX = (bf16_t*)(ws + WS_HX); \
    bf16_t* QA = (bf16_t*)(ws + WS_QA); bf16_t* KA = (bf16_t*)(ws + WS_KA); bf16_t* VA = (bf16_t*)(ws + WS_VA); \
    bf16_t* QB = (bf16_t*)(ws + WS_QB); bf16_t* KB = (bf16_t*)(ws + WS_KB); bf16_t* VB = (bf16_t*)(ws + WS_VB); \
    bf16_t* GB = (bf16_t*)(ws + WS_G); bf16_t* MIX = (bf16_t*)(ws + WS_MIX); \
    (void)mod; (void)lamp; (void)rope; (void)WinT; (void)WoutT; (void)HX; (void)QA; (void)KA; (void)VA; (void)QB; (void)KB; (void)VB; (void)GB; (void)MIX;
    { WSPTRS(); TIDS();
    if (bid < 192) {
        const int cgp = bid % 12, kc = bid / 12;
        float* sl = (float*)lds;
        for (int i = tid; i < 640; i += 512) { const int bb = i >> 7, k = kc * 128 + (i & 127); const float v = bb < 4 ? p.c[bb * DM + k] : p.c_ctx[k]; sl[i] = v / (1.f + expf(-v)); }
        __syncthreads();
        const int col = cgp * 512 + tid;
        float a0 = 0.f, a1 = 0.f, a2 = 0.f, a3 = 0.f, a4 = 0.f;
        const float* wp = p.w_mod + (size_t)(kc * 128) * 6144 + col;
#pragma unroll 8
        for (int k = 0; k < 128; ++k) { const float w = wp[(size_t)k * 6144]; a0 += sl[k] * w; a1 += sl[128 + k] * w; a2 += sl[256 + k] * w; a3 += sl[384 + k] * w; a4 += sl[512 + k] * w; }
        if (kc == 0) { const float bm = p.b_mod[col]; a0 += bm; a1 += bm; a2 += bm; a3 += bm; a4 += bm; }
        atomicAdd(mod + col, a0); atomicAdd(mod + 6144 + col, a1); atomicAdd(mod + 2 * 6144 + col, a2); atomicAdd(mod + 3 * 6144 + col, a3); atomicAdd(mod + 4 * 6144 + col, a4);
        __syncthreads();
    } else if (bid < 196) {
        const int idx = (bid - 192) * 512 + tid, pos = idx >> 4, i = idx & 15;
        const float inv = powf(10000.f, -(float)i / 16.f), ang = (float)pos * inv;
        rope[2 * idx] = cosf(ang); rope[2 * idx + 1] = sinf(ang);
    } else if (bid == 196 && wid == 0) {
        const float d1 = wave_sum(p.lq1[lane] * p.lk1[lane]), d2 = wave_sum(p.lq2[lane] * p.lk2[lane]);
        if (lane == 0) lamp[0] = expf(d1) - expf(d2) + 0.2f;
    }
    {
        LAS float* scr = (LAS float*)((LAS unsigned char*)lds + wid * 16384);
        const int gw = bid * 8 + wid, NGW = G * 8;
        constexpr int I_IN = (DM / 64) * (INC / 32), I_OUT = (DM / 64) * (DM / 32);
        for (int it = gw; it < I_IN + I_OUT; it += NGW) {
            if (it < I_IN) transpose_item(p.w_in, DM, INC, WinT, scr, it, lane, 2048);
            else transpose_item(p.w_out, DM, DM, WoutT, scr, it - I_IN, lane, 0);
        }
    }
    }
    grid.sync();

    { WSPTRS(); TIDS();
        const int gw = bid * 8 + wid, NGW = G * 8;
        for (int R = gw; R < NTOK + NCTX; R += NGW) {
            const float* src = R < NTOK ? p.x + (size_t)R * DM : p.ctx + (size_t)(R - NTOK) * DM;
            const float* mr = mod + (R < NTOK ? (R >> 13) : 4) * 6144;
            f32x4 v[8]; float ss = 0.f;
#pragma unroll
            for (int j = 0; j < 8; ++j) { v[j] = *(const f32x4*)(src + j * 256 + lane * 4); ss += (v[j].x * v[j].x + v[j].y * v[j].y) + (v[j].z * v[j].z + v[j].w * v[j].w); }
            const float rstd = rsqrtf(wave_sum(ss) * (1.f / DM) + 1e-6f);
            bf16_t* orow = HX + (size_t)R * DM;
#pragma unroll
            for (int j = 0; j < 8; ++j) { const int k = j * 256 + lane * 4;
                const f32x4 g4 = *(const f32x4*)(p.norm_g + k), sh = *(const f32x4*)(mr + k), sc4 = *(const f32x4*)(mr + 2048 + k);
                const f32x4 y = v[j] * rstd * g4 * (sc4 + 1.f) + sh;
                uint2 w; w.x = cvtpk(y.x, y.y); w.y = cvtpk(y.z, y.w); *(uint2*)(orow + k) = w; }
        }
    }
    grid.sync();

    { WSPTRS();
        pg8::Gemm g{HX, WinT, DM}; pg8::Order S; S.init(NTOK / 256, INC / 256, G, bid, 64);
        EpiIn E{QA, KA, VA, QB, KB, VB, GB, rope};
        pg8::gemm_phase<EpiIn>((LAS unsigned char*)lds, g, S, E);
    }
    grid.sync();

    { WSPTRS();
        AttnP ap{QA, KA, VA, QB, KB, VB, GB, MIX, p.subln_g, p.rpb, lamp};
        unsigned badmask = 0u; int it = 0;
        for (int L = bid; L < 1024; L += G, ++it) { const int xcd = L & 7, rest = L >> 3, blk = rest & 31, bh = xcd + 8 * (rest >> 5);
            if (attn_item<0, true>(ap, bh >> 3, bh & 7, blk, (char*)lds)) badmask |= 1u << (it & 31); }
        badmask = __builtin_amdgcn_readfirstlane(badmask);
        if (badmask) { it = 0;
            for (int L = bid; L < 1024; L += G, ++it) { const int xcd = L & 7, rest = L >> 3, blk = rest & 31, bh = xcd + 8 * (rest >> 5);
                if ((badmask >> (it & 31)) & 1u) attn_item<0, false>(ap, bh >> 3, bh & 7, blk, (char*)lds); } }
    }
    { WSPTRS();
        AttnP ap{QA, KA, VA, QB, KB, VB, GB, MIX, p.subln_g, p.rpb, lamp};
        unsigned badmask = 0u; int it = 0;
        for (int L = bid; L < 1024; L += G, ++it) { const int xcd = L & 7, rest = L >> 3, blk = rest & 31, bh = xcd + 8 * (rest >> 5);
            if (attn_item<1, true>(ap, bh >> 3, bh & 7, blk, (char*)lds)) badmask |= 1u << (it & 31); }
        badmask = __builtin_amdgcn_readfirstlane(badmask);
        if (badmask) { it = 0;
            for (int L = bid; L < 1024; L += G, ++it) { const int xcd = L & 7, rest = L >> 3, blk = rest & 31, bh = xcd + 8 * (rest >> 5);
                if ((badmask >> (it & 31)) & 1u) attn_item<1, false>(ap, bh >> 3, bh & 7, blk, (char*)lds); } }
    }
    grid.sync();

    { WSPTRS();
        pg8::Gemm g{MIX, WoutT, DM}; pg8::Order S; S.init(NTOK / 256, DM / 256, G, bid, 0);
        EpiOut E{p.x, mod, p.out};
        pg8::gemm_phase<EpiOut>((LAS unsigned char*)lds, g, S, E);
    }
    grid.sync();

    { TIDS();
        const int gw = bid * 8 + wid, NGW = G * 8;
        for (int R = gw; R < NTOK; R += NGW) {
            float* row = p.out + (size_t)R * DM;
            f32x4 v[8]; float ss = 0.f;
#pragma unroll
            for (int j = 0; j < 8; ++j) { v[j] = *(const f32x4*)(row + j * 256 + lane * 4); ss += (v[j].x * v[j].x + v[j].y * v[j].y) + (v[j].z * v[j].z + v[j].w * v[j].w); }
            const float rstd = rsqrtf(wave_sum(ss) * (1.f / DM) + 1e-6f);
#pragma unroll
            for (int j = 0; j < 8; ++j) { const int k = j * 256 + lane * 4; const f32x4 g4 = *(const f32x4*)(p.final_g + k); *(f32x4*)(row + k) = v[j] * rstd * g4; }
        }
    }
}

extern "C" void kernel_launch(void* const* d_in, const int* in_sizes, int n_in, void* d_out, int out_size, void* d_ws, size_t ws_size, hipStream_t stream) {
    static int grid_blocks = 0;
    if (grid_blocks == 0) {
        if (n_in != 16 || in_sizes[0] != NTOK * DM || out_size != NTOK * DM || ws_size < WS_END) {
            fprintf(stderr, "kernel_launch: shape mismatch (n_in %d in0 %d out %d ws %zu)\n", n_in, n_in > 0 ? in_sizes[0] : -1, out_size, ws_size); grid_blocks = -1; return; }
        int dev = 0, cus = 0, per_cu = 0;
        hipGetDevice(&dev);
        hipDeviceGetAttribute(&cus, hipDeviceAttributeMultiprocessorCount, dev);
        if (hipFuncSetAttribute((const void*)fwd_megakernel, hipFuncAttributeMaxDynamicSharedMemorySize, LDS_BYTES) != hipSuccess) { fprintf(stderr, "kernel_launch: hipFuncSetAttribute failed\n"); grid_blocks = -1; return; }
        hipOccupancyMaxActiveBlocksPerMultiprocessor(&per_cu, (const void*)fwd_megakernel, 512, LDS_BYTES);
        if (per_cu < 1) { fprintf(stderr, "kernel_launch: occupancy query returned %d\n", per_cu); per_cu = 1; }
        (void)hipGetLastError();
        grid_blocks = cus;
    }
    if (grid_blocks < 0) return;
    hipMemsetAsync((char*)d_ws + WS_MOD, 0, 128 * 1024, stream);
    Params p{};
    p.x = (const float*)d_in[0]; p.c = (const float*)d_in[1]; p.ctx = (const float*)d_in[2]; p.c_ctx = (const float*)d_in[3]; p.norm_g = (const float*)d_in[4];
    p.w_mod = (const float*)d_in[5]; p.b_mod = (const float*)d_in[6]; p.w_in = (const float*)d_in[7]; p.w_out = (const float*)d_in[8];
    p.lq1 = (const float*)d_in[9]; p.lk1 = (const float*)d_in[10]; p.lq2 = (const float*)d_in[11]; p.lk2 = (const float*)d_in[12];
    p.subln_g = (const float*)d_in[13]; p.rpb = (const float*)d_in[14]; p.final_g = (const float*)d_in[15];
    p.out = (float*)d_out; p.ws = (unsigned char*)d_ws;
    void* args[] = {&p};
    hipError_t e = hipLaunchCooperativeKernel((const void*)fwd_megakernel, dim3(grid_blocks), dim3(512), args, LDS_BYTES, stream);
    if (e != hipSuccess) fprintf(stderr, "cooperative launch failed: %s (grid %d)\n", hipGetErrorString(e), grid_blocks);
}
```

```cpp
#include <hip/hip_runtime.h>
#include <hip/hip_cooperative_groups.h>
#include <cstdio>
#include <cstdint>
namespace cg = cooperative_groups;

#define LAS __attribute__((address_space(3)))
typedef unsigned short bf16_t;
typedef short bf16x8 __attribute__((ext_vector_type(8)));
typedef short s16x4 __attribute__((ext_vector_type(4)));
typedef float f32x4 __attribute__((ext_vector_type(4)));
typedef float f32x16 __attribute__((ext_vector_type(16)));
typedef unsigned u32x4 __attribute__((ext_vector_type(4)));

constexpr int DM = 2048, NB = 4, SEQ = 8192, CTX = 256, NTOK = NB * SEQ, NCTX = NB * CTX, INC = 8192, SKV = SEQ + CTX;
constexpr float LOG2E = 1.4426950408889634f;
constexpr float C2A = 0.125f * LOG2E;
constexpr float C2B = 0.08838834764831845f * LOG2E;
constexpr size_t MiB = 1u << 20;
constexpr size_t WS_MOD = 0, WS_LAM = 128 * 1024, WS_ROPE = 192 * 1024, WS_WIN = 1 * MiB, WS_WOUT = 33 * MiB, WS_HX = 48 * MiB;
constexpr size_t WS_QA = 192 * MiB, WS_KA = 256 * MiB, WS_VA = 328 * MiB, WS_QB = 400 * MiB, WS_KB = 464 * MiB, WS_VB = 536 * MiB;
constexpr size_t WS_G = 608 * MiB, WS_MIX = 736 * MiB, WS_END = 864 * MiB;
constexpr int LDS_BYTES = 136192;

__device__ __forceinline__ unsigned cvtpk(float lo, float hi) { unsigned r; asm volatile("v_cvt_pk_bf16_f32 %0, %1, %2" : "=v"(r) : "v"(lo), "v"(hi)); return r; }
__device__ __forceinline__ float bf2f(bf16_t v) { return __uint_as_float((unsigned)v << 16); }
__device__ __forceinline__ float silu_f(float v) { return v * __builtin_amdgcn_rcpf(1.f + __builtin_amdgcn_exp2f(-v * LOG2E)); }
__device__ __forceinline__ float wave_sum(float v) {
#pragma unroll
    for (int o = 1; o < 64; o <<= 1) v += __shfl_xor(v, o);
    return v;
}

namespace pg8 {
constexpr int BM = 256, BK = 64, HALF = 128, HTB = HALF * BK * 2, NXCD = 8, WGM = 8;
__host__ __device__ __forceinline__ int lds_byte(int r, int c) { const int st = (r >> 4) * 2 + (c >> 5), rr = r & 15, cc = c & 31, ob = rr * 64 + cc * 2; return st * 1024 + (ob ^ (((ob >> 9) & 1) << 5)); }
__host__ __device__ __forceinline__ void stage_rc(int b, int& R, int& C) { const int st = b / 1024, sb = b % 1024, swz = sb ^ (((sb >> 9) & 1) << 5); R = (st >> 1) * 16 + swz / 64; C = (st & 1) * 32 + (swz % 64) / 2; }
__host__ __device__ __forceinline__ int perm32(int rho) { const int n = rho >> 4, i = rho & 15; return 8 * (i >> 2) + 4 * n + (i & 3); }
__host__ __device__ __forceinline__ int perm32inv(int q) { return 16 * ((q >> 2) & 1) + 4 * (q >> 3) + (q & 3); }
struct Unit { int pm, pn; };
struct Gemm { const bf16_t* A; const bf16_t* Bt; int K; };

struct Order {
    int nM, nN, nwg, G, c, nX;
    __device__ void init(int nM_, int nN_, int G_, int c_, int nX_) { nM = nM_; nN = nN_; nwg = nM * nN; G = G_; c = c_; nX = nX_; }
    __device__ bool next(int i, Unit& u) const {
        const int L = i * G + c; if (L >= nwg + nX) return false;
        if (L >= nwg) { const int e = L - nwg; u.pm = nM + (e >> 4); const int q = e & 15; u.pn = q < 8 ? 4 + q : 12 + q; return true; }
        int wgid = L; { const int q = nwg / NXCD, r = nwg % NXCD, xcd = wgid % NXCD, off = wgid / NXCD; wgid = (xcd < r ? xcd * (q + 1) : r * (q + 1) + (xcd - r) * q) + off; }
        const int nig = WGM * nN, gid = wgid / nig, fm = gid * WGM, gsz = (nM - fm) < WGM ? (nM - fm) : WGM;
        u.pm = fm + ((wgid % nig) % gsz); u.pn = (wgid % nig) / gsz; return true;
    }
};

template <class Epi>
__device__ __forceinline__ void gemm_phase(LAS unsigned char* lds, const Gemm g, const Order& S, const Epi& E) {
    int tid = threadIdx.x; asm volatile("" : "+v"(tid));
    const int wid = __builtin_amdgcn_readfirstlane(tid >> 6), lane = tid & 63, wr = wid >> 2, wc = wid & 3, fr = lane & 15, fq = lane >> 4;
    const int K = g.K, nt = K / BK;
    unsigned voffA[2], voffB[2];
#pragma unroll
    for (int i = 0; i < 2; ++i) { int R, C; stage_rc(tid * 16 + i * 8192, R, C); const int Rb = (R & ~31) + perm32(R & 31);
        voffA[i] = (unsigned)(R * K + C) * 2u; voffB[i] = (unsigned)(Rb * K + C) * 2u; }
    const size_t kstep = (size_t)(BK * 2);
    const size_t hstep = (size_t)HALF * K * 2;
    const size_t tstep = 2 * hstep;
    const unsigned ldsw = (unsigned)wid * 1024u;
    const int aoff = lds_byte(wr * 64 + fr, fq * 8), boff = lds_byte(wc * 32 + fr, fq * 8);
#define PG8_SA(b, h) (((b) * 2 + (h)) * HTB)
#define PG8_SB(b, h) ((4 + (b) * 2 + (h)) * HTB)
#define PG8_STAGE(bufoff, gbase, voff) do { _Pragma("unroll") for (int _i = 0; _i < 2; ++_i) \
        __builtin_amdgcn_global_load_lds((const unsigned*)((const char*)(gbase) + (voff)[_i]), (LAS unsigned*)(lds + (bufoff) + ldsw + _i * 8192), 16, 0, 0); } while (0)
#define PG8_LDA(dst, b, h) do { _Pragma("unroll") for (int m = 0; m < 4; ++m) _Pragma("unroll") for (int k = 0; k < 2; ++k) dst[m][k] = *(const LAS bf16x8*)(lds + PG8_SA(b, h) + aoff + m * 2048 + k * 1024); } while (0)
#define PG8_LDB(dst, b, h) do { _Pragma("unroll") for (int n = 0; n < 2; ++n) _Pragma("unroll") for (int k = 0; k < 2; ++k) dst[n][k] = *(const LAS bf16x8*)(lds + PG8_SB(b, h) + boff + n * 2048 + k * 1024); } while (0)
#define PG8_MMA(ai, bj, At, Bt) do { __builtin_amdgcn_s_setprio(1); _Pragma("unroll") for (int m = 0; m < 4; ++m) _Pragma("unroll") for (int n = 0; n < 2; ++n) _Pragma("unroll") for (int k = 0; k < 2; ++k) \
        acc[ai][bj][m][n] = __builtin_amdgcn_mfma_f32_16x16x32_bf16(Bt[n][k], At[m][k], acc[ai][bj][m][n], 0, 0, 0); __builtin_amdgcn_s_setprio(0); } while (0)
#define PG8_WAIT_V(n) asm volatile("s_waitcnt vmcnt(" #n ")" ::: "memory")
#define PG8_WAIT_L(n) asm volatile("s_waitcnt lgkmcnt(" #n ")" ::: "memory")
#define PG8_BAR __builtin_amdgcn_s_barrier()
#define PG8_SCHED __builtin_amdgcn_sched_barrier(0)
    Unit cur, nxt; int ui = 0;
    if (!S.next(0, cur)) return;
    f32x4 acc[2][2][4][2];
#pragma unroll
    for (int a = 0; a < 2; ++a)
#pragma unroll
        for (int b = 0; b < 2; ++b)
#pragma unroll
            for (int m = 0; m < 4; ++m)
#pragma unroll
                for (int n = 0; n < 2; ++n) acc[a][b][m][n] = (f32x4){0.f, 0.f, 0.f, 0.f};
    bf16x8 At[4][2], B0[2][2], B1[2][2];
    const char* cA = (const char*)g.A + (size_t)cur.pm * tstep; const char* cB = (const char*)g.Bt + (size_t)cur.pn * tstep;
    PG8_STAGE(PG8_SB(0, 0), cB, voffB); PG8_STAGE(PG8_SB(0, 1), cB + hstep, voffB); PG8_STAGE(PG8_SA(0, 0), cA, voffA); PG8_STAGE(PG8_SA(0, 1), cA + hstep, voffA);
    if (wr == 1) PG8_BAR;
    PG8_WAIT_V(2); PG8_BAR;
    PG8_STAGE(PG8_SB(1, 0), cB + kstep, voffB); PG8_STAGE(PG8_SA(1, 0), cA + kstep, voffA); PG8_STAGE(PG8_SB(1, 1), cB + hstep + kstep, voffB);
    PG8_WAIT_V(6); PG8_BAR;
    for (;;) {
        const bool has_next = S.next(ui + 1, nxt);
        const char* nA = has_next ? (const char*)g.A + (size_t)nxt.pm * tstep : cA; const char* nB = has_next ? (const char*)g.Bt + (size_t)nxt.pn * tstep : cB;
        for (int t = 0; t < nt; t += 2) {
            const bool last = (t == nt - 2);
            const char* a1 = cA + (size_t)(t + 1) * kstep;
            const char* a2 = last ? nA : cA + (size_t)(t + 2) * kstep; const char* b2 = last ? nB : cB + (size_t)(t + 2) * kstep;
            const char* a3 = a2 + kstep; const char* b3 = b2 + kstep;
            PG8_LDB(B0, 0, 0); PG8_LDB(B1, 0, 1); PG8_SCHED; PG8_LDA(At, 0, 0); PG8_STAGE(PG8_SA(1, 1), a1 + hstep, voffA);
            PG8_WAIT_V(8); PG8_WAIT_L(0); PG8_BAR; PG8_MMA(0, 0, At, B0); PG8_MMA(0, 1, At, B1); PG8_BAR; PG8_SCHED;
            PG8_LDA(At, 0, 1); PG8_STAGE(PG8_SB(0, 0), b2, voffB); PG8_STAGE(PG8_SB(0, 1), b2 + hstep, voffB); PG8_STAGE(PG8_SA(0, 0), a2, voffA);
            PG8_WAIT_V(8); PG8_WAIT_L(0); PG8_BAR; PG8_MMA(1, 0, At, B0); PG8_MMA(1, 1, At, B1); PG8_BAR; PG8_SCHED;
            PG8_LDB(B0, 1, 0); PG8_LDB(B1, 1, 1); PG8_SCHED; PG8_LDA(At, 1, 0); PG8_STAGE(PG8_SA(0, 1), a2 + hstep, voffA);
            PG8_WAIT_V(8); PG8_WAIT_L(0); PG8_BAR; PG8_MMA(0, 0, At, B0); PG8_MMA(0, 1, At, B1); PG8_BAR; PG8_SCHED;
            PG8_LDA(At, 1, 1); PG8_STAGE(PG8_SB(1, 0), b3, voffB); PG8_STAGE(PG8_SB(1, 1), b3 + hstep, voffB); PG8_STAGE(PG8_SA(1, 0), a3, voffA);
            PG8_WAIT_V(8); PG8_WAIT_L(0); PG8_BAR; PG8_MMA(1, 0, At, B0); PG8_MMA(1, 1, At, B1); PG8_BAR; PG8_SCHED;
        }
        if (wr == 0) PG8_BAR;
        E(acc, cur, wr, wc, fr, fq);
        if (!has_next) break;
#pragma unroll
        for (int a = 0; a < 2; ++a)
#pragma unroll
            for (int b = 0; b < 2; ++b)
#pragma unroll
                for (int m = 0; m < 4; ++m)
#pragma unroll
                    for (int n = 0; n < 2; ++n) acc[a][b][m][n] = (f32x4){0.f, 0.f, 0.f, 0.f};
        cur = nxt; cA = nA; cB = nB; ++ui;
        if (wr == 1) PG8_BAR;
    }
    PG8_WAIT_V(0);
    PG8_BAR;
#undef PG8_SA
#undef PG8_SB
#undef PG8_STAGE
#undef PG8_LDA
#undef PG8_LDB
#undef PG8_MMA
#undef PG8_WAIT_V
#undef PG8_WAIT_L
#undef PG8_BAR
#undef PG8_SCHED
}
}

struct EpiIn {
    static constexpr bool PERM = true;
    bf16_t *QA, *KA, *VA, *QB, *KB, *VB, *G; const float* rope;
    __device__ __forceinline__ void operator()(const f32x4 (&acc)[2][2][4][2], const pg8::Unit& u, int wr, int wc, int fr, int fq) const {
        const int type = u.pn >> 2, hb = (u.pn & 3) * 2;
        const bool isctx = u.pm >= 128;
        const int b = isctx ? u.pm - 128 : (u.pm >> 5);
        const int sbase = (isctx ? SEQ : (u.pm & 31) * 256) + wr * 64 + fr;
        const int dcol = wc * 32 + 8 * fq;
        if (type == 3 || type == 7) {
            bf16_t* gp = G + ((size_t)b * SEQ + sbase) * DM + (type == 7 ? 1024 : 0) + hb * 128 + dcol;
#pragma unroll
            for (int ai = 0; ai < 2; ++ai)
#pragma unroll
                for (int m = 0; m < 4; ++m)
#pragma unroll
                    for (int bj = 0; bj < 2; ++bj) {
                        const f32x4 v0 = acc[ai][bj][m][0], v1 = acc[ai][bj][m][1];
                        u32x4 w; w.x = cvtpk(silu_f(v0[0]), silu_f(v0[1])); w.y = cvtpk(silu_f(v0[2]), silu_f(v0[3]));
                        w.z = cvtpk(silu_f(v1[0]), silu_f(v1[1])); w.w = cvtpk(silu_f(v1[2]), silu_f(v1[3]));
                        *(u32x4*)(gp + (size_t)(ai * 128 + m * 16) * DM + bj * 128) = w;
                    }
            return;
        }
        bf16_t* base; int SK; float sc = 1.f;
        switch (type) {
            case 0: base = QA; SK = SEQ; sc = C2A; break;
            case 1: base = KA; SK = SKV; break;
            case 2: base = VA; SK = SKV; break;
            case 4: base = QB; SK = SEQ; sc = C2B; break;
            case 5: base = KB; SK = SKV; break;
            default: base = VB; SK = SKV; break;
        }
        const bool dorope = (type <= 1) && !isctx;
        bf16_t* op = base + ((size_t)(b * 8 + hb) * SK + sbase) * 128 + dcol;
        const size_t hstride = (size_t)SK * 128;
#pragma unroll
        for (int ai = 0; ai < 2; ++ai)
#pragma unroll
            for (int m = 0; m < 4; ++m) {
                f32x4 cs0 = {1.f, 0.f, 1.f, 0.f}, cs1 = {1.f, 0.f, 1.f, 0.f};
                if (dorope) { const int s = sbase + ai * 128 + m * 16; const int pos = (wc & 1) ? (s & 63) : (s >> 6);
                    const f32x4* rp = (const f32x4*)(rope + (size_t)(pos * 16 + 4 * fq) * 2); cs0 = rp[0]; cs1 = rp[1]; }
#pragma unroll
                for (int bj = 0; bj < 2; ++bj) {
                    const f32x4 x1 = acc[ai][bj][m][0], x2 = acc[ai][bj][m][1];
                    f32x4 y1, y2;
                    y1[0] = x1[0] * cs0[0] - x2[0] * cs0[1]; y2[0] = x2[0] * cs0[0] + x1[0] * cs0[1];
                    y1[1] = x1[1] * cs0[2] - x2[1] * cs0[3]; y2[1] = x2[1] * cs0[2] + x1[1] * cs0[3];
                    y1[2] = x1[2] * cs1[0] - x2[2] * cs1[1]; y2[2] = x2[2] * cs1[0] + x1[2] * cs1[1];
                    y1[3] = x1[3] * cs1[2] - x2[3] * cs1[3]; y2[3] = x2[3] * cs1[2] + x1[3] * cs1[3];
                    y1 = y1 * sc; y2 = y2 * sc;
                    u32x4 w; w.x = cvtpk(y1[0], y1[1]); w.y = cvtpk(y1[2], y1[3]); w.z = cvtpk(y2[0], y2[1]); w.w = cvtpk(y2[2], y2[3]);
                    *(u32x4*)(op + (size_t)(ai * 128 + m * 16) * 128 + bj * hstride) = w;
                }
            }
    }
};
struct EpiOut {
    static constexpr bool PERM = true;
    const float* x; const float* mod; float* out;
    __device__ __forceinline__ void operator()(const f32x4 (&acc)[2][2][4][2], const pg8::Unit& u, int wr, int wc, int fr, int fq) const {
        const int row0 = u.pm * 256 + wr * 64 + fr, b = u.pm >> 5, col0 = u.pn * 256 + wc * 32 + 8 * fq;
        f32x4 gv[2][2];
#pragma unroll
        for (int bj = 0; bj < 2; ++bj)
#pragma unroll
            for (int n = 0; n < 2; ++n) gv[bj][n] = *(const f32x4*)(mod + b * 6144 + 4096 + col0 + bj * 128 + 4 * n);
#pragma unroll
        for (int ai = 0; ai < 2; ++ai)
#pragma unroll
            for (int m = 0; m < 4; ++m) {
                const size_t ro = (size_t)(row0 + ai * 128 + m * 16) * DM + col0;
#pragma unroll
                for (int bj = 0; bj < 2; ++bj) {
                    const f32x4 x0 = *(const f32x4*)(x + ro + bj * 128), x1 = *(const f32x4*)(x + ro + bj * 128 + 4);
                    *(f32x4*)(out + ro + bj * 128) = x0 + gv[bj][0] * acc[ai][bj][m][0];
                    *(f32x4*)(out + ro + bj * 128 + 4) = x1 + gv[bj][1] * acc[ai][bj][m][1];
                }
            }
    }
};

#define KSWZ(row, colB) ((row) * 256 + ((colB) ^ (((row) & 7) << 4)))
#define SBAR() __builtin_amdgcn_sched_barrier(0)
__device__ __forceinline__ int crow(int r, int hi) { return (r & 3) + 8 * (r >> 2) + 4 * hi; }
__device__ __forceinline__ int v_st(int k, int c) { const int kk = (k & ~0xC) | ((k & 4) << 1) | ((k & 8) >> 1); return ((kk >> 3) * 4 + (c >> 5)) * 512 + ((kk & 7) * 32 + (c & 31)) * 2; }
__device__ __forceinline__ int v_rd_base(int lane) { return ((lane & 3) << 3) | (((lane >> 2) & 3) << 6) | (((lane >> 4) & 1) << 5) | (((lane >> 5) & 1) << 8); }
constexpr int v_rd_off(int d0, int ks, int half) { return d0 * 512 + ks * 4096 + half * 2048; }
template <int OFF> __device__ __forceinline__ s16x4 tr_read(int vb) {
    s16x4 r; asm volatile("ds_read_b64_tr_b16 %0, %1 offset:%2" : "=&v"(r) : "v"(vb), "i"(OFF) : "memory"); return r;
}
template <int D0> __device__ __forceinline__ void pv_one(f32x16& od, int vb, bf16x8 pa0, bf16x8 pa1, bf16x8 pa2, bf16x8 pa3) {
    const s16x4 l0 = tr_read<v_rd_off(D0, 0, 0)>(vb), h0 = tr_read<v_rd_off(D0, 0, 1)>(vb), l1 = tr_read<v_rd_off(D0, 1, 0)>(vb), h1 = tr_read<v_rd_off(D0, 1, 1)>(vb);
    const s16x4 l2 = tr_read<v_rd_off(D0, 2, 0)>(vb), h2 = tr_read<v_rd_off(D0, 2, 1)>(vb), l3 = tr_read<v_rd_off(D0, 3, 0)>(vb), h3 = tr_read<v_rd_off(D0, 3, 1)>(vb);
    asm volatile("s_waitcnt lgkmcnt(0)" ::: "memory"); SBAR();
#define PK(L, H) (bf16x8){L[0], L[1], L[2], L[3], H[0], H[1], H[2], H[3]}
    od = __builtin_amdgcn_mfma_f32_32x32x16_bf16(pa0, PK(l0, h0), od, 0, 0, 0);
    od = __builtin_amdgcn_mfma_f32_32x32x16_bf16(pa1, PK(l1, h1), od, 0, 0, 0);
    od = __builtin_amdgcn_mfma_f32_32x32x16_bf16(pa2, PK(l2, h2), od, 0, 0, 0);
    od = __builtin_amdgcn_mfma_f32_32x32x16_bf16(pa3, PK(l3, h3), od, 0, 0, 0);
#undef PK
}

template <int NMAP, int D0> __device__ __forceinline__ void pv_all(f32x16 (&o)[NMAP][4], int vb, const bf16x8 (&pa)[NMAP][4]) {
    const s16x4 l0 = tr_read<v_rd_off(D0, 0, 0)>(vb), h0 = tr_read<v_rd_off(D0, 0, 1)>(vb), l1 = tr_read<v_rd_off(D0, 1, 0)>(vb), h1 = tr_read<v_rd_off(D0, 1, 1)>(vb);
    const s16x4 l2 = tr_read<v_rd_off(D0, 2, 0)>(vb), h2 = tr_read<v_rd_off(D0, 2, 1)>(vb), l3 = tr_read<v_rd_off(D0, 3, 0)>(vb), h3 = tr_read<v_rd_off(D0, 3, 1)>(vb);
    asm volatile("s_waitcnt lgkmcnt(0)" ::: "memory"); SBAR();
#define PK(L, H) (bf16x8){L[0], L[1], L[2], L[3], H[0], H[1], H[2], H[3]}
    const bf16x8 v0 = PK(l0, h0), v1 = PK(l1, h1), v2 = PK(l2, h2), v3 = PK(l3, h3);
#undef PK
#pragma unroll
    for (int mp = 0; mp < NMAP; ++mp) o[mp][D0] = __builtin_amdgcn_mfma_f32_32x32x16_bf16(pa[mp][0], v0, o[mp][D0], 0, 0, 0);
#pragma unroll
    for (int mp = 0; mp < NMAP; ++mp) o[mp][D0] = __builtin_amdgcn_mfma_f32_32x32x16_bf16(pa[mp][1], v1, o[mp][D0], 0, 0, 0);
#pragma unroll
    for (int mp = 0; mp < NMAP; ++mp) o[mp][D0] = __builtin_amdgcn_mfma_f32_32x32x16_bf16(pa[mp][2], v2, o[mp][D0], 0, 0, 0);
#pragma unroll
    for (int mp = 0; mp < NMAP; ++mp) o[mp][D0] = __builtin_amdgcn_mfma_f32_32x32x16_bf16(pa[mp][3], v3, o[mp][D0], 0, 0, 0);
}

struct AttnP { const bf16_t *QA, *KA, *VA, *QB, *KB, *VB, *G; bf16_t* MIX; const float *subln_g, *rpb, *lam; };

template <int MODE, bool FAST>
__device__ __forceinline__ int attn_item(const AttnP& a, int b, int h, int blk, char* lds) {
    constexpr int NMAP = MODE == 0 ? 2 : 1, KD0 = MODE == 0 ? 4 : 8, NT = MODE == 0 ? SKV / 64 : 16;
    constexpr float THR = 8.f;
    int tid = threadIdx.x; asm volatile("" : "+v"(tid));
    const int wid = __builtin_amdgcn_readfirstlane(tid >> 6), lane = tid & 63, r32 = lane & 31, hi = lane >> 5;
    char* V_lds = lds; char* K_lds = lds + 32768;
    float* wsf = (float*)(lds + 65536) + wid * 64;
    float* rpbz = (float*)(lds + 65536 + 2048);
    float* rpbs = rpbz + 128;
    char* Qw = lds + 70656 + wid * 8192;
    const size_t bh = (size_t)(b * 8 + h);
    const int qrow = 4 * blk + (wid >> 1), half = wid & 1;
    const int qtok = MODE == 0 ? blk * 256 + wid * 32 : qrow * 64 + half * 32;
    const int ulo = min(max(4 * blk - 4, 0), 116), r0w = min(max(qrow - 4, 0), 120);
    {
        const bf16_t* Qg = (MODE == 0 ? a.QA : a.QB) + (bh * SEQ + qtok) * 128;
#pragma unroll
        for (int i = 0; i < 8; ++i) { const int row = i * 4 + (lane >> 4), c16 = lane & 15;
            const bf16x8 qv = *(const bf16x8*)(Qg + (size_t)row * 128 + c16 * 8);
            *(bf16x8*)(Qw + KSWZ(row, c16 * 16)) = qv; }
    }
    const char* Kh = (const char*)((MODE == 0 ? a.KA : a.KB) + bh * SKV * 128);
    const char* Vh = (const char*)((MODE == 0 ? a.VA : a.VB) + bh * SKV * 128);
    unsigned voffK, voffV;
    {
        const int krow = 4 * wid + (lane >> 4), kch = (lane & 15) ^ (krow & 7);
        voffK = (unsigned)(krow * 256 + kch * 16);
        const int sub = 2 * wid + (lane >> 5), kk = (sub >> 2) * 8 + ((lane & 31) >> 2), cblk = sub & 3;
        const int kreal = kk;
        voffV = (unsigned)(kreal * 256 + (cblk * 32 + (lane & 3) * 8) * 2);
    }
    const int vb0 = (int)(uintptr_t)V_lds + v_rd_base(lane);
    int koff[4];
#pragma unroll
    for (int i = 0; i < 4; ++i) koff[i] = r32 * 256 + (((2 * i + hi) ^ (r32 & 7)) << 4);
    if (MODE == 1) { for (int i = tid; i < 768; i += 512) { const int k = i - 128; rpbz[i] = (k >= 0 && k < 465) ? a.rpb[h * 465 + k] * LOG2E : 0.f; } }
    f32x16 negm0 = f32x16{}, negm1 = f32x16{};
    if (MODE == 1 && FAST) { const int j = half * 32 + r32, c0 = min(max(j - 8, 0), 48);
#pragma unroll
        for (int r = 0; r < 16; ++r) { const int kc = crow(r, hi); negm0[r] = ((unsigned)(kc - c0) < 16u) ? 0.f : -1e30f; negm1[r] = ((unsigned)(kc + 32 - c0) < 16u) ? 0.f : -1e30f; } }
    f32x16 o[NMAP][4]; float m_reg[NMAP], l_reg[NMAP];
#pragma unroll
    for (int mp = 0; mp < NMAP; ++mp) { m_reg[mp] = -1e30f; l_reg[mp] = 0.f;
#pragma unroll
        for (int d = 0; d < 4; ++d) o[mp][d] = f32x16{}; }
#define TROW(t) (MODE == 0 ? (t) * 64 : ((t) < 4 ? SEQ + (t) * 64 : (ulo + (t) - 4) * 64))
#define STAGE(t, bi) do { const size_t g0_ = (size_t)TROW(t) * 256; _Pragma("unroll") for (int ii_ = 0; ii_ < 2; ++ii_) { \
        __builtin_amdgcn_global_load_lds((const unsigned*)(Kh + g0_ + ii_ * 8192 + voffK), (LAS unsigned*)((LAS unsigned char*)K_lds + (bi) * 16384 + wid * 1024 + ii_ * 8192), 16, 0, 0); \
        __builtin_amdgcn_global_load_lds((const unsigned*)(Vh + g0_ + ii_ * 8192 + voffV), (LAS unsigned*)((LAS unsigned char*)V_lds + (bi) * 16384 + wid * 1024 + ii_ * 8192), 16, 0, 0); } } while (0)
    STAGE(0, 0);
    asm volatile("s_waitcnt vmcnt(0) lgkmcnt(0)" ::: "memory");
    __syncthreads();
#pragma nounroll
    for (int t = 0; t < NT; ++t) {
        const int cur = t & 1;
        if (t + 1 < NT) STAGE(t + 1, cur ^ 1);
        bool active = true; int br = 0;
        if (MODE == 1 && t >= 4) { br = ulo + t - 4; active = (br >= r0w) && (br <= r0w + 7); }
        if (active) {
            const char* Kc = K_lds + cur * 16384; const int vb = vb0 + cur * 16384;
            bf16x8 pa[NMAP][4];
#pragma unroll
            for (int mp = 0; mp < NMAP; ++mp) {
                SBAR();
                f32x16 p0 = f32x16{}, p1 = f32x16{};
                if (MODE == 1 && FAST && t >= 4) { p0 = negm0; p1 = negm1; }
#pragma unroll
                for (int d0 = 0; d0 < KD0; ++d0) { const int dd = (MODE == 0 ? mp * 4 : 0) + d0; const int off = koff[dd & 3] + (dd >> 2) * 128;
                    const bf16x8 k0 = *(const bf16x8*)(Kc + off); const bf16x8 k1 = *(const bf16x8*)(Kc + off + 8192);
                    const bf16x8 qf = *(const bf16x8*)(Qw + off);
                    p0 = __builtin_amdgcn_mfma_f32_32x32x16_bf16(k0, qf, p0, 0, 0, 0);
                    p1 = __builtin_amdgcn_mfma_f32_32x32x16_bf16(k1, qf, p1, 0, 0, 0);
                    if ((d0 & 1) == 1) SBAR(); }
                if (MODE == 1 && FAST && t >= 4) {
                    const float* bp = rpbs + (br - qrow + 7) * 31 + 15 - (half * 32 + r32) + 4 * hi;
#pragma unroll
                    for (int r = 0; r < 16; ++r) { p0[r] += bp[(r & 3) + 8 * (r >> 2)]; p1[r] += bp[32 + (r & 3) + 8 * (r >> 2)]; }
                }
                if (MODE == 1 && !FAST && t >= 4) {
                    const int j = half * 32 + r32, c0 = min(max(j - 8, 0), 48);
                    const float* bp = rpbs + (br - qrow + 7) * 31 + 15 - j;
#pragma unroll
                    for (int r = 0; r < 16; ++r) { const int kc = crow(r, hi); const bool ok = (unsigned)(kc - c0) < 16u; const float bv = bp[ok ? kc : j];
                        p0[r] = ok ? p0[r] + bv : -1e30f; }
#pragma unroll
                    for (int r = 0; r < 16; ++r) { const int kc = 32 + crow(r, hi); const bool ok = (unsigned)(kc - c0) < 16u; const float bv = bp[ok ? kc : j];
                        p1[r] = ok ? p1[r] + bv : -1e30f; }
                }
                float alpha = 1.f;
                if (FAST) {
                    float psa = 0.f, psb = 0.f;
#pragma unroll
                    for (int r = 0; r < 16; ++r) { p0[r] = __builtin_amdgcn_exp2f(p0[r]); psa += p0[r]; }
#pragma unroll
                    for (int r = 0; r < 16; ++r) { p1[r] = __builtin_amdgcn_exp2f(p1[r]); psb += p1[r]; }
                    l_reg[mp] += psa + psb;
                } else {
                float pmax = p0[0];
#pragma unroll
                for (int r = 1; r < 16; ++r) pmax = fmaxf(pmax, p0[r]);
#pragma unroll
                for (int r = 0; r < 16; ++r) pmax = fmaxf(pmax, p1[r]);
                { auto rr = __builtin_amdgcn_permlane32_swap(__float_as_uint(pmax), __float_as_uint(pmax), false, false);
                  pmax = fmaxf(__uint_as_float(rr[0]), __uint_as_float(rr[1])); }
                float mn = m_reg[mp];
                if (!__all(pmax - m_reg[mp] <= THR)) { mn = fmaxf(m_reg[mp], pmax); alpha = __builtin_amdgcn_exp2f(m_reg[mp] - mn); m_reg[mp] = mn; }
                float ps = 0.f;
#pragma unroll
                for (int r = 0; r < 16; ++r) { p0[r] = __builtin_amdgcn_exp2f(p0[r] - mn); ps += p0[r]; }
#pragma unroll
                for (int r = 0; r < 16; ++r) { p1[r] = __builtin_amdgcn_exp2f(p1[r] - mn); ps += p1[r]; }
                { auto rr = __builtin_amdgcn_permlane32_swap(__float_as_uint(ps), __float_as_uint(ps), false, false);
                  ps = __uint_as_float(rr[0]) + __uint_as_float(rr[1]); }
                l_reg[mp] = l_reg[mp] * alpha + ps;
                }
#define PK4(P, BASE, OUT) do { u32x4 w = {cvtpk(P[BASE + 0], P[BASE + 1]), cvtpk(P[BASE + 2], P[BASE + 3]), cvtpk(P[BASE + 4], P[BASE + 5]), cvtpk(P[BASE + 6], P[BASE + 7])}; \
    OUT = *reinterpret_cast<bf16x8*>(&w); } while (0)
                PK4(p0, 0, pa[mp][0]); PK4(p0, 8, pa[mp][1]); PK4(p1, 0, pa[mp][2]); PK4(p1, 8, pa[mp][3]);
#undef PK4
                if (!FAST && __any(alpha < 1.f)) {
                    if (hi == 0) wsf[r32] = alpha;
                    asm volatile("s_waitcnt lgkmcnt(0)" ::: "memory");
#pragma unroll
                    for (int r = 0; r < 16; ++r) { const float al = wsf[crow(r, hi)];
#pragma unroll
                        for (int d = 0; d < 4; ++d) o[mp][d][r] *= al; }
                }
            }
            SBAR();
            pv_all<NMAP, 0>(o, vb, pa); pv_all<NMAP, 1>(o, vb, pa); pv_all<NMAP, 2>(o, vb, pa); pv_all<NMAP, 3>(o, vb, pa);
        }
        asm volatile("s_waitcnt vmcnt(0)" ::: "memory");
        __syncthreads();
    }
#undef TROW
#undef STAGE
    if (FAST) {
        bool bad = false;
#pragma unroll
        for (int mp = 0; mp < NMAP; ++mp) { auto rr = __builtin_amdgcn_permlane32_swap(__float_as_uint(l_reg[mp]), __float_as_uint(l_reg[mp]), false, false);
            l_reg[mp] = __uint_as_float(rr[0]) + __uint_as_float(rr[1]); bad = bad || !(l_reg[mp] <= 1.0e30f); }
        if (lane == 0) rpbz[wid] = __any(bad) ? 1.f : 0.f;
        __syncthreads();
        float anyb = 0.f;
#pragma unroll
        for (int w = 0; w < 8; ++w) anyb += rpbz[w];
        __syncthreads();
        if (anyb != 0.f) return 1;
    }
    const float lam = MODE == 0 ? a.lam[0] : 0.f;
    if (hi == 0) { wsf[r32] = 1.f / l_reg[0]; if (MODE == 0) wsf[32 + r32] = lam / l_reg[NMAP - 1]; }
    asm volatile("s_waitcnt lgkmcnt(0)" ::: "memory");
    const size_t obase = ((size_t)b * SEQ + qtok) * DM + (MODE == 0 ? 0 : 1024) + h * 128 + r32;
    float sg[4];
#pragma unroll
    for (int d = 0; d < 4; ++d) sg[d] = MODE == 0 ? a.subln_g[d * 32 + r32] * 0.8f : 1.f;
#pragma unroll
    for (int r = 0; r < 16; ++r) {
        const int cr = crow(r, hi);
        const float ra = wsf[cr];
        float v[4];
        if (MODE == 0) {
            const float rb = wsf[32 + cr];
            float ss = 0.f;
#pragma unroll
            for (int d = 0; d < 4; ++d) { v[d] = o[0][d][r] * ra - o[NMAP - 1][d][r] * rb; ss += v[d] * v[d]; }
            ss += __shfl_xor(ss, 1); ss += __shfl_xor(ss, 2); ss += __shfl_xor(ss, 4); ss += __shfl_xor(ss, 8); ss += __shfl_xor(ss, 16);
            const float rstd = rsqrtf(ss * (1.f / 128.f) + 1e-5f);
#pragma unroll
            for (int d = 0; d < 4; ++d) v[d] *= rstd * sg[d];
        } else {
#pragma unroll
            for (int d = 0; d < 4; ++d) v[d] = o[0][d][r] * ra;
        }
        const size_t ro = obase + (size_t)cr * DM;
#pragma unroll
        for (int d = 0; d < 4; ++d) { const float gg = bf2f(a.G[ro + d * 32]); a.MIX[ro + d * 32] = (bf16_t)(cvtpk(v[d] * gg, 0.f) & 0xffffu); }
    }
    return 0;
}

struct Params {
    const float *x, *c, *ctx, *c_ctx, *norm_g, *w_mod, *b_mod, *w_in, *w_out, *lq1, *lk1, *lq2, *lk2, *subln_g, *rpb, *final_g;
    float* out; unsigned char* ws;
};

__device__ __forceinline__ void transpose_item(const float* W, int K, int N, bf16_t* WT, LAS float* scr, int item, int lane, int perm_below) {
    const int nblk = N / 32, kb = item / nblk, nb = item % nblk, k0 = 64 * kb, n0 = 32 * nb;
#pragma unroll 8
    for (int i = 0; i < 32; ++i) { const int kk = 2 * i + (lane >> 5); scr[kk * 33 + (lane & 31)] = W[(size_t)(k0 + kk) * N + n0 + (lane & 31)]; }
    asm volatile("s_waitcnt lgkmcnt(0)" ::: "memory");
    const int c = lane & 7; const bool pr = n0 < perm_below;
#pragma unroll
    for (int j = 0; j < 4; ++j) { const int n = (lane >> 3) + 8 * j; const int ns = pr ? pg8::perm32inv(n) : n; const LAS float* s = scr + (8 * c) * 33 + ns;
        u32x4 o; o.x = cvtpk(s[0 * 33], s[1 * 33]); o.y = cvtpk(s[2 * 33], s[3 * 33]); o.z = cvtpk(s[4 * 33], s[5 * 33]); o.w = cvtpk(s[6 * 33], s[7 * 33]);
        *(u32x4*)(WT + (size_t)(n0 + n) * K + k0 + 8 * c) = o; }
    asm volatile("s_waitcnt lgkmcnt(0)" ::: "memory");
}

__global__ void __launch_bounds__(512, 2) fwd_megakernel(Params p) {
    extern __shared__ __attribute__((aligned(16))) unsigned char lds[];
    cg::grid_group grid = cg::this_grid();
    const int bid = blockIdx.x, G = gridDim.x;
#define TIDS() int tid = threadIdx.x; asm volatile("" : "+v"(tid)); const int lane = tid & 63, wid = __builtin_amdgcn_readfirstlane(tid >> 6); (void)lane; (void)wid;
#define WSPTRS() unsigned char* ws = p.ws; asm volatile("" : "+s"(ws)); \
    float* mod = (float*)(ws + WS_MOD); float* lamp = (float*)(ws + WS_LAM); float* rope = (float*)(ws + WS_ROPE); \
    bf16_t* WinT = (bf16_t*)(ws + WS_WIN); bf16_t* WoutT = (bf16_t*)(ws + WS_WOUT); bf16_t* HX = (bf16_t*)(ws + WS_HX); \
    bf16_t* QA = (bf16_t*)(ws + WS_QA); bf16_t* KA = (bf16_t*)(ws + WS_KA); bf16_t* VA = (bf16_t*)(ws + WS_VA); \
    bf16_t* QB = (bf16_t*)(ws + WS_QB); bf16_t* KB = (bf16_t*)(ws + WS_KB); bf16_t* VB = (bf16_t*)(ws + WS_VB); \
    bf16_t* GB = (bf16_t*)(ws + WS_G); bf16_t* MIX = (bf16_t*)(ws + WS_MIX); \
    (void)mod; (void)lamp; (void)rope; (void)WinT; (void)WoutT; (void)HX; (void)QA; (void)KA; (void)VA; (void)QB; (void)KB; (void)VB; (void)GB; (void)MIX;
    { WSPTRS(); TIDS();
    if (bid < 192) {
        const int cgp = bid % 12, kc = bid / 12;
        float* sl = (float*)lds;
        for (int i = tid; i < 640; i += 512) { const int bb = i >> 7, k = kc * 128 + (i & 127); const float v = bb < 4 ? p.c[bb * DM + k] : p.c_ctx[k]; sl[i] = v / (1.f + expf(-v)); }
        __syncthreads();
        const int col = cgp * 512 + tid;
        float a0 = 0.f, a1 = 0.f, a2 = 0.f, a3 = 0.f, a4 = 0.f;
        const float* wp = p.w_mod + (size_t)(kc * 128) * 6144 + col;
#pragma unroll 8
        for (int k = 0; k < 128; ++k) { const float w = wp[(size_t)k * 6144]; a0 += sl[k] * w; a1 += sl[128 + k] * w; a2 += sl[256 + k] * w; a3 += sl[384 + k] * w; a4 += sl[512 + k] * w; }
        if (kc == 0) { const float bm = p.b_mod[col]; a0 += bm; a1 += bm; a2 += bm; a3 += bm; a4 += bm; }
        atomicAdd(mod + col, a0); atomicAdd(mod + 6144 + col, a1); atomicAdd(mod + 2 * 6144 + col, a2); atomicAdd(mod + 3 * 6144 + col, a3); atomicAdd(mod + 4 * 6144 + col, a4);
        __syncthreads();
    } else if (bid < 196) {
        const int idx = (bid - 192) * 512 + tid, pos = idx >> 4, i = idx & 15;
        const float inv = powf(10000.f, -(float)i / 16.f), ang = (float)pos * inv;
        rope[2 * idx] = cosf(ang); rope[2 * idx + 1] = sinf(ang);
    } else if (bid == 196 && wid == 0) {
        const float d1 = wave_sum(p.lq1[lane] * p.lk1[lane]), d2 = wave_sum(p.lq2[lane] * p.lk2[lane]);
        if (lane == 0) lamp[0] = expf(d1) - expf(d2) + 0.2f;
    }
    {
        LAS float* scr = (LAS float*)((LAS unsigned char*)lds + wid * 16384);
        const int gw = bid * 8 + wid, NGW = G * 8;
        constexpr int I_IN = (DM / 64) * (INC / 32), I_OUT = (DM / 64) * (DM / 32);
        for (int it = gw; it < I_IN + I_OUT; it += NGW) {
            if (it < I_IN) transpose_item(p.w_in, DM, INC, WinT, scr, it, lane, 2048);
            else transpose_item(p.w_out, DM, DM, WoutT, scr, it - I_IN, lane, 0);
        }
    }
    }
    grid.sync();

    { WSPTRS(); TIDS();
        const int gw = bid * 8 + wid, NGW = G * 8;
        for (int R = gw; R < NTOK + NCTX; R += NGW) {
            const float* src = R < NTOK ? p.x + (size_t)R * DM : p.ctx + (size_t)(R - NTOK) * DM;
            const float* mr = mod + (R < NTOK ? (R >> 13) : 4) * 6144;
            f32x4 v[8]; float ss = 0.f;
#pragma unroll
            for (int j = 0; j < 8; ++j) { v[j] = *(const f32x4*)(src + j * 256 + lane * 4); ss += (v[j].x * v[j].x + v[j].y * v[j].y) + (v[j].z * v[j].z + v[j].w * v[j].w); }
            const float rstd = rsqrtf(wave_sum(ss) * (1.f / DM) + 1e-6f);
            bf16_t* orow = HX + (size_t)R * DM;
#pragma unroll
            for (int j = 0; j < 8; ++j) { const int k = j * 256 + lane * 4;
                const f32x4 g4 = *(const f32x4*)(p.norm_g + k), sh = *(const f32x4*)(mr + k), sc4 = *(const f32x4*)(mr + 2048 + k);
                const f32x4 y = v[j] * rstd * g4 * (sc4 + 1.f) + sh;
                uint2 w; w.x = cvtpk(y.x, y.y); w.y = cvtpk(y.z, y.w); *(uint2*)(orow + k) = w; }
        }
    }
    grid.sync();

    { WSPTRS();
        pg8::Gemm g{HX, WinT, DM}; pg8::Order S; S.init(NTOK / 256, INC / 256, G, bid, 64);
        EpiIn E{QA, KA, VA, QB, KB, VB, GB, rope};
        pg8::gemm_phase<EpiIn>((LAS unsigned char*)lds, g, S, E);
    }
    grid.sync();

    { WSPTRS();
        AttnP ap{QA, KA, VA, QB, KB, VB, GB, MIX, p.subln_g, p.rpb, lamp};
        unsigned badmask = 0u; int it = 0;
        for (int L = bid; L < 1024; L += G, ++it) { const int xcd = L & 7, rest = L >> 3, blk = rest & 31, bh = xcd + 8 * (rest >> 5);
            if (attn_item<0, true>(ap, bh >> 3, bh & 7, blk, (char*)lds)) badmask |= 1u << (it & 31); }
        badmask = __builtin_amdgcn_readfirstlane(badmask);
        if (badmask) { it = 0;
            for (int L = bid; L < 1024; L += G, ++it) { const int xcd = L & 7, rest = L >> 3, blk = rest & 31, bh = xcd + 8 * (rest >> 5);
                if ((badmask >> (it & 31)) & 1u) attn_item<0, false>(ap, bh >> 3, bh & 7, blk, (char*)lds); } }
    }
    { WSPTRS();
        AttnP ap{QA, KA, VA, QB, KB, VB, GB, MIX, p.subln_g, p.rpb, lamp};
        unsigned badmask = 0u; int it = 0;
        for (int L = bid; L < 1024; L += G, ++it) { const int xcd = L & 7, rest = L >> 3, blk = rest & 31, bh = xcd + 8 * (rest >> 5);
            if (attn_item<1, true>(ap, bh >> 3, bh & 7, blk, (char*)lds)) badmask |= 1u << (it & 31); }
        badmask = __builtin_amdgcn_readfirstlane(badmask);
        if (badmask) { it = 0;
            for (int L = bid; L < 1024; L += G, ++it) { const int xcd = L & 7, rest = L >> 3, blk = rest & 31, bh = xcd + 8 * (rest >> 5);
                if ((badmask >> (it & 31)) & 1u) attn_item<1, false>(ap, bh >> 3, bh & 7, blk, (char*)lds); } }
    }
    grid.sync();

    { WSPTRS();
        pg8::Gemm g{MIX, WoutT, DM}; pg8::Order S; S.init(NTOK / 256, DM / 256, G, bid, 0);
        EpiOut E{p.x, mod, p.out};
        pg8::gemm_phase<EpiOut>((LAS unsigned char*)lds, g, S, E);
    }
    grid.sync();

    { TIDS();
        const int gw = bid * 8 + wid, NGW = G * 8;
        for (int R = gw; R < NTOK; R += NGW) {
            float* row = p.out + (size_t)R * DM;
            f32x4 v[8]; float ss = 0.f;
#pragma unroll
            for (int j = 0; j < 8; ++j) { v[j] = *(const f32x4*)(row + j * 256 + lane * 4); ss += (v[j].x * v[j].x + v[j].y * v[j].y) + (v[j].z * v[j].z + v[j].w * v[j].w); }
            const float rstd = rsqrtf(wave_sum(ss) * (1.f / DM) + 1e-6f);
#pragma unroll
            for (int j = 0; j < 8; ++j) { const int k = j * 256 + lane * 4; const f32x4 g4 = *(const f32x4*)(p.final_g + k); *(f32x4*)(row + k) = v[j] * rstd * g4; }
        }
    }
}

extern "C" void kernel_launch(void* const* d_in, const int* in_sizes, int n_in, void* d_out, int out_size, void* d_ws, size_t ws_size, hipStream_t stream) {
    static int grid_blocks = 0;
    if (grid_blocks == 0) {
        if (n_in != 16 || in_sizes[0] != NTOK * DM || out_size != NTOK * DM || ws_size < WS_END) {
            fprintf(stderr, "kernel_launch: shape mismatch (n_in %d in0 %d out %d ws %zu)\n", n_in, n_in > 0 ? in_sizes[0] : -1, out_size, ws_size); grid_blocks = -1; return; }
        int dev = 0, cus = 0, per_cu = 0;
        hipGetDevice(&dev);
        hipDeviceGetAttribute(&cus, hipDeviceAttributeMultiprocessorCount, dev);
        if (hipFuncSetAttribute((const void*)fwd_megakernel, hipFuncAttributeMaxDynamicSharedMemorySize, LDS_BYTES) != hipSuccess) { fprintf(stderr, "kernel_launch: hipFuncSetAttribute failed\n"); grid_blocks = -1; return; }
        hipOccupancyMaxActiveBlocksPerMultiprocessor(&per_cu, (const void*)fwd_megakernel, 512, LDS_BYTES);
        if (per_cu < 1) { fprintf(stderr, "kernel_launch: occupancy query returned %d\n", per_cu); per_cu = 1; }
        (void)hipGetLastError();
        grid_blocks = cus;
    }
    if (grid_blocks < 0) return;
    hipMemsetAsync((char*)d_ws + WS_MOD, 0, 128 * 1024, stream);
    Params p{};
    p.x = (const float*)d_in[0]; p.c = (const float*)d_in[1]; p.ctx = (const float*)d_in[2]; p.c_ctx = (const float*)d_in[3]; p.norm_g = (const float*)d_in[4];
    p.w_mod = (const float*)d_in[5]; p.b_mod = (const float*)d_in[6]; p.w_in = (const float*)d_in[7]; p.w_out = (const float*)d_in[8];
    p.lq1 = (const float*)d_in[9]; p.lk1 = (const float*)d_in[10]; p.lq2 = (const float*)d_in[11]; p.lk2 = (const float*)d_in[12];
    p.subln_g = (const float*)d_in[13]; p.rpb = (const float*)d_in[14]; p.final_g = (const float*)d_in[15];
    p.out = (float*)d_out; p.ws = (unsigned char*)d_ws;
    void* args[] = {&p};
    hipError_t e = hipLaunchCooperativeKernel((const void*)fwd_megakernel, dim3(grid_blocks), dim3(512), args, LDS_BYTES, stream);
    if (e != hipSuccess) fprintf(stderr, "cooperative launch failed: %s (grid %d)\n", hipGetErrorString(e), grid_blocks);
}
```

```cpp
#include <hip/hip_runtime.h>
#include <hip/hip_cooperative_groups.h>
#include <cstdio>
#include <cstdint>
namespace cg = cooperative_groups;

#define LAS __attribute__((address_space(3)))
typedef unsigned short bf16_t;
typedef short bf16x8 __attribute__((ext_vector_type(8)));
typedef short s16x4 __attribute__((ext_vector_type(4)));
typedef float f32x4 __attribute__((ext_vector_type(4)));
typedef float f32x16 __attribute__((ext_vector_type(16)));
typedef unsigned u32x4 __attribute__((ext_vector_type(4)));

constexpr int DM = 2048, NB = 4, SEQ = 8192, CTX = 256, NTOK = NB * SEQ, NCTX = NB * CTX, INC = 8192, SKV = SEQ + CTX;
constexpr float LOG2E = 1.4426950408889634f;
constexpr float C2A = 0.125f * LOG2E;
constexpr float C2B = 0.08838834764831845f * LOG2E;
constexpr size_t MiB = 1u << 20;
constexpr size_t WS_MOD = 0, WS_LAM = 128 * 1024, WS_ROPE = 192 * 1024, WS_WIN = 1 * MiB, WS_WOUT = 33 * MiB, WS_HX = 48 * MiB;
constexpr size_t WS_QA = 192 * MiB, WS_KA = 256 * MiB, WS_VA = 328 * MiB, WS_QB = 400 * MiB, WS_KB = 464 * MiB, WS_VB = 536 * MiB;
constexpr size_t WS_G = 608 * MiB, WS_MIX = 736 * MiB, WS_XCH = 864 * MiB, WS_END = 866 * MiB;
constexpr int LDS_BYTES = 136192;

__device__ __forceinline__ unsigned cvtpk(float lo, float hi) { unsigned r; asm volatile("v_cvt_pk_bf16_f32 %0, %1, %2" : "=v"(r) : "v"(lo), "v"(hi)); return r; }
__device__ __forceinline__ float bf2f(bf16_t v) { return __uint_as_float((unsigned)v << 16); }
__device__ __forceinline__ float silu_f(float v) { return v * __builtin_amdgcn_rcpf(1.f + __builtin_amdgcn_exp2f(-v * LOG2E)); }
__device__ __forceinline__ float wave_sum(float v) {
#pragma unroll
    for (int o = 1; o < 64; o <<= 1) v += __shfl_xor(v, o);
    return v;
}

namespace pg8 {
constexpr int BM = 256, BK = 64, HALF = 128, HTB = HALF * BK * 2, NXCD = 8, WGM = 8;
__host__ __device__ __forceinline__ int lds_byte(int r, int c) { const int st = (r >> 4) * 2 + (c >> 5), rr = r & 15, cc = c & 31, ob = rr * 64 + cc * 2; return st * 1024 + (ob ^ (((ob >> 9) & 1) << 5)); }
__host__ __device__ __forceinline__ void stage_rc(int b, int& R, int& C) { const int st = b / 1024, sb = b % 1024, swz = sb ^ (((sb >> 9) & 1) << 5); R = (st >> 1) * 16 + swz / 64; C = (st & 1) * 32 + (swz % 64) / 2; }
__host__ __device__ __forceinline__ int perm32(int rho) { const int n = rho >> 4, i = rho & 15; return 8 * (i >> 2) + 4 * n + (i & 3); }
__host__ __device__ __forceinline__ int perm32inv(int q) { return 16 * ((q >> 2) & 1) + 4 * (q >> 3) + (q & 3); }
struct Unit { int pm, pn; };
struct Gemm { const bf16_t* A; const bf16_t* Bt; int K; };

struct Order {
    int nM, nN, nwg, G, c, nX;
    __device__ void init(int nM_, int nN_, int G_, int c_, int nX_) { nM = nM_; nN = nN_; nwg = nM * nN; G = G_; c = c_; nX = nX_; }
    __device__ bool next(int i, Unit& u) const {
        const int L = i * G + c; if (L >= nwg + nX) return false;
        if (L >= nwg) { const int e = L - nwg; u.pm = nM + (e >> 4); const int q = e & 15; u.pn = q < 8 ? 4 + q : 12 + q; return true; }
        int wgid = L; { const int q = nwg / NXCD, r = nwg % NXCD, xcd = wgid % NXCD, off = wgid / NXCD; wgid = (xcd < r ? xcd * (q + 1) : r * (q + 1) + (xcd - r) * q) + off; }
        const int nig = WGM * nN, gid = wgid / nig, fm = gid * WGM, gsz = (nM - fm) < WGM ? (nM - fm) : WGM;
        u.pm = fm + ((wgid % nig) % gsz); u.pn = (wgid % nig) / gsz; return true;
    }
};

struct OrderPanel { int c; __device__ bool next(int i, Unit& u) const { if (i >= 4) return false; const int xcd = c & 7, j = c >> 3; u.pm = xcd * 4 + (j >> 3) + 32 * i; u.pn = j & 7; return true; } };

template <class Epi, class Sched>
__device__ __forceinline__ void gemm_phase(LAS unsigned char* lds, const Gemm g, const Sched& S, const Epi& E) {
    int tid = threadIdx.x; asm volatile("" : "+v"(tid));
    const int wid = __builtin_amdgcn_readfirstlane(tid >> 6), lane = tid & 63, wr = wid >> 2, wc = wid & 3, fr = lane & 15, fq = lane >> 4;
    const int K = g.K, nt = K / BK;
    unsigned voffA[2], voffB[2];
#pragma unroll
    for (int i = 0; i < 2; ++i) { int R, C; stage_rc(tid * 16 + i * 8192, R, C); const int Rb = (R & ~31) + perm32(R & 31);
        voffA[i] = (unsigned)(R * K + C) * 2u; voffB[i] = (unsigned)(Rb * K + C) * 2u; }
    const size_t kstep = (size_t)(BK * 2);
    const size_t hstep = (size_t)HALF * K * 2;
    const size_t tstep = 2 * hstep;
    const unsigned ldsw = (unsigned)wid * 1024u;
    const int aoff = lds_byte(wr * 64 + fr, fq * 8), boff = lds_byte(wc * 32 + fr, fq * 8);
#define PG8_SA(b, h) (((b) * 2 + (h)) * HTB)
#define PG8_SB(b, h) ((4 + (b) * 2 + (h)) * HTB)
#define PG8_STAGE(bufoff, gbase, voff) do { _Pragma("unroll") for (int _i = 0; _i < 2; ++_i) \
        __builtin_amdgcn_global_load_lds((const unsigned*)((const char*)(gbase) + (voff)[_i]), (LAS unsigned*)(lds + (bufoff) + ldsw + _i * 8192), 16, 0, 0); } while (0)
#define PG8_LDA(dst, b, h) do { _Pragma("unroll") for (int m = 0; m < 4; ++m) _Pragma("unroll") for (int k = 0; k < 2; ++k) dst[m][k] = *(const LAS bf16x8*)(lds + PG8_SA(b, h) + aoff + m * 2048 + k * 1024); } while (0)
#define PG8_LDB(dst, b, h) do { _Pragma("unroll") for (int n = 0; n < 2; ++n) _Pragma("unroll") for (int k = 0; k < 2; ++k) dst[n][k] = *(const LAS bf16x8*)(lds + PG8_SB(b, h) + boff + n * 2048 + k * 1024); } while (0)
#define PG8_MMA(ai, bj, At, Bt) do { __builtin_amdgcn_s_setprio(1); _Pragma("unroll") for (int m = 0; m < 4; ++m) _Pragma("unroll") for (int n = 0; n < 2; ++n) _Pragma("unroll") for (int k = 0; k < 2; ++k) \
        acc[ai][bj][m][n] = __builtin_amdgcn_mfma_f32_16x16x32_bf16(Bt[n][k], At[m][k], acc[ai][bj][m][n], 0, 0, 0); __builtin_amdgcn_s_setprio(0); } while (0)
#define PG8_WAIT_V(n) asm volatile("s_waitcnt vmcnt(" #n ")" ::: "memory")
#define PG8_WAIT_L(n) asm volatile("s_waitcnt lgkmcnt(" #n ")" ::: "memory")
#define PG8_BAR __builtin_amdgcn_s_barrier()
#define PG8_SCHED __builtin_amdgcn_sched_barrier(0)
    Unit cur, nxt; int ui = 0;
    if (!S.next(0, cur)) return;
    f32x4 acc[2][2][4][2];
#pragma unroll
    for (int a = 0; a < 2; ++a)
#pragma unroll
        for (int b = 0; b < 2; ++b)
#pragma unroll
            for (int m = 0; m < 4; ++m)
#pragma unroll
                for (int n = 0; n < 2; ++n) acc[a][b][m][n] = (f32x4){0.f, 0.f, 0.f, 0.f};
    bf16x8 At[4][2], B0[2][2], B1[2][2];
    const char* cA = (const char*)g.A + (size_t)cur.pm * tstep; const char* cB = (const char*)g.Bt + (size_t)cur.pn * tstep;
    PG8_STAGE(PG8_SB(0, 0), cB, voffB); PG8_STAGE(PG8_SB(0, 1), cB + hstep, voffB); PG8_STAGE(PG8_SA(0, 0), cA, voffA); PG8_STAGE(PG8_SA(0, 1), cA + hstep, voffA);
    if (wr == 1) PG8_BAR;
    PG8_WAIT_V(2); PG8_BAR;
    PG8_STAGE(PG8_SB(1, 0), cB + kstep, voffB); PG8_STAGE(PG8_SA(1, 0), cA + kstep, voffA); PG8_STAGE(PG8_SB(1, 1), cB + hstep + kstep, voffB);
    PG8_WAIT_V(6); PG8_BAR;
    for (;;) {
        const bool has_next = S.next(ui + 1, nxt);
        const char* nA = has_next ? (const char*)g.A + (size_t)nxt.pm * tstep : cA; const char* nB = has_next ? (const char*)g.Bt + (size_t)nxt.pn * tstep : cB;
        for (int t = 0; t < nt; t += 2) {
            const bool last = (t == nt - 2);
            const char* a1 = cA + (size_t)(t + 1) * kstep;
            const char* a2 = last ? nA : cA + (size_t)(t + 2) * kstep; const char* b2 = last ? nB : cB + (size_t)(t + 2) * kstep;
            const char* a3 = a2 + kstep; const char* b3 = b2 + kstep;
            PG8_LDB(B0, 0, 0); PG8_LDB(B1, 0, 1); PG8_SCHED; PG8_LDA(At, 0, 0); PG8_STAGE(PG8_SA(1, 1), a1 + hstep, voffA);
            PG8_WAIT_V(8); PG8_WAIT_L(0); PG8_BAR; PG8_MMA(0, 0, At, B0); PG8_MMA(0, 1, At, B1); PG8_BAR; PG8_SCHED;
            PG8_LDA(At, 0, 1); PG8_STAGE(PG8_SB(0, 0), b2, voffB); PG8_STAGE(PG8_SB(0, 1), b2 + hstep, voffB); PG8_STAGE(PG8_SA(0, 0), a2, voffA);
            PG8_WAIT_V(8); PG8_WAIT_L(0); PG8_BAR; PG8_MMA(1, 0, At, B0); PG8_MMA(1, 1, At, B1); PG8_BAR; PG8_SCHED;
            PG8_LDB(B0, 1, 0); PG8_LDB(B1, 1, 1); PG8_SCHED; PG8_LDA(At, 1, 0); PG8_STAGE(PG8_SA(0, 1), a2 + hstep, voffA);
            PG8_WAIT_V(8); PG8_WAIT_L(0); PG8_BAR; PG8_MMA(0, 0, At, B0); PG8_MMA(0, 1, At, B1); PG8_BAR; PG8_SCHED;
            PG8_LDA(At, 1, 1); PG8_STAGE(PG8_SB(1, 0), b3, voffB); PG8_STAGE(PG8_SB(1, 1), b3 + hstep, voffB); PG8_STAGE(PG8_SA(1, 0), a3, voffA);
            PG8_WAIT_V(8); PG8_WAIT_L(0); PG8_BAR; PG8_MMA(1, 0, At, B0); PG8_MMA(1, 1, At, B1); PG8_BAR; PG8_SCHED;
        }
        if (wr == 0) PG8_BAR;
        E(acc, cur, wr, wc, fr, fq);
        if (!has_next) break;
#pragma unroll
        for (int a = 0; a < 2; ++a)
#pragma unroll
            for (int b = 0; b < 2; ++b)
#pragma unroll
                for (int m = 0; m < 4; ++m)
#pragma unroll
                    for (int n = 0; n < 2; ++n) acc[a][b][m][n] = (f32x4){0.f, 0.f, 0.f, 0.f};
        cur = nxt; cA = nA; cB = nB; ++ui;
        if (wr == 1) PG8_BAR;
    }
    PG8_WAIT_V(0);
    PG8_BAR;
#undef PG8_SA
#undef PG8_SB
#undef PG8_STAGE
#undef PG8_LDA
#undef PG8_LDB
#undef PG8_MMA
#undef PG8_WAIT_V
#undef PG8_WAIT_L
#undef PG8_BAR
#undef PG8_SCHED
}
}

struct EpiIn {
    static constexpr bool PERM = true;
    bf16_t *QA, *KA, *VA, *QB, *KB, *VB, *G; const float* rope;
    __device__ __forceinline__ void operator()(const f32x4 (&acc)[2][2][4][2], const pg8::Unit& u, int wr, int wc, int fr, int fq) const {
        const int type = u.pn >> 2, hb = (u.pn & 3) * 2;
        const bool isctx = u.pm >= 128;
        const int b = isctx ? u.pm - 128 : (u.pm >> 5);
        const int sbase = (isctx ? SEQ : (u.pm & 31) * 256) + wr * 64 + fr;
        const int dcol = wc * 32 + 8 * fq;
        if (type == 3 || type == 7) {
            bf16_t* gp = G + ((size_t)b * SEQ + sbase) * DM + (type == 7 ? 1024 : 0) + hb * 128 + dcol;
#pragma unroll
            for (int ai = 0; ai < 2; ++ai)
#pragma unroll
                for (int m = 0; m < 4; ++m)
#pragma unroll
                    for (int bj = 0; bj < 2; ++bj) {
                        const f32x4 v0 = acc[ai][bj][m][0], v1 = acc[ai][bj][m][1];
                        u32x4 w; w.x = cvtpk(silu_f(v0[0]), silu_f(v0[1])); w.y = cvtpk(silu_f(v0[2]), silu_f(v0[3]));
                        w.z = cvtpk(silu_f(v1[0]), silu_f(v1[1])); w.w = cvtpk(silu_f(v1[2]), silu_f(v1[3]));
                        *(u32x4*)(gp + (size_t)(ai * 128 + m * 16) * DM + bj * 128) = w;
                    }
            return;
        }
        bf16_t* base; int SK; float sc = 1.f;
        switch (type) {
            case 0: base = QA; SK = SEQ; sc = C2A; break;
            case 1: base = KA; SK = SKV; break;
            case 2: base = VA; SK = SKV; break;
            case 4: base = QB; SK = SEQ; sc = C2B; break;
            case 5: base = KB; SK = SKV; break;
            default: base = VB; SK = SKV; break;
        }
        const bool dorope = (type <= 1) && !isctx;
        bf16_t* op = base + ((size_t)(b * 8 + hb) * SK + sbase) * 128 + dcol;
        const size_t hstride = (size_t)SK * 128;
#pragma unroll
        for (int ai = 0; ai < 2; ++ai)
#pragma unroll
            for (int m = 0; m < 4; ++m) {
                f32x4 cs0 = {1.f, 0.f, 1.f, 0.f}, cs1 = {1.f, 0.f, 1.f, 0.f};
                if (dorope) { const int s = sbase + ai * 128 + m * 16; const int pos = (wc & 1) ? (s & 63) : (s >> 6);
                    const f32x4* rp = (const f32x4*)(rope + (size_t)(pos * 16 + 4 * fq) * 2); cs0 = rp[0]; cs1 = rp[1]; }
#pragma unroll
                for (int bj = 0; bj < 2; ++bj) {
                    const f32x4 x1 = acc[ai][bj][m][0], x2 = acc[ai][bj][m][1];
                    f32x4 y1, y2;
                    y1[0] = x1[0] * cs0[0] - x2[0] * cs0[1]; y2[0] = x2[0] * cs0[0] + x1[0] * cs0[1];
                    y1[1] = x1[1] * cs0[2] - x2[1] * cs0[3]; y2[1] = x2[1] * cs0[2] + x1[1] * cs0[3];
                    y1[2] = x1[2] * cs1[0] - x2[2] * cs1[1]; y2[2] = x2[2] * cs1[0] + x1[2] * cs1[1];
                    y1[3] = x1[3] * cs1[2] - x2[3] * cs1[3]; y2[3] = x2[3] * cs1[2] + x1[3] * cs1[3];
                    y1 = y1 * sc; y2 = y2 * sc;
                    u32x4 w; w.x = cvtpk(y1[0], y1[1]); w.y = cvtpk(y1[2], y1[3]); w.z = cvtpk(y2[0], y2[1]); w.w = cvtpk(y2[2], y2[3]);
                    *(u32x4*)(op + (size_t)(ai * 128 + m * 16) * 128 + bj * hstride) = w;
                }
            }
    }
};
struct EpiOutNorm {
    static constexpr bool PERM = true;
    const float* x; const float* mod; const float* fg; float* out; float* X; unsigned* cnt; LAS float* sc;
    __device__ __forceinline__ void operator()(f32x4 (&acc)[2][2][4][2], const pg8::Unit& u, int wr, int wc, int fr, int fq) const {
        const int row0 = u.pm * 256 + wr * 64 + fr, b = u.pm >> 5, col0 = u.pn * 256 + wc * 32 + 8 * fq;
        int tid = threadIdx.x; asm volatile("" : "+v"(tid));
        f32x4 gv[2][2];
#pragma unroll
        for (int bj = 0; bj < 2; ++bj)
#pragma unroll
            for (int n = 0; n < 2; ++n) gv[bj][n] = *(const f32x4*)(mod + b * 6144 + 4096 + col0 + bj * 128 + 4 * n);
#pragma unroll
        for (int ai = 0; ai < 2; ++ai)
#pragma unroll
            for (int m = 0; m < 4; ++m) {
                const size_t ro = (size_t)(row0 + ai * 128 + m * 16) * DM + col0;
                float s = 0.f;
#pragma unroll
                for (int bj = 0; bj < 2; ++bj) {
                    const f32x4 x0 = *(const f32x4*)(x + ro + bj * 128), x1 = *(const f32x4*)(x + ro + bj * 128 + 4);
                    const f32x4 h0 = x0 + gv[bj][0] * acc[ai][bj][m][0], h1 = x1 + gv[bj][1] * acc[ai][bj][m][1];
                    acc[ai][bj][m][0] = h0; acc[ai][bj][m][1] = h1;
                    s += (h0.x * h0.x + h0.y * h0.y) + (h0.z * h0.z + h0.w * h0.w) + (h1.x * h1.x + h1.y * h1.y) + (h1.z * h1.z + h1.w * h1.w);
                }
                s += __shfl_xor(s, 16); s += __shfl_xor(s, 32);
                if (fq == 0) sc[wc * 256 + ai * 128 + wr * 64 + m * 16 + fr] = s;
            }
        asm volatile("s_waitcnt lgkmcnt(0)" ::: "memory"); __builtin_amdgcn_s_barrier(); asm volatile("" ::: "memory");
        if (tid < 256) X[((size_t)u.pm * 8 + u.pn) * 256 + tid] = (sc[tid] + sc[256 + tid]) + (sc[512 + tid] + sc[768 + tid]);
        asm volatile("s_waitcnt vmcnt(0) lgkmcnt(0)" ::: "memory"); __builtin_amdgcn_s_barrier(); asm volatile("" ::: "memory");
        if (tid == 0) {
            unsigned* c = cnt + u.pm * 8;
            __builtin_amdgcn_fence(__ATOMIC_RELEASE, "agent");
            asm volatile("s_waitcnt vmcnt(0) lgkmcnt(0)" ::: "memory");
            __hip_atomic_fetch_add(c, 1u, __ATOMIC_RELAXED, __HIP_MEMORY_SCOPE_AGENT);
            while (__hip_atomic_load(c, __ATOMIC_RELAXED, __HIP_MEMORY_SCOPE_AGENT) < 8u) __builtin_amdgcn_s_sleep(1);
            __builtin_amdgcn_fence(__ATOMIC_ACQUIRE, "agent");
            asm volatile("s_waitcnt vmcnt(0) lgkmcnt(0)" ::: "memory");
        }
        __builtin_amdgcn_s_barrier(); asm volatile("" ::: "memory");
        if (tid < 256) { float t = 0.f;
#pragma unroll
            for (int k = 0; k < 8; ++k) t += __hip_atomic_load(X + ((size_t)u.pm * 8 + k) * 256 + tid, __ATOMIC_RELAXED, __HIP_MEMORY_SCOPE_AGENT);
            sc[1024 + tid] = rsqrtf(t * (1.f / DM) + 1e-6f); }
        asm volatile("s_waitcnt lgkmcnt(0)" ::: "memory"); __builtin_amdgcn_s_barrier(); asm volatile("" ::: "memory");
        f32x4 fv[2][2];
#pragma unroll
        for (int bj = 0; bj < 2; ++bj)
#pragma unroll
            for (int n = 0; n < 2; ++n) fv[bj][n] = *(const f32x4*)(fg + col0 + bj * 128 + 4 * n);
#pragma unroll
        for (int ai = 0; ai < 2; ++ai)
#pragma unroll
            for (int m = 0; m < 4; ++m) {
                const size_t ro = (size_t)(row0 + ai * 128 + m * 16) * DM + col0;
                const float r = sc[1024 + ai * 128 + wr * 64 + m * 16 + fr];
#pragma unroll
                for (int bj = 0; bj < 2; ++bj) {
                    *(f32x4*)(out + ro + bj * 128) = acc[ai][bj][m][0] * r * fv[bj][0];
                    *(f32x4*)(out + ro + bj * 128 + 4) = acc[ai][bj][m][1] * r * fv[bj][1];
                }
            }
    }
};

#define KSWZ(row, colB) ((row) * 256 + ((colB) ^ (((row) & 7) << 4)))
#define SBAR() __builtin_amdgcn_sched_barrier(0)
__device__ __forceinline__ int crow(int r, int hi) { return (r & 3) + 8 * (r >> 2) + 4 * hi; }
__device__ __forceinline__ int v_st(int k, int c) { const int kk = (k & ~0xC) | ((k & 4) << 1) | ((k & 8) >> 1); return ((kk >> 3) * 4 + (c >> 5)) * 512 + ((kk & 7) * 32 + (c & 31)) * 2; }
__device__ __forceinline__ int v_rd_base(int lane) { return ((lane & 3) << 3) | (((lane >> 2) & 3) << 6) | (((lane >> 4) & 1) << 5) | (((lane >> 5) & 1) << 8); }
constexpr int v_rd_off(int d0, int ks, int half) { return d0 * 512 + ks * 4096 + half * 2048; }
template <int OFF> __device__ __forceinline__ s16x4 tr_read(int vb) {
    s16x4 r; asm volatile("ds_read_b64_tr_b16 %0, %1 offset:%2" : "=&v"(r) : "v"(vb), "i"(OFF) : "memory"); return r;
}
template <int D0> __device__ __forceinline__ void pv_one(f32x16& od, int vb, bf16x8 pa0, bf16x8 pa1, bf16x8 pa2, bf16x8 pa3) {
    const s16x4 l0 = tr_read<v_rd_off(D0, 0, 0)>(vb), h0 = tr_read<v_rd_off(D0, 0, 1)>(vb), l1 = tr_read<v_rd_off(D0, 1, 0)>(vb), h1 = tr_read<v_rd_off(D0, 1, 1)>(vb);
    const s16x4 l2 = tr_read<v_rd_off(D0, 2, 0)>(vb), h2 = tr_read<v_rd_off(D0, 2, 1)>(vb), l3 = tr_read<v_rd_off(D0, 3, 0)>(vb), h3 = tr_read<v_rd_off(D0, 3, 1)>(vb);
    asm volatile("s_waitcnt lgkmcnt(0)" ::: "memory"); SBAR();
#define PK(L, H) (bf16x8){L[0], L[1], L[2], L[3], H[0], H[1], H[2], H[3]}
    od = __builtin_amdgcn_mfma_f32_32x32x16_bf16(pa0, PK(l0, h0), od, 0, 0, 0);
    od = __builtin_amdgcn_mfma_f32_32x32x16_bf16(pa1, PK(l1, h1), od, 0, 0, 0);
    od = __builtin_amdgcn_mfma_f32_32x32x16_bf16(pa2, PK(l2, h2), od, 0, 0, 0);
    od = __builtin_amdgcn_mfma_f32_32x32x16_bf16(pa3, PK(l3, h3), od, 0, 0, 0);
#undef PK
}

template <int NMAP, int D0> __device__ __forceinline__ void pv_all(f32x16 (&o)[NMAP][4], int vb, const bf16x8 (&pa)[NMAP][4]) {
    const s16x4 l0 = tr_read<v_rd_off(D0, 0, 0)>(vb), h0 = tr_read<v_rd_off(D0, 0, 1)>(vb), l1 = tr_read<v_rd_off(D0, 1, 0)>(vb), h1 = tr_read<v_rd_off(D0, 1, 1)>(vb);
    const s16x4 l2 = tr_read<v_rd_off(D0, 2, 0)>(vb), h2 = tr_read<v_rd_off(D0, 2, 1)>(vb), l3 = tr_read<v_rd_off(D0, 3, 0)>(vb), h3 = tr_read<v_rd_off(D0, 3, 1)>(vb);
    asm volatile("s_waitcnt lgkmcnt(0)" ::: "memory"); SBAR();
#define PK(L, H) (bf16x8){L[0], L[1], L[2], L[3], H[0], H[1], H[2], H[3]}
    const bf16x8 v0 = PK(l0, h0), v1 = PK(l1, h1), v2 = PK(l2, h2), v3 = PK(l3, h3);
#undef PK
#pragma unroll
    for (int mp = 0; mp < NMAP; ++mp) o[mp][D0] = __builtin_amdgcn_mfma_f32_32x32x16_bf16(pa[mp][0], v0, o[mp][D0], 0, 0, 0);
#pragma unroll
    for (int mp = 0; mp < NMAP; ++mp) o[mp][D0] = __builtin_amdgcn_mfma_f32_32x32x16_bf16(pa[mp][1], v1, o[mp][D0], 0, 0, 0);
#pragma unroll
    for (int mp = 0; mp < NMAP; ++mp) o[mp][D0] = __builtin_amdgcn_mfma_f32_32x32x16_bf16(pa[mp][2], v2, o[mp][D0], 0, 0, 0);
#pragma unroll
    for (int mp = 0; mp < NMAP; ++mp) o[mp][D0] = __builtin_amdgcn_mfma_f32_32x32x16_bf16(pa[mp][3], v3, o[mp][D0], 0, 0, 0);
}

struct AttnP { const bf16_t *QA, *KA, *VA, *QB, *KB, *VB, *G; bf16_t* MIX; const float *subln_g, *rpb, *lam; };

template <int MODE, bool FAST>
__device__ __forceinline__ int attn_item(const AttnP& a, int b, int h, int blk, char* lds) {
    constexpr int NMAP = MODE == 0 ? 2 : 1, KD0 = MODE == 0 ? 4 : 8, NT = MODE == 0 ? SKV / 64 : 16;
    constexpr float THR = 8.f;
    int tid = threadIdx.x; asm volatile("" : "+v"(tid));
    const int wid = __builtin_amdgcn_readfirstlane(tid >> 6), lane = tid & 63, r32 = lane & 31, hi = lane >> 5;
    char* V_lds = lds; char* K_lds = lds + 32768;
    float* wsf = (float*)(lds + 65536) + wid * 64;
    float* rpbz = (float*)(lds + 65536 + 2048);
    float* rpbs = rpbz + 128;
    char* Qw = lds + 70656 + wid * 8192;
    const size_t bh = (size_t)(b * 8 + h);
    const int qrow = 4 * blk + (wid >> 1), half = wid & 1;
    const int qtok = MODE == 0 ? blk * 256 + wid * 32 : qrow * 64 + half * 32;
    const int ulo = min(max(4 * blk - 4, 0), 116), r0w = min(max(qrow - 4, 0), 120);
    {
        const bf16_t* Qg = (MODE == 0 ? a.QA : a.QB) + (bh * SEQ + qtok) * 128;
#pragma unroll
        for (int i = 0; i < 8; ++i) { const int row = i * 4 + (lane >> 4), c16 = lane & 15;
            const bf16x8 qv = *(const bf16x8*)(Qg + (size_t)row * 128 + c16 * 8);
            *(bf16x8*)(Qw + KSWZ(row, c16 * 16)) = qv; }
    }
    const char* Kh = (const char*)((MODE == 0 ? a.KA : a.KB) + bh * SKV * 128);
    const char* Vh = (const char*)((MODE == 0 ? a.VA : a.VB) + bh * SKV * 128);
    unsigned voffK, voffV;
    {
        const int krow = 4 * wid + (lane >> 4), kch = (lane & 15) ^ (krow & 7);
        voffK = (unsigned)(krow * 256 + kch * 16);
        const int sub = 2 * wid + (lane >> 5), kk = (sub >> 2) * 8 + ((lane & 31) >> 2), cblk = sub & 3;
        const int kreal = kk;
        voffV = (unsigned)(kreal * 256 + (cblk * 32 + (lane & 3) * 8) * 2);
    }
    const int vb0 = (int)(uintptr_t)V_lds + v_rd_base(lane);
    int koff[4];
#pragma unroll
    for (int i = 0; i < 4; ++i) koff[i] = r32 * 256 + (((2 * i + hi) ^ (r32 & 7)) << 4);
    if (MODE == 1) { for (int i = tid; i < 768; i += 512) { const int k = i - 128; rpbz[i] = (k >= 0 && k < 465) ? a.rpb[h * 465 + k] * LOG2E : 0.f; } }
    f32x16 negm0 = f32x16{}, negm1 = f32x16{};
    if (MODE == 1 && FAST) { const int j = half * 32 + r32, c0 = min(max(j - 8, 0), 48);
#pragma unroll
        for (int r = 0; r < 16; ++r) { const int kc = crow(r, hi); negm0[r] = ((unsigned)(kc - c0) < 16u) ? 0.f : -1e30f; negm1[r] = ((unsigned)(kc + 32 - c0) < 16u) ? 0.f : -1e30f; } }
    f32x16 o[NMAP][4]; float m_reg[NMAP], l_reg[NMAP];
#pragma unroll
    for (int mp = 0; mp < NMAP; ++mp) { m_reg[mp] = -1e30f; l_reg[mp] = 0.f;
#pragma unroll
        for (int d = 0; d < 4; ++d) o[mp][d] = f32x16{}; }
#define TROW(t) (MODE == 0 ? (t) * 64 : ((t) < 4 ? SEQ + (t) * 64 : (ulo + (t) - 4) * 64))
#define STAGE(t, bi) do { const size_t g0_ = (size_t)TROW(t) * 256; _Pragma("unroll") for (int ii_ = 0; ii_ < 2; ++ii_) { \
        __builtin_amdgcn_global_load_lds((const unsigned*)(Kh + g0_ + ii_ * 8192 + voffK), (LAS unsigned*)((LAS unsigned char*)K_lds + (bi) * 16384 + wid * 1024 + ii_ * 8192), 16, 0, 0); \
        __builtin_amdgcn_global_load_lds((const unsigned*)(Vh + g0_ + ii_ * 8192 + voffV), (LAS unsigned*)((LAS unsigned char*)V_lds + (bi) * 16384 + wid * 1024 + ii_ * 8192), 16, 0, 0); } } while (0)
    STAGE(0, 0);
    asm volatile("s_waitcnt vmcnt(0) lgkmcnt(0)" ::: "memory");
    __syncthreads();
#pragma nounroll
    for (int t = 0; t < NT; ++t) {
        const int cur = t & 1;
        if (t + 1 < NT) STAGE(t + 1, cur ^ 1);
        bool active = true; int br = 0;
        if (MODE == 1 && t >= 4) { br = ulo + t - 4; active = (br >= r0w) && (br <= r0w + 7); }
        if (active) {
            const char* Kc = K_lds + cur * 16384; const int vb = vb0 + cur * 16384;
            bf16x8 pa[NMAP][4];
#pragma unroll
            for (int mp = 0; mp < NMAP; ++mp) {
                SBAR();
                f32x16 p0 = f32x16{}, p1 = f32x16{};
                if (MODE == 1 && FAST && t >= 4) { p0 = negm0; p1 = negm1; }
#pragma unroll
                for (int d0 = 0; d0 < KD0; ++d0) { const int dd = (MODE == 0 ? mp * 4 : 0) + d0; const int off = koff[dd & 3] + (dd >> 2) * 128;
                    const bf16x8 k0 = *(const bf16x8*)(Kc + off); const bf16x8 k1 = *(const bf16x8*)(Kc + off + 8192);
                    const bf16x8 qf = *(const bf16x8*)(Qw + off);
                    p0 = __builtin_amdgcn_mfma_f32_32x32x16_bf16(k0, qf, p0, 0, 0, 0);
                    p1 = __builtin_amdgcn_mfma_f32_32x32x16_bf16(k1, qf, p1, 0, 0, 0);
                    if ((d0 & 1) == 1) SBAR(); }
                if (MODE == 1 && FAST && t >= 4) {
                    const float* bp = rpbs + (br - qrow + 7) * 31 + 15 - (half * 32 + r32) + 4 * hi;
#pragma unroll
                    for (int r = 0; r < 16; ++r) { p0[r] += bp[(r & 3) + 8 * (r >> 2)]; p1[r] += bp[32 + (r & 3) + 8 * (r >> 2)]; }
                }
                if (MODE == 1 && !FAST && t >= 4) {
                    const int j = half * 32 + r32, c0 = min(max(j - 8, 0), 48);
                    const float* bp = rpbs + (br - qrow + 7) * 31 + 15 - j;
#pragma unroll
                    for (int r = 0; r < 16; ++r) { const int kc = crow(r, hi); const bool ok = (unsigned)(kc - c0) < 16u; const float bv = bp[ok ? kc : j];
                        p0[r] = ok ? p0[r] + bv : -1e30f; }
#pragma unroll
                    for (int r = 0; r < 16; ++r) { const int kc = 32 + crow(r, hi); const bool ok = (unsigned)(kc - c0) < 16u; const float bv = bp[ok ? kc : j];
                        p1[r] = ok ? p1[r] + bv : -1e30f; }
                }
                float alpha = 1.f;
                if (FAST) {
                    float psa = 0.f, psb = 0.f;
#pragma unroll
                    for (int r = 0; r < 16; ++r) { p0[r] = __builtin_amdgcn_exp2f(p0[r]); psa += p0[r]; }
#pragma unroll
                    for (int r = 0; r < 16; ++r) { p1[r] = __builtin_amdgcn_exp2f(p1[r]); psb += p1[r]; }
                    l_reg[mp] += psa + psb;
                } else {
                float pmax = p0[0];
#pragma unroll
                for (int r = 1; r < 16; ++r) pmax = fmaxf(pmax, p0[r]);
#pragma unroll
                for (int r = 0; r < 16; ++r) pmax = fmaxf(pmax, p1[r]);
                { auto rr = __builtin_amdgcn_permlane32_swap(__float_as_uint(pmax), __float_as_uint(pmax), false, false);
                  pmax = fmaxf(__uint_as_float(rr[0]), __uint_as_float(rr[1])); }
                float mn = m_reg[mp];
                if (!__all(pmax - m_reg[mp] <= THR)) { mn = fmaxf(m_reg[mp], pmax); alpha = __builtin_amdgcn_exp2f(m_reg[mp] - mn); m_reg[mp] = mn; }
                float ps = 0.f;
#pragma unroll
                for (int r = 0; r < 16; ++r) { p0[r] = __builtin_amdgcn_exp2f(p0[r] - mn); ps += p0[r]; }
#pragma unroll
                for (int r = 0; r < 16; ++r) { p1[r] = __builtin_amdgcn_exp2f(p1[r] - mn); ps += p1[r]; }
                { auto rr = __builtin_amdgcn_permlane32_swap(__float_as_uint(ps), __float_as_uint(ps), false, false);
                  ps = __uint_as_float(rr[0]) + __uint_as_float(rr[1]); }
                l_reg[mp] = l_reg[mp] * alpha + ps;
                }
#define PK4(P, BASE, OUT) do { u32x4 w = {cvtpk(P[BASE + 0], P[BASE + 1]), cvtpk(P[BASE + 2], P[BASE + 3]), cvtpk(P[BASE + 4], P[BASE + 5]), cvtpk(P[BASE + 6], P[BASE + 7])}; \
    OUT = *reinterpret_cast<bf16x8*>(&w); } while (0)
                PK4(p0, 0, pa[mp][0]); PK4(p0, 8, pa[mp][1]); PK4(p1, 0, pa[mp][2]); PK4(p1, 8, pa[mp][3]);
#undef PK4
                if (!FAST && __any(alpha < 1.f)) {
                    if (hi == 0) wsf[r32] = alpha;
                    asm volatile("s_waitcnt lgkmcnt(0)" ::: "memory");
#pragma unroll
                    for (int r = 0; r < 16; ++r) { const float al = wsf[crow(r, hi)];
#pragma unroll
                        for (int d = 0; d < 4; ++d) o[mp][d][r] *= al; }
                }
            }
            SBAR();
            pv_all<NMAP, 0>(o, vb, pa); pv_all<NMAP, 1>(o, vb, pa); pv_all<NMAP, 2>(o, vb, pa); pv_all<NMAP, 3>(o, vb, pa);
        }
        asm volatile("s_waitcnt vmcnt(0)" ::: "memory");
        __syncthreads();
    }
#undef TROW
#undef STAGE
    if (FAST) {
        bool bad = false;
#pragma unroll
        for (int mp = 0; mp < NMAP; ++mp) { auto rr = __builtin_amdgcn_permlane32_swap(__float_as_uint(l_reg[mp]), __float_as_uint(l_reg[mp]), false, false);
            l_reg[mp] = __uint_as_float(rr[0]) + __uint_as_float(rr[1]); bad = bad || !(l_reg[mp] <= 1.0e30f); }
        if (lane == 0) rpbz[wid] = __any(bad) ? 1.f : 0.f;
        __syncthreads();
        float anyb = 0.f;
#pragma unroll
        for (int w = 0; w < 8; ++w) anyb += rpbz[w];
        __syncthreads();
        if (anyb != 0.f) return 1;
    }
    const float lam = MODE == 0 ? a.lam[0] : 0.f;
    if (hi == 0) { wsf[r32] = 1.f / l_reg[0]; if (MODE == 0) wsf[32 + r32] = lam / l_reg[NMAP - 1]; }
    asm volatile("s_waitcnt lgkmcnt(0)" ::: "memory");
    const size_t obase = ((size_t)b * SEQ + qtok) * DM + (MODE == 0 ? 0 : 1024) + h * 128 + r32;
    float sg[4];
#pragma unroll
    for (int d = 0; d < 4; ++d) sg[d] = MODE == 0 ? a.subln_g[d * 32 + r32] * 0.8f : 1.f;
#pragma unroll
    for (int r = 0; r < 16; ++r) {
        const int cr = crow(r, hi);
        const float ra = wsf[cr];
        float v[4];
        if (MODE == 0) {
            const float rb = wsf[32 + cr];
            float ss = 0.f;
#pragma unroll
            for (int d = 0; d < 4; ++d) { v[d] = o[0][d][r] * ra - o[NMAP - 1][d][r] * rb; ss += v[d] * v[d]; }
            ss += __shfl_xor(ss, 1); ss += __shfl_xor(ss, 2); ss += __shfl_xor(ss, 4); ss += __shfl_xor(ss, 8); ss += __shfl_xor(ss, 16);
            const float rstd = rsqrtf(ss * (1.f / 128.f) + 1e-5f);
#pragma unroll
            for (int d = 0; d < 4; ++d) v[d] *= rstd * sg[d];
        } else {
#pragma unroll
            for (int d = 0; d < 4; ++d) v[d] = o[0][d][r] * ra;
        }
        const size_t ro = obase + (size_t)cr * DM;
#pragma unroll
        for (int d = 0; d < 4; ++d) { const float gg = bf2f(a.G[ro + d * 32]); a.MIX[ro + d * 32] = (bf16_t)(cvtpk(v[d] * gg, 0.f) & 0xffffu); }
    }
    return 0;
}

struct Params {
    const float *x, *c, *ctx, *c_ctx, *norm_g, *w_mod, *b_mod, *w_in, *w_out, *lq1, *lk1, *lq2, *lk2, *subln_g, *rpb, *final_g;
    float* out; unsigned char* ws;
};

__device__ __forceinline__ void transpose_item(const float* W, int K, int N, bf16_t* WT, LAS float* scr, int item, int lane, int perm_below) {
    const int nblk = N / 32, kb = item / nblk, nb = item % nblk, k0 = 64 * kb, n0 = 32 * nb;
#pragma unroll 8
    for (int i = 0; i < 32; ++i) { const int kk = 2 * i + (lane >> 5); scr[kk * 33 + (lane & 31)] = W[(size_t)(k0 + kk) * N + n0 + (lane & 31)]; }
    asm volatile("s_waitcnt lgkmcnt(0)" ::: "memory");
    const int c = lane & 7; const bool pr = n0 < perm_below;
#pragma unroll
    for (int j = 0; j < 4; ++j) { const int n = (lane >> 3) + 8 * j; const int ns = pr ? pg8::perm32inv(n) : n; const LAS float* s = scr + (8 * c) * 33 + ns;
        u32x4 o; o.x = cvtpk(s[0 * 33], s[1 * 33]); o.y = cvtpk(s[2 * 33], s[3 * 33]); o.z = cvtpk(s[4 * 33], s[5 * 33]); o.w = cvtpk(s[6 * 33], s[7 * 33]);
        *(u32x4*)(WT + (size_t)(n0 + n) * K + k0 + 8 * c) = o; }
    asm volatile("s_waitcnt lgkmcnt(0)" ::: "memory");
}

__global__ void __launch_bounds__(512, 2) fwd_megakernel(Params p) {
    extern __shared__ __attribute__((aligned(16))) unsigned char lds[];
    cg::grid_group grid = cg::this_grid();
    const int bid = blockIdx.x, G = gridDim.x;
#define TIDS() int tid = threadIdx.x; asm volatile("" : "+v"(tid)); const int lane = tid & 63, wid = __builtin_amdgcn_readfirstlane(tid >> 6); (void)lane; (void)wid;
#define WSPTRS() unsigned char* ws = p.ws; asm volatile("" : "+s"(ws)); \
    float* mod = (float*)(ws + WS_MOD); float* lamp = (float*)(ws + WS_LAM); float* rope = (float*)(ws + WS_ROPE); \
    bf16_t* WinT = (bf16_t*)(ws + WS_WIN); bf16_t* WoutT = (bf16_t*)(ws + WS_WOUT); bf16_t* HX = (bf16_t*)(ws + WS_HX); \
    bf16_t* QA = (bf16_t*)(ws + WS_QA); bf16_t* KA = (bf16_t*)(ws + WS_KA); bf16_t* VA = (bf16_t*)(ws + WS_VA); \
    bf16_t* QB = (bf16_t*)(ws + WS_QB); bf16_t* KB = (bf16_t*)(ws + WS_KB); bf16_t* VB = (bf16_t*)(ws + WS_VB); \
    bf16_t* GB = (bf16_t*)(ws + WS_G); bf16_t* MIX = (bf16_t*)(ws + WS_MIX); \
    (void)mod; (void)lamp; (void)rope; (void)WinT; (void)WoutT; (void)HX; (void)QA; (void)KA; (void)VA; (void)QB; (void)KB; (void)VB; (void)GB; (void)MIX;
    { WSPTRS(); TIDS();
    if (bid < 192) {
        const int cgp = bid % 12, kc = bid / 12;
        float* sl = (float*)lds;
        for (int i = tid; i < 640; i += 512) { const int bb = i >> 7, k = kc * 128 + (i & 127); const float v = bb < 4 ? p.c[bb * DM + k] : p.c_ctx[k]; sl[i] = v / (1.f + expf(-v)); }
        __syncthreads();
        const int col = cgp * 512 + tid;
        float a0 = 0.f, a1 = 0.f, a2 = 0.f, a3 = 0.f, a4 = 0.f;
        const float* wp = p.w_mod + (size_t)(kc * 128) * 6144 + col;
#pragma unroll 8
        for (int k = 0; k < 128; ++k) { const float w = wp[(size_t)k * 6144]; a0 += sl[k] * w; a1 += sl[128 + k] * w; a2 += sl[256 + k] * w; a3 += sl[384 + k] * w; a4 += sl[512 + k] * w; }
        if (kc == 0) { const float bm = p.b_mod[col]; a0 += bm; a1 += bm; a2 += bm; a3 += bm; a4 += bm; }
        atomicAdd(mod + col, a0); atomicAdd(mod + 6144 + col, a1); atomicAdd(mod + 2 * 6144 + col, a2); atomicAdd(mod + 3 * 6144 + col, a3); atomicAdd(mod + 4 * 6144 + col, a4);
        __syncthreads();
    } else if (bid < 196) {
        const int idx = (bid - 192) * 512 + tid, pos = idx >> 4, i = idx & 15;
        const float inv = powf(10000.f, -(float)i / 16.f), ang = (float)pos * inv;
        rope[2 * idx] = cosf(ang); rope[2 * idx + 1] = sinf(ang);
    } else if (bid == 196 && wid == 0) {
        const float d1 = wave_sum(p.lq1[lane] * p.lk1[lane]), d2 = wave_sum(p.lq2[lane] * p.lk2[lane]);
        if (lane == 0) lamp[0] = expf(d1) - expf(d2) + 0.2f;
    }
    {
        LAS float* scr = (LAS float*)((LAS unsigned char*)lds + wid * 16384);
        const int gw = bid * 8 + wid, NGW = G * 8;
        constexpr int I_IN = (DM / 64) * (INC / 32), I_OUT = (DM / 64) * (DM / 32);
        for (int it = gw; it < I_IN + I_OUT; it += NGW) {
            if (it < I_IN) transpose_item(p.w_in, DM, INC, WinT, scr, it, lane, 2048);
            else transpose_item(p.w_out, DM, DM, WoutT, scr, it - I_IN, lane, 0);
        }
    }
    }
    grid.sync();

    { WSPTRS(); TIDS();
        const int gw = bid * 8 + wid, NGW = G * 8;
        for (int R = gw; R < NTOK + NCTX; R += NGW) {
            const float* src = R < NTOK ? p.x + (size_t)R * DM : p.ctx + (size_t)(R - NTOK) * DM;
            const float* mr = mod + (R < NTOK ? (R >> 13) : 4) * 6144;
            f32x4 v[8]; float ss = 0.f;
#pragma unroll
            for (int j = 0; j < 8; ++j) { v[j] = *(const f32x4*)(src + j * 256 + lane * 4); ss += (v[j].x * v[j].x + v[j].y * v[j].y) + (v[j].z * v[j].z + v[j].w * v[j].w); }
            const float rstd = rsqrtf(wave_sum(ss) * (1.f / DM) + 1e-6f);
            bf16_t* orow = HX + (size_t)R * DM;
#pragma unroll
            for (int j = 0; j < 8; ++j) { const int k = j * 256 + lane * 4;
                const f32x4 g4 = *(const f32x4*)(p.norm_g + k), sh = *(const f32x4*)(mr + k), sc4 = *(const f32x4*)(mr + 2048 + k);
                const f32x4 y = v[j] * rstd * g4 * (sc4 + 1.f) + sh;
                uint2 w; w.x = cvtpk(y.x, y.y); w.y = cvtpk(y.z, y.w); *(uint2*)(orow + k) = w; }
        }
    }
    grid.sync();

    { WSPTRS();
        pg8::Gemm g{HX, WinT, DM}; pg8::Order S; S.init(NTOK / 256, INC / 256, G, bid, 64);
        EpiIn E{QA, KA, VA, QB, KB, VB, GB, rope};
        pg8::gemm_phase<EpiIn, pg8::Order>((LAS unsigned char*)lds, g, S, E);
    }
    grid.sync();

    { WSPTRS();
        AttnP ap{QA, KA, VA, QB, KB, VB, GB, MIX, p.subln_g, p.rpb, lamp};
        unsigned badmask = 0u; int it = 0;
        for (int L = bid; L < 1024; L += G, ++it) { const int xcd = L & 7, rest = L >> 3, blk = rest & 31, bh = xcd + 8 * (rest >> 5);
            if (attn_item<0, true>(ap, bh >> 3, bh & 7, blk, (char*)lds)) badmask |= 1u << (it & 31); }
        badmask = __builtin_amdgcn_readfirstlane(badmask);
        if (badmask) { it = 0;
            for (int L = bid; L < 1024; L += G, ++it) { const int xcd = L & 7, rest = L >> 3, blk = rest & 31, bh = xcd + 8 * (rest >> 5);
                if ((badmask >> (it & 31)) & 1u) attn_item<0, false>(ap, bh >> 3, bh & 7, blk, (char*)lds); } }
    }
    { WSPTRS();
        AttnP ap{QA, KA, VA, QB, KB, VB, GB, MIX, p.subln_g, p.rpb, lamp};
        unsigned badmask = 0u; int it = 0;
        for (int L = bid; L < 1024; L += G, ++it) { const int xcd = L & 7, rest = L >> 3, blk = rest & 31, bh = xcd + 8 * (rest >> 5);
            if (attn_item<1, true>(ap, bh >> 3, bh & 7, blk, (char*)lds)) badmask |= 1u << (it & 31); }
        badmask = __builtin_amdgcn_readfirstlane(badmask);
        if (badmask) { it = 0;
            for (int L = bid; L < 1024; L += G, ++it) { const int xcd = L & 7, rest = L >> 3, blk = rest & 31, bh = xcd + 8 * (rest >> 5);
                if ((badmask >> (it & 31)) & 1u) attn_item<1, false>(ap, bh >> 3, bh & 7, blk, (char*)lds); } }
    }
    grid.sync();

    { WSPTRS();
        pg8::Gemm g{MIX, WoutT, DM}; pg8::OrderPanel S{bid};
        EpiOutNorm E{p.x, mod, p.final_g, p.out, (float*)(ws + WS_XCH), (unsigned*)(ws + 126976), (LAS float*)((LAS unsigned char*)lds + 131072)};
        pg8::gemm_phase<EpiOutNorm, pg8::OrderPanel>((LAS unsigned char*)lds, g, S, E);
    }
}

extern "C" void kernel_launch(void* const* d_in, const int* in_sizes, int n_in, void* d_out, int out_size, void* d_ws, size_t ws_size, hipStream_t stream) {
    static int grid_blocks = 0;
    if (grid_blocks == 0) {
        if (n_in != 16 || in_sizes[0] != NTOK * DM || out_size != NTOK * DM || ws_size < WS_END) {
            fprintf(stderr, "kernel_launch: shape mismatch (n_in %d in0 %d out %d ws %zu)\n", n_in, n_in > 0 ? in_sizes[0] : -1, out_size, ws_size); grid_blocks = -1; return; }
        int dev = 0, cus = 0, per_cu = 0;
        hipGetDevice(&dev);
        hipDeviceGetAttribute(&cus, hipDeviceAttributeMultiprocessorCount, dev);
        if (hipFuncSetAttribute((const void*)fwd_megakernel, hipFuncAttributeMaxDynamicSharedMemorySize, LDS_BYTES) != hipSuccess) { fprintf(stderr, "kernel_launch: hipFuncSetAttribute failed\n"); grid_blocks = -1; return; }
        hipOccupancyMaxActiveBlocksPerMultiprocessor(&per_cu, (const void*)fwd_megakernel, 512, LDS_BYTES);
        if (per_cu < 1) { fprintf(stderr, "kernel_launch: occupancy query returned %d\n", per_cu); per_cu = 1; }
        (void)hipGetLastError();
        if (cus != 256) { fprintf(stderr, "kernel_launch: built for a 256-CU device (got %d CUs)\n", cus); grid_blocks = -1; return; }
        grid_blocks = cus;
    }
    if (grid_blocks < 0) return;
    hipMemsetAsync((char*)d_ws + WS_MOD, 0, 128 * 1024, stream);
    Params p{};
    p.x = (const float*)d_in[0]; p.c = (const float*)d_in[1]; p.ctx = (const float*)d_in[2]; p.c_ctx = (const float*)d_in[3]; p.norm_g = (const float*)d_in[4];
    p.w_mod = (const float*)d_in[5]; p.b_mod = (const float*)d_in[6]; p.w_in = (const float*)d_in[7]; p.w_out = (const float*)d_in[8];
    p.lq1 = (const float*)d_in[9]; p.lk1 = (const float*)d_in[10]; p.lq2 = (const float*)d_in[11]; p.lk2 = (const float*)d_in[12];
    p.subln_g = (const float*)d_in[13]; p.rpb = (const float*)d_in[14]; p.final_g = (const float*)d_in[15];
    p.out = (float*)d_out; p.ws = (unsigned char*)d_ws;
    void* args[] = {&p};
    hipError_t e = hipLaunchCooperativeKernel((const void*)fwd_megakernel, dim3(grid_blocks), dim3(512), args, LDS_BYTES, stream);
    if (e != hipSuccess) fprintf(stderr, "cooperative launch failed: %s (grid %d)\n", hipGetErrorString(e), grid_blocks);
}
```

```cpp
#include <hip/hip_runtime.h>
#include <hip/hip_cooperative_groups.h>
#include <cstdio>
#include <cstdint>
namespace cg = cooperative_groups;

#define LAS __attribute__((address_space(3)))
typedef unsigned short bf16_t;
typedef short bf16x8 __attribute__((ext_vector_type(8)));
typedef short s16x4 __attribute__((ext_vector_type(4)));
typedef float f32x4 __attribute__((ext_vector_type(4)));
typedef float f32x16 __attribute__((ext_vector_type(16)));
typedef unsigned u32x4 __attribute__((ext_vector_type(4)));

constexpr int DM = 2048, NB = 4, SEQ = 8192, CTX = 256, NTOK = NB * SEQ, NCTX = NB * CTX, INC = 8192, SKV = SEQ + CTX;
constexpr float LOG2E = 1.4426950408889634f;
constexpr float C2A = 0.125f * LOG2E;
constexpr float C2B = 0.08838834764831845f * LOG2E;
constexpr size_t MiB = 1u << 20;
constexpr size_t WS_MOD = 0, WS_LAM = 128 * 1024, WS_ROPE = 192 * 1024, WS_WIN = 1 * MiB, WS_WOUT = 33 * MiB, WS_HX = 48 * MiB;
constexpr size_t WS_QA = 192 * MiB, WS_KA = 256 * MiB, WS_VA = 328 * MiB, WS_QB = 400 * MiB, WS_KB = 464 * MiB, WS_VB = 536 * MiB;
constexpr size_t WS_G = 608 * MiB, WS_MIX = 736 * MiB, WS_XCH = 864 * MiB, WS_END = 866 * MiB;
constexpr int LDS_BYTES = 136192;

__device__ __forceinline__ unsigned cvtpk(float lo, float hi) { unsigned r; asm volatile("v_cvt_pk_bf16_f32 %0, %1, %2" : "=v"(r) : "v"(lo), "v"(hi)); return r; }
__device__ __forceinline__ float bf2f(bf16_t v) { return __uint_as_float((unsigned)v << 16); }
__device__ __forceinline__ float silu_f(float v) { return v * __builtin_amdgcn_rcpf(1.f + __builtin_amdgcn_exp2f(-v * LOG2E)); }
__device__ __forceinline__ float wave_sum(float v) {
#pragma unroll
    for (int o = 1; o < 64; o <<= 1) v += __shfl_xor(v, o);
    return v;
}

namespace pg8 {
constexpr int BM = 256, BK = 64, HALF = 128, HTB = HALF * BK * 2, NXCD = 8, WGM = 8;
__host__ __device__ __forceinline__ int lds_byte(int r, int c) { const int st = (r >> 4) * 2 + (c >> 5), rr = r & 15, cc = c & 31, ob = rr * 64 + cc * 2; return st * 1024 + (ob ^ (((ob >> 9) & 1) << 5)); }
__host__ __device__ __forceinline__ void stage_rc(int b, int& R, int& C) { const int st = b / 1024, sb = b % 1024, swz = sb ^ (((sb >> 9) & 1) << 5); R = (st >> 1) * 16 + swz / 64; C = (st & 1) * 32 + (swz % 64) / 2; }
__host__ __device__ __forceinline__ int perm32(int rho) { const int n = rho >> 4, i = rho & 15; return 8 * (i >> 2) + 4 * n + (i & 3); }
__host__ __device__ __forceinline__ int perm32inv(int q) { return 16 * ((q >> 2) & 1) + 4 * (q >> 3) + (q & 3); }
struct Unit { int pm, pn; };
struct Gemm { const bf16_t* A; const bf16_t* Bt; int K; };

struct Order {
    int nM, nN, nwg, G, c, nX;
    __device__ void init(int nM_, int nN_, int G_, int c_, int nX_) { nM = nM_; nN = nN_; nwg = nM * nN; G = G_; c = c_; nX = nX_; }
    __device__ bool next(int i, Unit& u) const {
        const int L = i * G + c; if (L >= nwg + nX) return false;
        if (L >= nwg) { const int e = L - nwg; u.pm = nM + (e >> 4); const int q = e & 15; u.pn = q < 8 ? 4 + q : 12 + q; return true; }
        int wgid = L; { const int q = nwg / NXCD, r = nwg % NXCD, xcd = wgid % NXCD, off = wgid / NXCD; wgid = (xcd < r ? xcd * (q + 1) : r * (q + 1) + (xcd - r) * q) + off; }
        const int nig = WGM * nN, gid = wgid / nig, fm = gid * WGM, gsz = (nM - fm) < WGM ? (nM - fm) : WGM;
        u.pm = fm + ((wgid % nig) % gsz); u.pn = (wgid % nig) / gsz; return true;
    }
};

struct OrderPanel { int c; __device__ bool next(int i, Unit& u) const { if (i >= 4) return false; const int xcd = c & 7, j = c >> 3; u.pm = xcd * 4 + (j >> 3) + 32 * i; u.pn = j & 7; return true; } };

template <class Epi, class Sched>
__device__ __forceinline__ void gemm_phase(LAS unsigned char* lds, const Gemm g, const Sched& S, const Epi& E) {
    int tid = threadIdx.x; asm volatile("" : "+v"(tid));
    const int wid = __builtin_amdgcn_readfirstlane(tid >> 6), lane = tid & 63, wr = wid >> 2, wc = wid & 3, fr = lane & 15, fq = lane >> 4;
    const int K = g.K, nt = K / BK;
    unsigned voffA[2], voffB[2];
#pragma unroll
    for (int i = 0; i < 2; ++i) { int R, C; stage_rc(tid * 16 + i * 8192, R, C); const int Rb = (R & ~31) + perm32(R & 31);
        voffA[i] = (unsigned)(R * K + C) * 2u; voffB[i] = (unsigned)(Rb * K + C) * 2u; }
    const size_t kstep = (size_t)(BK * 2);
    const size_t hstep = (size_t)HALF * K * 2;
    const size_t tstep = 2 * hstep;
    const unsigned ldsw = (unsigned)wid * 1024u;
    const int aoff = lds_byte(wr * 64 + fr, fq * 8), boff = lds_byte(wc * 32 + fr, fq * 8);
#define PG8_SA(b, h) (((b) * 2 + (h)) * HTB)
#define PG8_SB(b, h) ((4 + (b) * 2 + (h)) * HTB)
#define PG8_STAGE(bufoff, gbase, voff) do { _Pragma("unroll") for (int _i = 0; _i < 2; ++_i) \
        __builtin_amdgcn_global_load_lds((const unsigned*)((const char*)(gbase) + (voff)[_i]), (LAS unsigned*)(lds + (bufoff) + ldsw + _i * 8192), 16, 0, 0); } while (0)
#define PG8_LDA(dst, b, h) do { _Pragma("unroll") for (int m = 0; m < 4; ++m) _Pragma("unroll") for (int k = 0; k < 2; ++k) dst[m][k] = *(const LAS bf16x8*)(lds + PG8_SA(b, h) + aoff + m * 2048 + k * 1024); } while (0)
#define PG8_LDB(dst, b, h) do { _Pragma("unroll") for (int n = 0; n < 2; ++n) _Pragma("unroll") for (int k = 0; k < 2; ++k) dst[n][k] = *(const LAS bf16x8*)(lds + PG8_SB(b, h) + boff + n * 2048 + k * 1024); } while (0)
#define PG8_MMA(ai, bj, At, Bt) do { __builtin_amdgcn_s_setprio(1); _Pragma("unroll") for (int m = 0; m < 4; ++m) _Pragma("unroll") for (int n = 0; n < 2; ++n) _Pragma("unroll") for (int k = 0; k < 2; ++k) \
        acc[ai][bj][m][n] = __builtin_amdgcn_mfma_f32_16x16x32_bf16(Bt[n][k], At[m][k], acc[ai][bj][m][n], 0, 0, 0); __builtin_amdgcn_s_setprio(0); } while (0)
#define PG8_WAIT_V(n) asm volatile("s_waitcnt vmcnt(" #n ")" ::: "memory")
#define PG8_WAIT_L(n) asm volatile("s_waitcnt lgkmcnt(" #n ")" ::: "memory")
#define PG8_BAR __builtin_amdgcn_s_barrier()
#define PG8_SCHED __builtin_amdgcn_sched_barrier(0)
    Unit cur, nxt; int ui = 0;
    if (!S.next(0, cur)) return;
    f32x4 acc[2][2][4][2];
#pragma unroll
    for (int a = 0; a < 2; ++a)
#pragma unroll
        for (int b = 0; b < 2; ++b)
#pragma unroll
            for (int m = 0; m < 4; ++m)
#pragma unroll
                for (int n = 0; n < 2; ++n) acc[a][b][m][n] = (f32x4){0.f, 0.f, 0.f, 0.f};
    bf16x8 At[4][2], B0[2][2], B1[2][2];
    const char* cA = (const char*)g.A + (size_t)cur.pm * tstep; const char* cB = (const char*)g.Bt + (size_t)cur.pn * tstep;
    PG8_STAGE(PG8_SB(0, 0), cB, voffB); PG8_STAGE(PG8_SB(0, 1), cB + hstep, voffB); PG8_STAGE(PG8_SA(0, 0), cA, voffA); PG8_STAGE(PG8_SA(0, 1), cA + hstep, voffA);
    if (wr == 1) PG8_BAR;
    PG8_WAIT_V(2); PG8_BAR;
    PG8_STAGE(PG8_SB(1, 0), cB + kstep, voffB); PG8_STAGE(PG8_SA(1, 0), cA + kstep, voffA); PG8_STAGE(PG8_SB(1, 1), cB + hstep + kstep, voffB);
    PG8_WAIT_V(6); PG8_BAR;
    for (;;) {
        const bool has_next = S.next(ui + 1, nxt);
        const char* nA = has_next ? (const char*)g.A + (size_t)nxt.pm * tstep : cA; const char* nB = has_next ? (const char*)g.Bt + (size_t)nxt.pn * tstep : cB;
        for (int t = 0; t < nt; t += 2) {
            const bool last = (t == nt - 2);
            const char* a1 = cA + (size_t)(t + 1) * kstep;
            const char* a2 = last ? nA : cA + (size_t)(t + 2) * kstep; const char* b2 = last ? nB : cB + (size_t)(t + 2) * kstep;
            const char* a3 = a2 + kstep; const char* b3 = b2 + kstep;
            PG8_LDB(B0, 0, 0); PG8_LDB(B1, 0, 1); PG8_SCHED; PG8_LDA(At, 0, 0); PG8_STAGE(PG8_SA(1, 1), a1 + hstep, voffA);
            PG8_WAIT_V(8); PG8_WAIT_L(0); PG8_BAR; PG8_MMA(0, 0, At, B0); PG8_MMA(0, 1, At, B1); PG8_BAR; PG8_SCHED;
            PG8_LDA(At, 0, 1); PG8_STAGE(PG8_SB(0, 0), b2, voffB); PG8_STAGE(PG8_SB(0, 1), b2 + hstep, voffB); PG8_STAGE(PG8_SA(0, 0), a2, voffA);
            PG8_WAIT_V(8); PG8_WAIT_L(0); PG8_BAR; PG8_MMA(1, 0, At, B0); PG8_MMA(1, 1, At, B1); PG8_BAR; PG8_SCHED;
            PG8_LDB(B0, 1, 0); PG8_LDB(B1, 1, 1); PG8_SCHED; PG8_LDA(At, 1, 0); PG8_STAGE(PG8_SA(0, 1), a2 + hstep, voffA);
            PG8_WAIT_V(8); PG8_WAIT_L(0); PG8_BAR; PG8_MMA(0, 0, At, B0); PG8_MMA(0, 1, At, B1); PG8_BAR; PG8_SCHED;
            PG8_LDA(At, 1, 1); PG8_STAGE(PG8_SB(1, 0), b3, voffB); PG8_STAGE(PG8_SB(1, 1), b3 + hstep, voffB); PG8_STAGE(PG8_SA(1, 0), a3, voffA);
            PG8_WAIT_V(8); PG8_WAIT_L(0); PG8_BAR; PG8_MMA(1, 0, At, B0); PG8_MMA(1, 1, At, B1); PG8_BAR; PG8_SCHED;
        }
        if (wr == 0) PG8_BAR;
        E(acc, cur, wr, wc, fr, fq);
        if (!has_next) break;
#pragma unroll
        for (int a = 0; a < 2; ++a)
#pragma unroll
            for (int b = 0; b < 2; ++b)
#pragma unroll
                for (int m = 0; m < 4; ++m)
#pragma unroll
                    for (int n = 0; n < 2; ++n) acc[a][b][m][n] = (f32x4){0.f, 0.f, 0.f, 0.f};
        cur = nxt; cA = nA; cB = nB; ++ui;
        if (wr == 1) PG8_BAR;
    }
    PG8_WAIT_V(0);
    PG8_BAR;
#undef PG8_SA
#undef PG8_SB
#undef PG8_STAGE
#undef PG8_LDA
#undef PG8_LDB
#undef PG8_MMA
#undef PG8_WAIT_V
#undef PG8_WAIT_L
#undef PG8_BAR
#undef PG8_SCHED
}
}

struct EpiIn {
    static constexpr bool PERM = true;
    bf16_t *QA, *KA, *VA, *QB, *KB, *VB, *G; const float* rope;
    __device__ __forceinline__ void operator()(const f32x4 (&acc)[2][2][4][2], const pg8::Unit& u, int wr, int wc, int fr, int fq) const {
        const int type = u.pn >> 2, hb = (u.pn & 3) * 2;
        const bool isctx = u.pm >= 128;
        const int b = isctx ? u.pm - 128 : (u.pm >> 5);
        const int sbase = (isctx ? SEQ : (u.pm & 31) * 256) + wr * 64 + fr;
        const int dcol = wc * 32 + 8 * fq;
        if (type == 3 || type == 7) {
            bf16_t* gp = G + ((size_t)b * SEQ + sbase) * DM + (type == 7 ? 1024 : 0) + hb * 128 + dcol;
#pragma unroll
            for (int ai = 0; ai < 2; ++ai)
#pragma unroll
                for (int m = 0; m < 4; ++m)
#pragma unroll
                    for (int bj = 0; bj < 2; ++bj) {
                        const f32x4 v0 = acc[ai][bj][m][0], v1 = acc[ai][bj][m][1];
                        u32x4 w; w.x = cvtpk(silu_f(v0[0]), silu_f(v0[1])); w.y = cvtpk(silu_f(v0[2]), silu_f(v0[3]));
                        w.z = cvtpk(silu_f(v1[0]), silu_f(v1[1])); w.w = cvtpk(silu_f(v1[2]), silu_f(v1[3]));
                        *(u32x4*)(gp + (size_t)(ai * 128 + m * 16) * DM + bj * 128) = w;
                    }
            return;
        }
        bf16_t* base; int SK; float sc = 1.f;
        switch (type) {
            case 0: base = QA; SK = SEQ; sc = C2A; break;
            case 1: base = KA; SK = SKV; break;
            case 2: base = VA; SK = SKV; break;
            case 4: base = QB; SK = SEQ; sc = C2B; break;
            case 5: base = KB; SK = SKV; break;
            default: base = VB; SK = SKV; break;
        }
        const bool dorope = (type <= 1) && !isctx;
        bf16_t* op = base + ((size_t)(b * 8 + hb) * SK + sbase) * 128 + dcol;
        const size_t hstride = (size_t)SK * 128;
#pragma unroll
        for (int ai = 0; ai < 2; ++ai)
#pragma unroll
            for (int m = 0; m < 4; ++m) {
                f32x4 cs0 = {1.f, 0.f, 1.f, 0.f}, cs1 = {1.f, 0.f, 1.f, 0.f};
                if (dorope) { const int s = sbase + ai * 128 + m * 16; const int pos = (wc & 1) ? (s & 63) : (s >> 6);
                    const f32x4* rp = (const f32x4*)(rope + (size_t)(pos * 16 + 4 * fq) * 2); cs0 = rp[0]; cs1 = rp[1]; }
#pragma unroll
                for (int bj = 0; bj < 2; ++bj) {
                    const f32x4 x1 = acc[ai][bj][m][0], x2 = acc[ai][bj][m][1];
                    f32x4 y1, y2;
                    y1[0] = x1[0] * cs0[0] - x2[0] * cs0[1]; y2[0] = x2[0] * cs0[0] + x1[0] * cs0[1];
                    y1[1] = x1[1] * cs0[2] - x2[1] * cs0[3]; y2[1] = x2[1] * cs0[2] + x1[1] * cs0[3];
                    y1[2] = x1[2] * cs1[0] - x2[2] * cs1[1]; y2[2] = x2[2] * cs1[0] + x1[2] * cs1[1];
                    y1[3] = x1[3] * cs1[2] - x2[3] * cs1[3]; y2[3] = x2[3] * cs1[2] + x1[3] * cs1[3];
                    y1 = y1 * sc; y2 = y2 * sc;
                    u32x4 w; w.x = cvtpk(y1[0], y1[1]); w.y = cvtpk(y1[2], y1[3]); w.z = cvtpk(y2[0], y2[1]); w.w = cvtpk(y2[2], y2[3]);
                    *(u32x4*)(op + (size_t)(ai * 128 + m * 16) * 128 + bj * hstride) = w;
                }
            }
    }
};
struct EpiOutNorm {
    static constexpr bool PERM = true;
    const float* x; const float* mod; const float* fg; float* out; float* X; unsigned* cnt; LAS float* sc;
    __device__ __forceinline__ void operator()(f32x4 (&acc)[2][2][4][2], const pg8::Unit& u, int wr, int wc, int fr, int fq) const {
        const int row0 = u.pm * 256 + wr * 64 + fr, b = u.pm >> 5, col0 = u.pn * 256 + wc * 32 + 8 * fq;
        int tid = threadIdx.x; asm volatile("" : "+v"(tid));
        f32x4 gv[2][2];
#pragma unroll
        for (int bj = 0; bj < 2; ++bj)
#pragma unroll
            for (int n = 0; n < 2; ++n) gv[bj][n] = *(const f32x4*)(mod + b * 6144 + 4096 + col0 + bj * 128 + 4 * n);
#pragma unroll
        for (int ai = 0; ai < 2; ++ai)
#pragma unroll
            for (int m = 0; m < 4; ++m) {
                const size_t ro = (size_t)(row0 + ai * 128 + m * 16) * DM + col0;
                float s = 0.f;
#pragma unroll
                for (int bj = 0; bj < 2; ++bj) {
                    const f32x4 x0 = *(const f32x4*)(x + ro + bj * 128), x1 = *(const f32x4*)(x + ro + bj * 128 + 4);
                    const f32x4 h0 = x0 + gv[bj][0] * acc[ai][bj][m][0], h1 = x1 + gv[bj][1] * acc[ai][bj][m][1];
                    acc[ai][bj][m][0] = h0; acc[ai][bj][m][1] = h1;
                    s += (h0.x * h0.x + h0.y * h0.y) + (h0.z * h0.z + h0.w * h0.w) + (h1.x * h1.x + h1.y * h1.y) + (h1.z * h1.z + h1.w * h1.w);
                }
                s += __shfl_xor(s, 16); s += __shfl_xor(s, 32);
                if (fq == 0) sc[wc * 256 + ai * 128 + wr * 64 + m * 16 + fr] = s;
            }
        asm volatile("s_waitcnt lgkmcnt(0)" ::: "memory"); __builtin_amdgcn_s_barrier(); asm volatile("" ::: "memory");
        if (tid < 256) X[((size_t)u.pm * 8 + u.pn) * 256 + tid] = (sc[tid] + sc[256 + tid]) + (sc[512 + tid] + sc[768 + tid]);
        asm volatile("s_waitcnt vmcnt(0) lgkmcnt(0)" ::: "memory"); __builtin_amdgcn_s_barrier(); asm volatile("" ::: "memory");
        if (tid == 0) {
            unsigned* c = cnt + u.pm * 8;
            __builtin_amdgcn_fence(__ATOMIC_RELEASE, "agent");
            asm volatile("s_waitcnt vmcnt(0) lgkmcnt(0)" ::: "memory");
            __hip_atomic_fetch_add(c, 1u, __ATOMIC_RELAXED, __HIP_MEMORY_SCOPE_AGENT);
            while (__hip_atomic_load(c, __ATOMIC_RELAXED, __HIP_MEMORY_SCOPE_AGENT) < 8u) __builtin_amdgcn_s_sleep(1);
            __builtin_amdgcn_fence(__ATOMIC_ACQUIRE, "agent");
            asm volatile("s_waitcnt vmcnt(0) lgkmcnt(0)" ::: "memory");
        }
        __builtin_amdgcn_s_barrier(); asm volatile("" ::: "memory");
        if (tid < 256) { float t = 0.f;
#pragma unroll
            for (int k = 0; k < 8; ++k) t += __hip_atomic_load(X + ((size_t)u.pm * 8 + k) * 256 + tid, __ATOMIC_RELAXED, __HIP_MEMORY_SCOPE_AGENT);
            sc[1024 + tid] = rsqrtf(t * (1.f / DM) + 1e-6f); }
        asm volatile("s_waitcnt lgkmcnt(0)" ::: "memory"); __builtin_amdgcn_s_barrier(); asm volatile("" ::: "memory");
        f32x4 fv[2][2];
#pragma unroll
        for (int bj = 0; bj < 2; ++bj)
#pragma unroll
            for (int n = 0; n < 2; ++n) fv[bj][n] = *(const f32x4*)(fg + col0 + bj * 128 + 4 * n);
#pragma unroll
        for (int ai = 0; ai < 2; ++ai)
#pragma unroll
            for (int m = 0; m < 4; ++m) {
                const size_t ro = (size_t)(row0 + ai * 128 + m * 16) * DM + col0;
                const float r = sc[1024 + ai * 128 + wr * 64 + m * 16 + fr];
#pragma unroll
                for (int bj = 0; bj < 2; ++bj) {
                    *(f32x4*)(out + ro + bj * 128) = acc[ai][bj][m][0] * r * fv[bj][0];
                    *(f32x4*)(out + ro + bj * 128 + 4) = acc[ai][bj][m][1] * r * fv[bj][1];
                }
            }
    }
};

#define KSWZ(row, colB) ((row) * 256 + ((colB) ^ (((row) & 7) << 4)))
#define SBAR() __builtin_amdgcn_sched_barrier(0)
__device__ __forceinline__ int crow(int r, int hi) { return (r & 3) + 8 * (r >> 2) + 4 * hi; }
__device__ __forceinline__ int v_st(int k, int c) { const int kk = (k & ~0xC) | ((k & 4) << 1) | ((k & 8) >> 1); return ((kk >> 3) * 4 + (c >> 5)) * 512 + ((kk & 7) * 32 + (c & 31)) * 2; }
__device__ __forceinline__ int v_rd_base(int lane) { return ((lane & 3) << 3) | (((lane >> 2) & 3) << 6) | (((lane >> 4) & 1) << 5) | (((lane >> 5) & 1) << 8); }
constexpr int v_rd_off(int d0, int ks, int half) { return d0 * 512 + ks * 4096 + half * 2048; }
template <int OFF> __device__ __forceinline__ s16x4 tr_read(int vb) {
    s16x4 r; asm volatile("ds_read_b64_tr_b16 %0, %1 offset:%2" : "=&v"(r) : "v"(vb), "i"(OFF) : "memory"); return r;
}
template <int D0> __device__ __forceinline__ void pv_one(f32x16& od, int vb, bf16x8 pa0, bf16x8 pa1, bf16x8 pa2, bf16x8 pa3) {
    const s16x4 l0 = tr_read<v_rd_off(D0, 0, 0)>(vb), h0 = tr_read<v_rd_off(D0, 0, 1)>(vb), l1 = tr_read<v_rd_off(D0, 1, 0)>(vb), h1 = tr_read<v_rd_off(D0, 1, 1)>(vb);
    const s16x4 l2 = tr_read<v_rd_off(D0, 2, 0)>(vb), h2 = tr_read<v_rd_off(D0, 2, 1)>(vb), l3 = tr_read<v_rd_off(D0, 3, 0)>(vb), h3 = tr_read<v_rd_off(D0, 3, 1)>(vb);
    asm volatile("s_waitcnt lgkmcnt(0)" ::: "memory"); SBAR();
#define PK(L, H) (bf16x8){L[0], L[1], L[2], L[3], H[0], H[1], H[2], H[3]}
    od = __builtin_amdgcn_mfma_f32_32x32x16_bf16(pa0, PK(l0, h0), od, 0, 0, 0);
    od = __builtin_amdgcn_mfma_f32_32x32x16_bf16(pa1, PK(l1, h1), od, 0, 0, 0);
    od = __builtin_amdgcn_mfma_f32_32x32x16_bf16(pa2, PK(l2, h2), od, 0, 0, 0);
    od = __builtin_amdgcn_mfma_f32_32x32x16_bf16(pa3, PK(l3, h3), od, 0, 0, 0);
#undef PK
}

template <int NMAP, int D0> __device__ __forceinline__ void pv_all(f32x16 (&o)[NMAP][4], int vb, const bf16x8 (&pa)[NMAP][4]) {
    const s16x4 l0 = tr_read<v_rd_off(D0, 0, 0)>(vb), h0 = tr_read<v_rd_off(D0, 0, 1)>(vb), l1 = tr_read<v_rd_off(D0, 1, 0)>(vb), h1 = tr_read<v_rd_off(D0, 1, 1)>(vb);
    const s16x4 l2 = tr_read<v_rd_off(D0, 2, 0)>(vb), h2 = tr_read<v_rd_off(D0, 2, 1)>(vb), l3 = tr_read<v_rd_off(D0, 3, 0)>(vb), h3 = tr_read<v_rd_off(D0, 3, 1)>(vb);
    asm volatile("s_waitcnt lgkmcnt(0)" ::: "memory"); SBAR();
#define PK(L, H) (bf16x8){L[0], L[1], L[2], L[3], H[0], H[1], H[2], H[3]}
    const bf16x8 v0 = PK(l0, h0), v1 = PK(l1, h1), v2 = PK(l2, h2), v3 = PK(l3, h3);
#undef PK
#pragma unroll
    for (int mp = 0; mp < NMAP; ++mp) o[mp][D0] = __builtin_amdgcn_mfma_f32_32x32x16_bf16(pa[mp][0], v0, o[mp][D0], 0, 0, 0);
#pragma unroll
    for (int mp = 0; mp < NMAP; ++mp) o[mp][D0] = __builtin_amdgcn_mfma_f32_32x32x16_bf16(pa[mp][1], v1, o[mp][D0], 0, 0, 0);
#pragma unroll
    for (int mp = 0; mp < NMAP; ++mp) o[mp][D0] = __builtin_amdgcn_mfma_f32_32x32x16_bf16(pa[mp][2], v2, o[mp][D0], 0, 0, 0);
#pragma unroll
    for (int mp = 0; mp < NMAP; ++mp) o[mp][D0] = __builtin_amdgcn_mfma_f32_32x32x16_bf16(pa[mp][3], v3, o[mp][D0], 0, 0, 0);
}

struct AttnP { const bf16_t *QA, *KA, *VA, *QB, *KB, *VB, *G; bf16_t* MIX; const float *subln_g, *rpb, *lam; };

template <int MODE, bool FAST>
__device__ __forceinline__ int attn_item(const AttnP& a, int b, int h, int blk, char* lds) {
    constexpr int NMAP = MODE == 0 ? 2 : 1, KD0 = MODE == 0 ? 4 : 8, NT = MODE == 0 ? SKV / 64 : 16;
    constexpr float THR = 8.f;
    int tid = threadIdx.x; asm volatile("" : "+v"(tid));
    const int wid = __builtin_amdgcn_readfirstlane(tid >> 6), lane = tid & 63, r32 = lane & 31, hi = lane >> 5;
    char* V_lds = lds; char* K_lds = lds + 32768;
    float* wsf = (float*)(lds + 65536) + wid * 64;
    float* rpbz = (float*)(lds + 65536 + 2048);
    float* rpbs = rpbz + 128;
    char* Qw = lds + 70656 + wid * 8192;
    const size_t bh = (size_t)(b * 8 + h);
    const int qrow = 4 * blk + (wid >> 1), half = wid & 1;
    const int qtok = MODE == 0 ? blk * 256 + wid * 32 : qrow * 64 + half * 32;
    const int ulo = min(max(4 * blk - 4, 0), 116), r0w = min(max(qrow - 4, 0), 120);
    {
        const bf16_t* Qg = (MODE == 0 ? a.QA : a.QB) + (bh * SEQ + qtok) * 128;
#pragma unroll
        for (int i = 0; i < 8; ++i) { const int row = i * 4 + (lane >> 4), c16 = lane & 15;
            const bf16x8 qv = *(const bf16x8*)(Qg + (size_t)row * 128 + c16 * 8);
            *(bf16x8*)(Qw + KSWZ(row, c16 * 16)) = qv; }
    }
    const char* Kh = (const char*)((MODE == 0 ? a.KA : a.KB) + bh * SKV * 128);
    const char* Vh = (const char*)((MODE == 0 ? a.VA : a.VB) + bh * SKV * 128);
    unsigned voffK, voffV;
    {
        const int krow = 4 * wid + (lane >> 4), kch = (lane & 15) ^ (krow & 7);
        voffK = (unsigned)(krow * 256 + kch * 16);
        const int sub = 2 * wid + (lane >> 5), kk = (sub >> 2) * 8 + ((lane & 31) >> 2), cblk = sub & 3;
        const int kreal = kk;
        voffV = (unsigned)(kreal * 256 + (cblk * 32 + (lane & 3) * 8) * 2);
    }
    const int vb0 = (int)(uintptr_t)V_lds + v_rd_base(lane);
    int koff[4];
#pragma unroll
    for (int i = 0; i < 4; ++i) koff[i] = r32 * 256 + (((2 * i + hi) ^ (r32 & 7)) << 4);
    if (MODE == 1) { for (int i = tid; i < 768; i += 512) { const int k = i - 128; rpbz[i] = (k >= 0 && k < 465) ? a.rpb[h * 465 + k] * LOG2E : 0.f; } }
    f32x16 negm0 = f32x16{}, negm1 = f32x16{};
    if (MODE == 1 && FAST) { const int j = half * 32 + r32, c0 = min(max(j - 8, 0), 48);
#pragma unroll
        for (int r = 0; r < 16; ++r) { const int kc = crow(r, hi); negm0[r] = ((unsigned)(kc - c0) < 16u) ? 0.f : -1e30f; negm1[r] = ((unsigned)(kc + 32 - c0) < 16u) ? 0.f : -1e30f; } }
    f32x16 o[NMAP][4]; float m_reg[NMAP], l_reg[NMAP];
#pragma unroll
    for (int mp = 0; mp < NMAP; ++mp) { m_reg[mp] = -1e30f; l_reg[mp] = 0.f;
#pragma unroll
        for (int d = 0; d < 4; ++d) o[mp][d] = f32x16{}; }
#define TROW(t) (MODE == 0 ? (t) * 64 : ((t) < 4 ? SEQ + (t) * 64 : (ulo + (t) - 4) * 64))
#define STAGE(t, bi) do { const size_t g0_ = (size_t)TROW(t) * 256; _Pragma("unroll") for (int ii_ = 0; ii_ < 2; ++ii_) { \
        __builtin_amdgcn_global_load_lds((const unsigned*)(Kh + g0_ + ii_ * 8192 + voffK), (LAS unsigned*)((LAS unsigned char*)K_lds + (bi) * 16384 + wid * 1024 + ii_ * 8192), 16, 0, 0); \
        __builtin_amdgcn_global_load_lds((const unsigned*)(Vh + g0_ + ii_ * 8192 + voffV), (LAS unsigned*)((LAS unsigned char*)V_lds + (bi) * 16384 + wid * 1024 + ii_ * 8192), 16, 0, 0); } } while (0)
    STAGE(0, 0);
    asm volatile("s_waitcnt vmcnt(0) lgkmcnt(0)" ::: "memory");
    __syncthreads();
#pragma nounroll
    for (int t = 0; t < NT; ++t) {
        const int cur = t & 1;
        if (t + 1 < NT) STAGE(t + 1, cur ^ 1);
        bool active = true; int br = 0;
        if (MODE == 1 && t >= 4) { br = ulo + t - 4; active = (br >= r0w) && (br <= r0w + 7); }
        if (active) {
            const char* Kc = K_lds + cur * 16384; const int vb = vb0 + cur * 16384;
            bf16x8 pa[NMAP][4];
#pragma unroll
            for (int mp = 0; mp < NMAP; ++mp) {
                SBAR();
                f32x16 p0 = f32x16{}, p1 = f32x16{};
                if (MODE == 1 && FAST && t >= 4) { p0 = negm0; p1 = negm1; }
#pragma unroll
                for (int d0 = 0; d0 < KD0; ++d0) { const int dd = (MODE == 0 ? mp * 4 : 0) + d0; const int off = koff[dd & 3] + (dd >> 2) * 128;
                    const bf16x8 k0 = *(const bf16x8*)(Kc + off); const bf16x8 k1 = *(const bf16x8*)(Kc + off + 8192);
                    const bf16x8 qf = *(const bf16x8*)(Qw + off);
                    p0 = __builtin_amdgcn_mfma_f32_32x32x16_bf16(k0, qf, p0, 0, 0, 0);
                    p1 = __builtin_amdgcn_mfma_f32_32x32x16_bf16(k1, qf, p1, 0, 0, 0);
                    if ((d0 & 1) == 1) SBAR(); }
                if (MODE == 1 && FAST && t >= 4) {
                    const float* bp = rpbs + (br - qrow + 7) * 31 + 15 - (half * 32 + r32) + 4 * hi;
#pragma unroll
                    for (int r = 0; r < 16; ++r) { p0[r] += bp[(r & 3) + 8 * (r >> 2)]; p1[r] += bp[32 + (r & 3) + 8 * (r >> 2)]; }
                }
                if (MODE == 1 && !FAST && t >= 4) {
                    const int j = half * 32 + r32, c0 = min(max(j - 8, 0), 48);
                    const float* bp = rpbs + (br - qrow + 7) * 31 + 15 - j;
#pragma unroll
                    for (int r = 0; r < 16; ++r) { const int kc = crow(r, hi); const bool ok = (unsigned)(kc - c0) < 16u; const float bv = bp[ok ? kc : j];
                        p0[r] = ok ? p0[r] + bv : -1e30f; }
#pragma unroll
                    for (int r = 0; r < 16; ++r) { const int kc = 32 + crow(r, hi); const bool ok = (unsigned)(kc - c0) < 16u; const float bv = bp[ok ? kc : j];
                        p1[r] = ok ? p1[r] + bv : -1e30f; }
                }
                float alpha = 1.f;
                if (FAST) {
                    float psa = 0.f, psb = 0.f;
#pragma unroll
                    for (int r = 0; r < 16; ++r) { p0[r] = __builtin_amdgcn_exp2f(p0[r]); psa += p0[r]; }
#pragma unroll
                    for (int r = 0; r < 16; ++r) { p1[r] = __builtin_amdgcn_exp2f(p1[r]); psb += p1[r]; }
                    l_reg[mp] += psa + psb;
                } else {
                float pmax = p0[0];
#pragma unroll
                for (int r = 1; r < 16; ++r) pmax = fmaxf(pmax, p0[r]);
#pragma unroll
                for (int r = 0; r < 16; ++r) pmax = fmaxf(pmax, p1[r]);
                { auto rr = __builtin_amdgcn_permlane32_swap(__float_as_uint(pmax), __float_as_uint(pmax), false, false);
                  pmax = fmaxf(__uint_as_float(rr[0]), __uint_as_float(rr[1])); }
                float mn = m_reg[mp];
                if (!__all(pmax - m_reg[mp] <= THR)) { mn = fmaxf(m_reg[mp], pmax); alpha = __builtin_amdgcn_exp2f(m_reg[mp] - mn); m_reg[mp] = mn; }
                float ps = 0.f;
#pragma unroll
                for (int r = 0; r < 16; ++r) { p0[r] = __builtin_amdgcn_exp2f(p0[r] - mn); ps += p0[r]; }
#pragma unroll
                for (int r = 0; r < 16; ++r) { p1[r] = __builtin_amdgcn_exp2f(p1[r] - mn); ps += p1[r]; }
                { auto rr = __builtin_amdgcn_permlane32_swap(__float_as_uint(ps), __float_as_uint(ps), false, false);
                  ps = __uint_as_float(rr[0]) + __uint_as_float(rr[1]); }
                l_reg[mp] = l_reg[mp] * alpha + ps;
                }
#define PK4(P, BASE, OUT) do { u32x4 w = {cvtpk(P[BASE + 0], P[BASE + 1]), cvtpk(P[BASE + 2], P[BASE + 3]), cvtpk(P[BASE + 4], P[BASE + 5]), cvtpk(P[BASE + 6], P[BASE + 7])}; \
    OUT = *reinterpret_cast<bf16x8*>(&w); } while (0)
                PK4(p0, 0, pa[mp][0]); PK4(p0, 8, pa[mp][1]); PK4(p1, 0, pa[mp][2]); PK4(p1, 8, pa[mp][3]);
#undef PK4
                if (!FAST && __any(alpha < 1.f)) {
                    if (hi == 0) wsf[r32] = alpha;
                    asm volatile("s_waitcnt lgkmcnt(0)" ::: "memory");
#pragma unroll
                    for (int r = 0; r < 16; ++r) { const float al = wsf[crow(r, hi)];
#pragma unroll
                        for (int d = 0; d < 4; ++d) o[mp][d][r] *= al; }
                }
            }
            SBAR();
            pv_all<NMAP, 0>(o, vb, pa); pv_all<NMAP, 1>(o, vb, pa); pv_all<NMAP, 2>(o, vb, pa); pv_all<NMAP, 3>(o, vb, pa);
        }
        asm volatile("s_waitcnt vmcnt(0)" ::: "memory");
        __syncthreads();
    }
#undef TROW
#undef STAGE
    if (FAST) {
        bool bad = false;
#pragma unroll
        for (int mp = 0; mp < NMAP; ++mp) { auto rr = __builtin_amdgcn_permlane32_swap(__float_as_uint(l_reg[mp]), __float_as_uint(l_reg[mp]), false, false);
            l_reg[mp] = __uint_as_float(rr[0]) + __uint_as_float(rr[1]); bad = bad || !(l_reg[mp] <= 1.0e30f) || !(l_reg[mp] >= 1.0e-30f); }
        if (lane == 0) rpbz[wid] = __any(bad) ? 1.f : 0.f;
        __syncthreads();
        float anyb = 0.f;
#pragma unroll
        for (int w = 0; w < 8; ++w) anyb += rpbz[w];
        __syncthreads();
        if (anyb != 0.f) return 1;
    }
    const float lam = MODE == 0 ? a.lam[0] : 0.f;
    if (hi == 0) { wsf[r32] = 1.f / l_reg[0]; if (MODE == 0) wsf[32 + r32] = lam / l_reg[NMAP - 1]; }
    asm volatile("s_waitcnt lgkmcnt(0)" ::: "memory");
    const size_t obase = ((size_t)b * SEQ + qtok) * DM + (MODE == 0 ? 0 : 1024) + h * 128 + r32;
    float sg[4];
#pragma unroll
    for (int d = 0; d < 4; ++d) sg[d] = MODE == 0 ? a.subln_g[d * 32 + r32] * 0.8f : 1.f;
#pragma unroll
    for (int r = 0; r < 16; ++r) {
        const int cr = crow(r, hi);
        const float ra = wsf[cr];
        float v[4];
        if (MODE == 0) {
            const float rb = wsf[32 + cr];
            float ss = 0.f;
#pragma unroll
            for (int d = 0; d < 4; ++d) { v[d] = o[0][d][r] * ra - o[NMAP - 1][d][r] * rb; ss += v[d] * v[d]; }
            ss += __shfl_xor(ss, 1); ss += __shfl_xor(ss, 2); ss += __shfl_xor(ss, 4); ss += __shfl_xor(ss, 8); ss += __shfl_xor(ss, 16);
            const float rstd = rsqrtf(ss * (1.f / 128.f) + 1e-5f);
#pragma unroll
            for (int d = 0; d < 4; ++d) v[d] *= rstd * sg[d];
        } else {
#pragma unroll
            for (int d = 0; d < 4; ++d) v[d] = o[0][d][r] * ra;
        }
        const size_t ro = obase + (size_t)cr * DM;
#pragma unroll
        for (int d = 0; d < 4; ++d) { const float gg = bf2f(a.G[ro + d * 32]); a.MIX[ro + d * 32] = (bf16_t)(cvtpk(v[d] * gg, 0.f) & 0xffffu); }
    }
    return 0;
}

struct Params {
    const float *x, *c, *ctx, *c_ctx, *norm_g, *w_mod, *b_mod, *w_in, *w_out, *lq1, *lk1, *lq2, *lk2, *subln_g, *rpb, *final_g;
    float* out; unsigned char* ws;
};

__device__ __forceinline__ void transpose_item(const float* W, int K, int N, bf16_t* WT, LAS float* scr, int item, int lane, int perm_below) {
    const int nblk = N / 32, kb = item / nblk, nb = item % nblk, k0 = 64 * kb, n0 = 32 * nb;
#pragma unroll 8
    for (int i = 0; i < 32; ++i) { const int kk = 2 * i + (lane >> 5); scr[kk * 33 + (lane & 31)] = W[(size_t)(k0 + kk) * N + n0 + (lane & 31)]; }
    asm volatile("s_waitcnt lgkmcnt(0)" ::: "memory");
    const int c = lane & 7; const bool pr = n0 < perm_below;
#pragma unroll
    for (int j = 0; j < 4; ++j) { const int n = (lane >> 3) + 8 * j; const int ns = pr ? pg8::perm32inv(n) : n; const LAS float* s = scr + (8 * c) * 33 + ns;
        u32x4 o; o.x = cvtpk(s[0 * 33], s[1 * 33]); o.y = cvtpk(s[2 * 33], s[3 * 33]); o.z = cvtpk(s[4 * 33], s[5 * 33]); o.w = cvtpk(s[6 * 33], s[7 * 33]);
        *(u32x4*)(WT + (size_t)(n0 + n) * K + k0 + 8 * c) = o; }
    asm volatile("s_waitcnt lgkmcnt(0)" ::: "memory");
}

__global__ void __launch_bounds__(512, 2) fwd_megakernel(Params p) {
    extern __shared__ __attribute__((aligned(16))) unsigned char lds[];
    cg::grid_group grid = cg::this_grid();
    const int bid = blockIdx.x, G = gridDim.x;
#define TIDS() int tid = threadIdx.x; asm volatile("" : "+v"(tid)); const int lane = tid & 63, wid = __builtin_amdgcn_readfirstlane(tid >> 6); (void)lane; (void)wid;
#define WSPTRS() unsigned char* ws = p.ws; asm volatile("" : "+s"(ws)); \
    float* mod = (float*)(ws + WS_MOD); float* lamp = (float*)(ws + WS_LAM); float* rope = (float*)(ws + WS_ROPE); \
    bf16_t* WinT = (bf16_t*)(ws + WS_WIN); bf16_t* WoutT = (bf16_t*)(ws + WS_WOUT); bf16_t* HX = (bf16_t*)(ws + WS_HX); \
    bf16_t* QA = (bf16_t*)(ws + WS_QA); bf16_t* KA = (bf16_t*)(ws + WS_KA); bf16_t* VA = (bf16_t*)(ws + WS_VA); \
    bf16_t* QB = (bf16_t*)(ws + WS_QB); bf16_t* KB = (bf16_t*)(ws + WS_KB); bf16_t* VB = (bf16_t*)(ws + WS_VB); \
    bf16_t* GB = (bf16_t*)(ws + WS_G); bf16_t* MIX = (bf16_t*)(ws + WS_MIX); \
    (void)mod; (void)lamp; (void)rope; (void)WinT; (void)WoutT; (void)HX; (void)QA; (void)KA; (void)VA; (void)QB; (void)KB; (void)VB; (void)GB; (void)MIX;
    { WSPTRS(); TIDS();
    if (bid < 192) {
        const int cgp = bid % 12, kc = bid / 12;
        float* sl = (float*)lds;
        for (int i = tid; i < 640; i += 512) { const int bb = i >> 7, k = kc * 128 + (i & 127); const float v = bb < 4 ? p.c[bb * DM + k] : p.c_ctx[k]; sl[i] = v / (1.f + expf(-v)); }
        __syncthreads();
        const int col = cgp * 512 + tid;
        float a0 = 0.f, a1 = 0.f, a2 = 0.f, a3 = 0.f, a4 = 0.f;
        const float* wp = p.w_mod + (size_t)(kc * 128) * 6144 + col;
#pragma unroll 8
        for (int k = 0; k < 128; ++k) { const float w = wp[(size_t)k * 6144]; a0 += sl[k] * w; a1 += sl[128 + k] * w; a2 += sl[256 + k] * w; a3 += sl[384 + k] * w; a4 += sl[512 + k] * w; }
        if (kc == 0) { const float bm = p.b_mod[col]; a0 += bm; a1 += bm; a2 += bm; a3 += bm; a4 += bm; }
        atomicAdd(mod + col, a0); atomicAdd(mod + 6144 + col, a1); atomicAdd(mod + 2 * 6144 + col, a2); atomicAdd(mod + 3 * 6144 + col, a3); atomicAdd(mod + 4 * 6144 + col, a4);
        __syncthreads();
    } else if (bid < 196) {
        const int idx = (bid - 192) * 512 + tid, pos = idx >> 4, i = idx & 15;
        const float inv = powf(10000.f, -(float)i / 16.f), ang = (float)pos * inv;
        rope[2 * idx] = cosf(ang); rope[2 * idx + 1] = sinf(ang);
    } else if (bid == 196 && wid == 0) {
        const float d1 = wave_sum(p.lq1[lane] * p.lk1[lane]), d2 = wave_sum(p.lq2[lane] * p.lk2[lane]);
        if (lane == 0) lamp[0] = expf(d1) - expf(d2) + 0.2f;
    }
    {
        LAS float* scr = (LAS float*)((LAS unsigned char*)lds + wid * 16384);
        const int gw = bid * 8 + wid, NGW = G * 8;
        constexpr int I_IN = (DM / 64) * (INC / 32), I_OUT = (DM / 64) * (DM / 32);
        for (int it = gw; it < I_IN + I_OUT; it += NGW) {
            if (it < I_IN) transpose_item(p.w_in, DM, INC, WinT, scr, it, lane, 2048);
            else transpose_item(p.w_out, DM, DM, WoutT, scr, it - I_IN, lane, 0);
        }
    }
    }
    grid.sync();

    { WSPTRS(); TIDS();
        const int gw = bid * 8 + wid, NGW = G * 8;
        for (int R = gw; R < NTOK + NCTX; R += NGW) {
            const float* src = R < NTOK ? p.x + (size_t)R * DM : p.ctx + (size_t)(R - NTOK) * DM;
            const float* mr = mod + (R < NTOK ? (R >> 13) : 4) * 6144;
            f32x4 v[8]; float ss = 0.f;
#pragma unroll
            for (int j = 0; j < 8; ++j) { v[j] = *(const f32x4*)(src + j * 256 + lane * 4); ss += (v[j].x * v[j].x + v[j].y * v[j].y) + (v[j].z * v[j].z + v[j].w * v[j].w); }
            const float rstd = rsqrtf(wave_sum(ss) * (1.f / DM) + 1e-6f);
            bf16_t* orow = HX + (size_t)R * DM;
#pragma unroll
            for (int j = 0; j < 8; ++j) { const int k = j * 256 + lane * 4;
                const f32x4 g4 = *(const f32x4*)(p.norm_g + k), sh = *(const f32x4*)(mr + k), sc4 = *(const f32x4*)(mr + 2048 + k);
                const f32x4 y = v[j] * rstd * g4 * (sc4 + 1.f) + sh;
                uint2 w; w.x = cvtpk(y.x, y.y); w.y = cvtpk(y.z, y.w); *(uint2*)(orow + k) = w; }
        }
    }
    grid.sync();

    { WSPTRS();
        pg8::Gemm g{HX, WinT, DM}; pg8::Order S; S.init(NTOK / 256, INC / 256, G, bid, 64);
        EpiIn E{QA, KA, VA, QB, KB, VB, GB, rope};
        pg8::gemm_phase<EpiIn, pg8::Order>((LAS unsigned char*)lds, g, S, E);
    }
    grid.sync();

    { WSPTRS();
        AttnP ap{QA, KA, VA, QB, KB, VB, GB, MIX, p.subln_g, p.rpb, lamp};
        unsigned badmask = 0u; int it = 0;
        for (int L = bid; L < 1024; L += G, ++it) { const int xcd = L & 7, rest = L >> 3, blk = rest & 31, bh = xcd + 8 * (rest >> 5);
            if (attn_item<0, true>(ap, bh >> 3, bh & 7, blk, (char*)lds)) badmask |= 1u << (it & 31); }
        badmask = __builtin_amdgcn_readfirstlane(badmask);
        if (badmask) { it = 0;
            for (int L = bid; L < 1024; L += G, ++it) { const int xcd = L & 7, rest = L >> 3, blk = rest & 31, bh = xcd + 8 * (rest >> 5);
                if ((badmask >> (it & 31)) & 1u) attn_item<0, false>(ap, bh >> 3, bh & 7, blk, (char*)lds); } }
    }
    { WSPTRS();
        AttnP ap{QA, KA, VA, QB, KB, VB, GB, MIX, p.subln_g, p.rpb, lamp};
        unsigned badmask = 0u; int it = 0;
        for (int L = bid; L < 1024; L += G, ++it) { const int xcd = L & 7, rest = L >> 3, blk = rest & 31, bh = xcd + 8 * (rest >> 5);
            if (attn_item<1, true>(ap, bh >> 3, bh & 7, blk, (char*)lds)) badmask |= 1u << (it & 31); }
        badmask = __builtin_amdgcn_readfirstlane(badmask);
        if (badmask) { it = 0;
            for (int L = bid; L < 1024; L += G, ++it) { const int xcd = L & 7, rest = L >> 3, blk = rest & 31, bh = xcd + 8 * (rest >> 5);
                if ((badmask >> (it & 31)) & 1u) attn_item<1, false>(ap, bh >> 3, bh & 7, blk, (char*)lds); } }
    }
    grid.sync();

    { WSPTRS();
        pg8::Gemm g{MIX, WoutT, DM}; pg8::OrderPanel S{bid};
        EpiOutNorm E{p.x, mod, p.final_g, p.out, (float*)(ws + WS_XCH), (unsigned*)(ws + 126976), (LAS float*)((LAS unsigned char*)lds + 131072)};
        pg8::gemm_phase<EpiOutNorm, pg8::OrderPanel>((LAS unsigned char*)lds, g, S, E);
    }
}

extern "C" void kernel_launch(void* const* d_in, const int* in_sizes, int n_in, void* d_out, int out_size, void* d_ws, size_t ws_size, hipStream_t stream) {
    static int grid_blocks = 0;
    if (grid_blocks == 0) {
        if (n_in != 16 || in_sizes[0] != NTOK * DM || out_size != NTOK * DM || ws_size < WS_END) {
            fprintf(stderr, "kernel_launch: shape mismatch (n_in %d in0 %d out %d ws %zu)\n", n_in, n_in > 0 ? in_sizes[0] : -1, out_size, ws_size); grid_blocks = -1; return; }
        int dev = 0, cus = 0, per_cu = 0;
        hipGetDevice(&dev);
        hipDeviceGetAttribute(&cus, hipDeviceAttributeMultiprocessorCount, dev);
        if (hipFuncSetAttribute((const void*)fwd_megakernel, hipFuncAttributeMaxDynamicSharedMemorySize, LDS_BYTES) != hipSuccess) { fprintf(stderr, "kernel_launch: hipFuncSetAttribute failed\n"); grid_blocks = -1; return; }
        hipOccupancyMaxActiveBlocksPerMultiprocessor(&per_cu, (const void*)fwd_megakernel, 512, LDS_BYTES);
        if (per_cu < 1) { fprintf(stderr, "kernel_launch: occupancy query returned %d\n", per_cu); per_cu = 1; }
        (void)hipGetLastError();
        if (cus != 256) { fprintf(stderr, "kernel_launch: built for a 256-CU device (got %d CUs)\n", cus); grid_blocks = -1; return; }
        grid_blocks = cus;
    }
    if (grid_blocks < 0) return;
    hipMemsetAsync((char*)d_ws + WS_MOD, 0, 128 * 1024, stream);
    Params p{};
    p.x = (const float*)d_in[0]; p.c = (const float*)d_in[1]; p.ctx = (const float*)d_in[2]; p.c_ctx = (const float*)d_in[3]; p.norm_g = (const float*)d_in[4];
    p.w_mod = (const float*)d_in[5]; p.b_mod = (const float*)d_in[6]; p.w_in = (const float*)d_in[7]; p.w_out = (const float*)d_in[8];
    p.lq1 = (const float*)d_in[9]; p.lk1 = (const float*)d_in[10]; p.lq2 = (const float*)d_in[11]; p.lk2 = (const float*)d_in[12];
    p.subln_g = (const float*)d_in[13]; p.rpb = (const float*)d_in[14]; p.final_g = (const float*)d_in[15];
    p.out = (float*)d_out; p.ws = (unsigned char*)d_ws;
    void* args[] = {&p};
    hipError_t e = hipLaunchCooperativeKernel((const void*)fwd_megakernel, dim3(grid_blocks), dim3(512), args, LDS_BYTES, stream);
    if (e != hipSuccess) fprintf(stderr, "cooperative launch failed: %s (grid %d)\n", hipGetErrorString(e), grid_blocks);
}
```

```cpp
#include <hip/hip_runtime.h>
#include <hip/hip_cooperative_groups.h>
#include <cstdio>
#include <cstdint>
namespace cg = cooperative_groups;

#define LAS __attribute__((address_space(3)))
typedef unsigned short bf16_t;
typedef short bf16x8 __attribute__((ext_vector_type(8)));
typedef short s16x4 __attribute__((ext_vector_type(4)));
typedef float f32x4 __attribute__((ext_vector_type(4)));
typedef float f32x16 __attribute__((ext_vector_type(16)));
typedef unsigned u32x4 __attribute__((ext_vector_type(4)));

constexpr int DM = 2048, NB = 4, SEQ = 8192, CTX = 256, NTOK = NB * SEQ, NCTX = NB * CTX, INC = 8192, SKV = SEQ + CTX;
constexpr float LOG2E = 1.4426950408889634f;
constexpr float C2A = 0.125f * LOG2E;
constexpr float C2B = 0.08838834764831845f * LOG2E;
constexpr size_t MiB = 1u << 20;
constexpr size_t WS_MOD = 0, WS_LAM = 128 * 1024, WS_ROPE = 192 * 1024, WS_WIN = 1 * MiB, WS_WOUT = 33 * MiB, WS_HX = 48 * MiB;
constexpr size_t WS_QA = 192 * MiB, WS_KA = 256 * MiB, WS_VA = 328 * MiB, WS_QB = 400 * MiB, WS_KB = 464 * MiB, WS_VB = 536 * MiB;
constexpr size_t WS_G = 608 * MiB, WS_MIX = 736 * MiB, WS_XCH = 864 * MiB, WS_END = 866 * MiB;
constexpr int LDS_BYTES = 136192;

__device__ __forceinline__ unsigned cvtpk(float lo, float hi) { unsigned r; asm volatile("v_cvt_pk_bf16_f32 %0, %1, %2" : "=v"(r) : "v"(lo), "v"(hi)); return r; }
__device__ __forceinline__ float bf2f(bf16_t v) { return __uint_as_float((unsigned)v << 16); }
__device__ __forceinline__ float silu_f(float v) { return v * __builtin_amdgcn_rcpf(1.f + __builtin_amdgcn_exp2f(-v * LOG2E)); }
__device__ __forceinline__ float wave_sum(float v) {
#pragma unroll
    for (int o = 1; o < 64; o <<= 1) v += __shfl_xor(v, o);
    return v;
}

namespace pg8 {
constexpr int BM = 256, BK = 64, HALF = 128, HTB = HALF * BK * 2, NXCD = 8, WGM = 8;
__host__ __device__ __forceinline__ int lds_byte(int r, int c) { const int st = (r >> 4) * 2 + (c >> 5), rr = r & 15, cc = c & 31, ob = rr * 64 + cc * 2; return st * 1024 + (ob ^ (((ob >> 9) & 1) << 5)); }
__host__ __device__ __forceinline__ void stage_rc(int b, int& R, int& C) { const int st = b / 1024, sb = b % 1024, swz = sb ^ (((sb >> 9) & 1) << 5); R = (st >> 1) * 16 + swz / 64; C = (st & 1) * 32 + (swz % 64) / 2; }
__host__ __device__ __forceinline__ int perm32(int rho) { const int n = rho >> 4, i = rho & 15; return 8 * (i >> 2) + 4 * n + (i & 3); }
__host__ __device__ __forceinline__ int perm32inv(int q) { return 16 * ((q >> 2) & 1) + 4 * (q >> 3) + (q & 3); }
struct Unit { int pm, pn; };
struct Gemm { const bf16_t* A; const bf16_t* Bt; int K; };

struct Order {
    int nM, nN, nwg, G, c, nX;
    __device__ void init(int nM_, int nN_, int G_, int c_, int nX_) { nM = nM_; nN = nN_; nwg = nM * nN; G = G_; c = c_; nX = nX_; }
    __device__ bool next(int i, Unit& u) const {
        const int L = i * G + c; if (L >= nwg + nX) return false;
        if (L >= nwg) { const int e = L - nwg; u.pm = nM + (e >> 4); const int q = e & 15; u.pn = q < 8 ? 4 + q : 12 + q; return true; }
        int wgid = L; { const int q = nwg / NXCD, r = nwg % NXCD, xcd = wgid % NXCD, off = wgid / NXCD; wgid = (xcd < r ? xcd * (q + 1) : r * (q + 1) + (xcd - r) * q) + off; }
        const int nig = WGM * nN, gid = wgid / nig, fm = gid * WGM, gsz = (nM - fm) < WGM ? (nM - fm) : WGM;
        u.pm = fm + ((wgid % nig) % gsz); u.pn = (wgid % nig) / gsz; return true;
    }
};

struct OrderPanel { int c; __device__ bool next(int i, Unit& u) const { if (i >= 4) return false; const int xcd = c & 7, j = c >> 3; u.pm = xcd * 4 + (j >> 3) + 32 * i; u.pn = j & 7; return true; } };

template <class Epi, class Sched>
__device__ __forceinline__ void gemm_phase(LAS unsigned char* lds, const Gemm g, const Sched& S, const Epi& E) {
    int tid = threadIdx.x; asm volatile("" : "+v"(tid));
    const int wid = __builtin_amdgcn_readfirstlane(tid >> 6), lane = tid & 63, wr = wid >> 2, wc = wid & 3, fr = lane & 15, fq = lane >> 4;
    const int K = g.K, nt = K / BK;
    unsigned voffA[2], voffB[2];
#pragma unroll
    for (int i = 0; i < 2; ++i) { int R, C; stage_rc(tid * 16 + i * 8192, R, C); const int Rb = (R & ~31) + perm32(R & 31);
        voffA[i] = (unsigned)(R * K + C) * 2u; voffB[i] = (unsigned)(Rb * K + C) * 2u; }
    const size_t kstep = (size_t)(BK * 2);
    const size_t hstep = (size_t)HALF * K * 2;
    const size_t tstep = 2 * hstep;
    const unsigned ldsw = (unsigned)wid * 1024u;
    const int aoff = lds_byte(wr * 64 + fr, fq * 8), boff = lds_byte(wc * 32 + fr, fq * 8);
#define PG8_SA(b, h) (((b) * 2 + (h)) * HTB)
#define PG8_SB(b, h) ((4 + (b) * 2 + (h)) * HTB)
#define PG8_STAGE(bufoff, gbase, voff) do { _Pragma("unroll") for (int _i = 0; _i < 2; ++_i) \
        __builtin_amdgcn_global_load_lds((const unsigned*)((const char*)(gbase) + (voff)[_i]), (LAS unsigned*)(lds + (bufoff) + ldsw + _i * 8192), 16, 0, 0); } while (0)
#define PG8_LDA(dst, b, h) do { _Pragma("unroll") for (int m = 0; m < 4; ++m) _Pragma("unroll") for (int k = 0; k < 2; ++k) dst[m][k] = *(const LAS bf16x8*)(lds + PG8_SA(b, h) + aoff + m * 2048 + k * 1024); } while (0)
#define PG8_LDB(dst, b, h) do { _Pragma("unroll") for (int n = 0; n < 2; ++n) _Pragma("unroll") for (int k = 0; k < 2; ++k) dst[n][k] = *(const LAS bf16x8*)(lds + PG8_SB(b, h) + boff + n * 2048 + k * 1024); } while (0)
#define PG8_MMA(ai, bj, At, Bt) do { __builtin_amdgcn_s_setprio(1); _Pragma("unroll") for (int m = 0; m < 4; ++m) _Pragma("unroll") for (int n = 0; n < 2; ++n) _Pragma("unroll") for (int k = 0; k < 2; ++k) \
        acc[ai][bj][m][n] = __builtin_amdgcn_mfma_f32_16x16x32_bf16(Bt[n][k], At[m][k], acc[ai][bj][m][n], 0, 0, 0); __builtin_amdgcn_s_setprio(0); } while (0)
#define PG8_WAIT_V(n) asm volatile("s_waitcnt vmcnt(" #n ")" ::: "memory")
#define PG8_WAIT_L(n) asm volatile("s_waitcnt lgkmcnt(" #n ")" ::: "memory")
#define PG8_BAR __builtin_amdgcn_s_barrier()
#define PG8_SCHED __builtin_amdgcn_sched_barrier(0)
    Unit cur, nxt; int ui = 0;
    if (!S.next(0, cur)) return;
    f32x4 acc[2][2][4][2];
#pragma unroll
    for (int a = 0; a < 2; ++a)
#pragma unroll
        for (int b = 0; b < 2; ++b)
#pragma unroll
            for (int m = 0; m < 4; ++m)
#pragma unroll
                for (int n = 0; n < 2; ++n) acc[a][b][m][n] = (f32x4){0.f, 0.f, 0.f, 0.f};
    bf16x8 At[4][2], B0[2][2], B1[2][2];
    const char* cA = (const char*)g.A + (size_t)cur.pm * tstep; const char* cB = (const char*)g.Bt + (size_t)cur.pn * tstep;
    PG8_STAGE(PG8_SB(0, 0), cB, voffB); PG8_STAGE(PG8_SB(0, 1), cB + hstep, voffB); PG8_STAGE(PG8_SA(0, 0), cA, voffA); PG8_STAGE(PG8_SA(0, 1), cA + hstep, voffA);
    if (wr == 1) PG8_BAR;
    PG8_WAIT_V(2); PG8_BAR;
    PG8_STAGE(PG8_SB(1, 0), cB + kstep, voffB); PG8_STAGE(PG8_SA(1, 0), cA + kstep, voffA); PG8_STAGE(PG8_SB(1, 1), cB + hstep + kstep, voffB);
    PG8_WAIT_V(6); PG8_BAR;
    for (;;) {
        const bool has_next = S.next(ui + 1, nxt);
        const char* nA = has_next ? (const char*)g.A + (size_t)nxt.pm * tstep : cA; const char* nB = has_next ? (const char*)g.Bt + (size_t)nxt.pn * tstep : cB;
        for (int t = 0; t < nt; t += 2) {
            const bool last = (t == nt - 2);
            const char* a1 = cA + (size_t)(t + 1) * kstep;
            const char* a2 = last ? nA : cA + (size_t)(t + 2) * kstep; const char* b2 = last ? nB : cB + (size_t)(t + 2) * kstep;
            const char* a3 = a2 + kstep; const char* b3 = b2 + kstep;
            PG8_LDB(B0, 0, 0); PG8_LDB(B1, 0, 1); PG8_SCHED; PG8_LDA(At, 0, 0); PG8_STAGE(PG8_SA(1, 1), a1 + hstep, voffA);
            PG8_WAIT_V(8); PG8_WAIT_L(0); PG8_BAR; PG8_MMA(0, 0, At, B0); PG8_MMA(0, 1, At, B1); PG8_BAR; PG8_SCHED;
            PG8_LDA(At, 0, 1); PG8_STAGE(PG8_SB(0, 0), b2, voffB); PG8_STAGE(PG8_SB(0, 1), b2 + hstep, voffB); PG8_STAGE(PG8_SA(0, 0), a2, voffA);
            PG8_WAIT_V(8); PG8_WAIT_L(0); PG8_BAR; PG8_MMA(1, 0, At, B0); PG8_MMA(1, 1, At, B1); PG8_BAR; PG8_SCHED;
            PG8_LDB(B0, 1, 0); PG8_LDB(B1, 1, 1); PG8_SCHED; PG8_LDA(At, 1, 0); PG8_STAGE(PG8_SA(0, 1), a2 + hstep, voffA);
            PG8_WAIT_V(8); PG8_WAIT_L(0); PG8_BAR; PG8_MMA(0, 0, At, B0); PG8_MMA(0, 1, At, B1); PG8_BAR; PG8_SCHED;
            PG8_LDA(At, 1, 1); PG8_STAGE(PG8_SB(1, 0), b3, voffB); PG8_STAGE(PG8_SB(1, 1), b3 + hstep, voffB); PG8_STAGE(PG8_SA(1, 0), a3, voffA);
            PG8_WAIT_V(8); PG8_WAIT_L(0); PG8_BAR; PG8_MMA(1, 0, At, B0); PG8_MMA(1, 1, At, B1); PG8_BAR; PG8_SCHED;
        }
        if (wr == 0) PG8_BAR;
        E(acc, cur, wr, wc, fr, fq);
        if (!has_next) break;
#pragma unroll
        for (int a = 0; a < 2; ++a)
#pragma unroll
            for (int b = 0; b < 2; ++b)
#pragma unroll
                for (int m = 0; m < 4; ++m)
#pragma unroll
                    for (int n = 0; n < 2; ++n) acc[a][b][m][n] = (f32x4){0.f, 0.f, 0.f, 0.f};
        cur = nxt; cA = nA; cB = nB; ++ui;
        if (wr == 1) PG8_BAR;
    }
    PG8_WAIT_V(0);
    PG8_BAR;
#undef PG8_SA
#undef PG8_SB
#undef PG8_STAGE
#undef PG8_LDA
#undef PG8_LDB
#undef PG8_MMA
#undef PG8_WAIT_V
#undef PG8_WAIT_L
#undef PG8_BAR
#undef PG8_SCHED
}
}

struct EpiIn {
    static constexpr bool PERM = true;
    bf16_t *QA, *KA, *VA, *QB, *KB, *VB, *G; const float* rope;
    __device__ __forceinline__ void operator()(const f32x4 (&acc)[2][2][4][2], const pg8::Unit& u, int wr, int wc, int fr, int fq) const {
        const int type = u.pn >> 2, hb = (u.pn & 3) * 2;
        const bool isctx = u.pm >= 128;
        const int b = isctx ? u.pm - 128 : (u.pm >> 5);
        const int sbase = (isctx ? SEQ : (u.pm & 31) * 256) + wr * 64 + fr;
        const int dcol = wc * 32 + 8 * fq;
        if (type == 3 || type == 7) {
            bf16_t* gp = G + ((size_t)b * SEQ + sbase) * DM + (type == 7 ? 1024 : 0) + hb * 128 + dcol;
#pragma unroll
            for (int ai = 0; ai < 2; ++ai)
#pragma unroll
                for (int m = 0; m < 4; ++m)
#pragma unroll
                    for (int bj = 0; bj < 2; ++bj) {
                        const f32x4 v0 = acc[ai][bj][m][0], v1 = acc[ai][bj][m][1];
                        u32x4 w; w.x = cvtpk(silu_f(v0[0]), silu_f(v0[1])); w.y = cvtpk(silu_f(v0[2]), silu_f(v0[3]));
                        w.z = cvtpk(silu_f(v1[0]), silu_f(v1[1])); w.w = cvtpk(silu_f(v1[2]), silu_f(v1[3]));
                        *(u32x4*)(gp + (size_t)(ai * 128 + m * 16) * DM + bj * 128) = w;
                    }
            return;
        }
        bf16_t* base; int SK; float sc = 1.f;
        switch (type) {
            case 0: base = QA; SK = SEQ; sc = C2A; break;
            case 1: base = KA; SK = SKV; break;
            case 2: base = VA; SK = SKV; break;
            case 4: base = QB; SK = SEQ; sc = C2B; break;
            case 5: base = KB; SK = SKV; break;
            default: base = VB; SK = SKV; break;
        }
        const bool dorope = (type <= 1) && !isctx;
        bf16_t* op = base + ((size_t)(b * 8 + hb) * SK + sbase) * 128 + dcol;
        const size_t hstride = (size_t)SK * 128;
#pragma unroll
        for (int ai = 0; ai < 2; ++ai)
#pragma unroll
            for (int m = 0; m < 4; ++m) {
                f32x4 cs0 = {1.f, 0.f, 1.f, 0.f}, cs1 = {1.f, 0.f, 1.f, 0.f};
                if (dorope) { const int s = sbase + ai * 128 + m * 16; const int pos = (wc & 1) ? (s & 63) : (s >> 6);
                    const f32x4* rp = (const f32x4*)(rope + (size_t)(pos * 16 + 4 * fq) * 2); cs0 = rp[0]; cs1 = rp[1]; }
#pragma unroll
                for (int bj = 0; bj < 2; ++bj) {
                    const f32x4 x1 = acc[ai][bj][m][0], x2 = acc[ai][bj][m][1];
                    f32x4 y1, y2;
                    y1[0] = x1[0] * cs0[0] - x2[0] * cs0[1]; y2[0] = x2[0] * cs0[0] + x1[0] * cs0[1];
                    y1[1] = x1[1] * cs0[2] - x2[1] * cs0[3]; y2[1] = x2[1] * cs0[2] + x1[1] * cs0[3];
                    y1[2] = x1[2] * cs1[0] - x2[2] * cs1[1]; y2[2] = x2[2] * cs1[0] + x1[2] * cs1[1];
                    y1[3] = x1[3] * cs1[2] - x2[3] * cs1[3]; y2[3] = x2[3] * cs1[2] + x1[3] * cs1[3];
                    y1 = y1 * sc; y2 = y2 * sc;
                    u32x4 w; w.x = cvtpk(y1[0], y1[1]); w.y = cvtpk(y1[2], y1[3]); w.z = cvtpk(y2[0], y2[1]); w.w = cvtpk(y2[2], y2[3]);
                    *(u32x4*)(op + (size_t)(ai * 128 + m * 16) * 128 + bj * hstride) = w;
                }
            }
    }
};
struct EpiOutNorm {
    static constexpr bool PERM = true;
    const float* x; const float* mod; const float* fg; float* out; float* X; unsigned* cnt; LAS float* sc;
    __device__ __forceinline__ void operator()(f32x4 (&acc)[2][2][4][2], const pg8::Unit& u, int wr, int wc, int fr, int fq) const {
        const int row0 = u.pm * 256 + wr * 64 + fr, b = u.pm >> 5, col0 = u.pn * 256 + wc * 32 + 8 * fq;
        int tid = threadIdx.x; asm volatile("" : "+v"(tid));
        f32x4 gv[2][2];
#pragma unroll
        for (int bj = 0; bj < 2; ++bj)
#pragma unroll
            for (int n = 0; n < 2; ++n) gv[bj][n] = *(const f32x4*)(mod + b * 6144 + 4096 + col0 + bj * 128 + 4 * n);
#pragma unroll
        for (int ai = 0; ai < 2; ++ai)
#pragma unroll
            for (int m = 0; m < 4; ++m) {
                const size_t ro = (size_t)(row0 + ai * 128 + m * 16) * DM + col0;
                float s = 0.f;
#pragma unroll
                for (int bj = 0; bj < 2; ++bj) {
                    const f32x4 x0 = *(const f32x4*)(x + ro + bj * 128), x1 = *(const f32x4*)(x + ro + bj * 128 + 4);
                    const f32x4 h0 = x0 + gv[bj][0] * acc[ai][bj][m][0], h1 = x1 + gv[bj][1] * acc[ai][bj][m][1];
                    acc[ai][bj][m][0] = h0; acc[ai][bj][m][1] = h1;
                    s += (h0.x * h0.x + h0.y * h0.y) + (h0.z * h0.z + h0.w * h0.w) + (h1.x * h1.x + h1.y * h1.y) + (h1.z * h1.z + h1.w * h1.w);
                }
                s += __shfl_xor(s, 16); s += __shfl_xor(s, 32);
                if (fq == 0) sc[wc * 256 + ai * 128 + wr * 64 + m * 16 + fr] = s;
            }
        asm volatile("s_waitcnt lgkmcnt(0)" ::: "memory"); __builtin_amdgcn_s_barrier(); asm volatile("" ::: "memory");
        if (tid < 256) X[((size_t)u.pm * 8 + u.pn) * 256 + tid] = (sc[tid] + sc[256 + tid]) + (sc[512 + tid] + sc[768 + tid]);
        asm volatile("s_waitcnt vmcnt(0) lgkmcnt(0)" ::: "memory"); __builtin_amdgcn_s_barrier(); asm volatile("" ::: "memory");
        if (tid == 0) {
            unsigned* c = cnt + u.pm * 8;
            __builtin_amdgcn_fence(__ATOMIC_RELEASE, "agent");
            asm volatile("s_waitcnt vmcnt(0) lgkmcnt(0)" ::: "memory");
            __hip_atomic_fetch_add(c, 1u, __ATOMIC_RELAXED, __HIP_MEMORY_SCOPE_AGENT);
            while (__hip_atomic_load(c, __ATOMIC_RELAXED, __HIP_MEMORY_SCOPE_AGENT) < 8u) __builtin_amdgcn_s_sleep(1);
            __builtin_amdgcn_fence(__ATOMIC_ACQUIRE, "agent");
            asm volatile("s_waitcnt vmcnt(0) lgkmcnt(0)" ::: "memory");
        }
        __builtin_amdgcn_s_barrier(); asm volatile("" ::: "memory");
        if (tid < 256) { float t = 0.f;
#pragma unroll
            for (int k = 0; k < 8; ++k) t += __hip_atomic_load(X + ((size_t)u.pm * 8 + k) * 256 + tid, __ATOMIC_RELAXED, __HIP_MEMORY_SCOPE_AGENT);
            sc[1024 + tid] = rsqrtf(t * (1.f / DM) + 1e-6f); }
        asm volatile("s_waitcnt lgkmcnt(0)" ::: "memory"); __builtin_amdgcn_s_barrier(); asm volatile("" ::: "memory");
        f32x4 fv[2][2];
#pragma unroll
        for (int bj = 0; bj < 2; ++bj)
#pragma unroll
            for (int n = 0; n < 2; ++n) fv[bj][n] = *(const f32x4*)(fg + col0 + bj * 128 + 4 * n);
#pragma unroll
        for (int ai = 0; ai < 2; ++ai)
#pragma unroll
            for (int m = 0; m < 4; ++m) {
                const size_t ro = (size_t)(row0 + ai * 128 + m * 16) * DM + col0;
                const float r = sc[1024 + ai * 128 + wr * 64 + m * 16 + fr];
#pragma unroll
                for (int bj = 0; bj < 2; ++bj) {
                    *(f32x4*)(out + ro + bj * 128) = acc[ai][bj][m][0] * r * fv[bj][0];
                    *(f32x4*)(out + ro + bj * 128 + 4) = acc[ai][bj][m][1] * r * fv[bj][1];
                }
            }
    }
};

#define KSWZ(row, colB) ((row) * 256 + ((colB) ^ (((row) & 7) << 4)))
#define SBAR() __builtin_amdgcn_sched_barrier(0)
__device__ __forceinline__ int crow(int r, int hi) { return (r & 3) + 8 * (r >> 2) + 4 * hi; }
__device__ __forceinline__ int v_st(int k, int c) { const int kk = (k & ~0xC) | ((k & 4) << 1) | ((k & 8) >> 1); return ((kk >> 3) * 4 + (c >> 5)) * 512 + ((kk & 7) * 32 + (c & 31)) * 2; }
__device__ __forceinline__ int v_rd_base(int lane) { return ((lane & 3) << 3) | (((lane >> 2) & 3) << 6) | (((lane >> 4) & 1) << 5) | (((lane >> 5) & 1) << 8); }
constexpr int v_rd_off(int d0, int ks, int half) { return d0 * 512 + ks * 4096 + half * 2048; }
template <int OFF> __device__ __forceinline__ s16x4 tr_read(int vb) {
    s16x4 r; asm volatile("ds_read_b64_tr_b16 %0, %1 offset:%2" : "=&v"(r) : "v"(vb), "i"(OFF) : "memory"); return r;
}
template <int D0> __device__ __forceinline__ void pv_one(f32x16& od, int vb, bf16x8 pa0, bf16x8 pa1, bf16x8 pa2, bf16x8 pa3) {
    const s16x4 l0 = tr_read<v_rd_off(D0, 0, 0)>(vb), h0 = tr_read<v_rd_off(D0, 0, 1)>(vb), l1 = tr_read<v_rd_off(D0, 1, 0)>(vb), h1 = tr_read<v_rd_off(D0, 1, 1)>(vb);
    const s16x4 l2 = tr_read<v_rd_off(D0, 2, 0)>(vb), h2 = tr_read<v_rd_off(D0, 2, 1)>(vb), l3 = tr_read<v_rd_off(D0, 3, 0)>(vb), h3 = tr_read<v_rd_off(D0, 3, 1)>(vb);
    asm volatile("s_waitcnt lgkmcnt(0)" ::: "memory"); SBAR();
#define PK(L, H) (bf16x8){L[0], L[1], L[2], L[3], H[0], H[1], H[2], H[3]}
    od = __builtin_amdgcn_mfma_f32_32x32x16_bf16(pa0, PK(l0, h0), od, 0, 0, 0);
    od = __builtin_amdgcn_mfma_f32_32x32x16_bf16(pa1, PK(l1, h1), od, 0, 0, 0);
    od = __builtin_amdgcn_mfma_f32_32x32x16_bf16(pa2, PK(l2, h2), od, 0, 0, 0);
    od = __builtin_amdgcn_mfma_f32_32x32x16_bf16(pa3, PK(l3, h3), od, 0, 0, 0);
#undef PK
}

template <int NMAP, int D0> __device__ __forceinline__ void pv_all(f32x16 (&o)[NMAP][4], int vb, const bf16x8 (&pa)[NMAP][4]) {
    const s16x4 l0 = tr_read<v_rd_off(D0, 0, 0)>(vb), h0 = tr_read<v_rd_off(D0, 0, 1)>(vb), l1 = tr_read<v_rd_off(D0, 1, 0)>(vb), h1 = tr_read<v_rd_off(D0, 1, 1)>(vb);
    const s16x4 l2 = tr_read<v_rd_off(D0, 2, 0)>(vb), h2 = tr_read<v_rd_off(D0, 2, 1)>(vb), l3 = tr_read<v_rd_off(D0, 3, 0)>(vb), h3 = tr_read<v_rd_off(D0, 3, 1)>(vb);
    asm volatile("s_waitcnt lgkmcnt(0)" ::: "memory"); SBAR();
#define PK(L, H) (bf16x8){L[0], L[1], L[2], L[3], H[0], H[1], H[2], H[3]}
    const bf16x8 v0 = PK(l0, h0), v1 = PK(l1, h1), v2 = PK(l2, h2), v3 = PK(l3, h3);
#undef PK
#pragma unroll
    for (int mp = 0; mp < NMAP; ++mp) o[mp][D0] = __builtin_amdgcn_mfma_f32_32x32x16_bf16(pa[mp][0], v0, o[mp][D0], 0, 0, 0);
#pragma unroll
    for (int mp = 0; mp < NMAP; ++mp) o[mp][D0] = __builtin_amdgcn_mfma_f32_32x32x16_bf16(pa[mp][1], v1, o[mp][D0], 0, 0, 0);
#pragma unroll
    for (int mp = 0; mp < NMAP; ++mp) o[mp][D0] = __builtin_amdgcn_mfma_f32_32x32x16_bf16(pa[mp][2], v2, o[mp][D0], 0, 0, 0);
#pragma unroll
    for (int mp = 0; mp < NMAP; ++mp) o[mp][D0] = __builtin_amdgcn_mfma_f32_32x32x16_bf16(pa[mp][3], v3, o[mp][D0], 0, 0, 0);
}

struct AttnP { const bf16_t *QA, *KA, *VA, *QB, *KB, *VB, *G; bf16_t* MIX; const float *subln_g, *rpb, *lam; };

template <int MODE, bool FAST>
__device__ __forceinline__ int attn_item(const AttnP& a, int b, int h, int blk, char* lds) {
    constexpr int NMAP = MODE == 0 ? 2 : 1, KD0 = MODE == 0 ? 4 : 8, NT = MODE == 0 ? SKV / 64 : 16;
    constexpr float THR = 8.f;
    int tid = threadIdx.x; asm volatile("" : "+v"(tid));
    const int wid = __builtin_amdgcn_readfirstlane(tid >> 6), lane = tid & 63, r32 = lane & 31, hi = lane >> 5;
    char* V_lds = lds; char* K_lds = lds + 32768;
    float* wsf = (float*)(lds + 65536) + wid * 64;
    float* rpbz = (float*)(lds + 65536 + 2048);
    float* rpbs = rpbz + 128;
    char* Qw = lds + 70656 + wid * 8192;
    const size_t bh = (size_t)(b * 8 + h);
    const int qrow = 4 * blk + (wid >> 1), half = wid & 1;
    const int qtok = MODE == 0 ? blk * 256 + wid * 32 : qrow * 64 + half * 32;
    const int ulo = min(max(4 * blk - 4, 0), 116), r0w = min(max(qrow - 4, 0), 120);
    {
        const bf16_t* Qg = (MODE == 0 ? a.QA : a.QB) + (bh * SEQ + qtok) * 128;
#pragma unroll
        for (int i = 0; i < 8; ++i) { const int row = i * 4 + (lane >> 4), c16 = lane & 15;
            const bf16x8 qv = *(const bf16x8*)(Qg + (size_t)row * 128 + c16 * 8);
            *(bf16x8*)(Qw + KSWZ(row, c16 * 16)) = qv; }
    }
    const char* Kh = (const char*)((MODE == 0 ? a.KA : a.KB) + bh * SKV * 128);
    const char* Vh = (const char*)((MODE == 0 ? a.VA : a.VB) + bh * SKV * 128);
    unsigned voffK, voffV;
    {
        const int krow = 4 * wid + (lane >> 4), kch = (lane & 15) ^ (krow & 7);
        voffK = (unsigned)(krow * 256 + kch * 16);
        const int sub = 2 * wid + (lane >> 5), kk = (sub >> 2) * 8 + ((lane & 31) >> 2), cblk = sub & 3;
        const int kreal = kk;
        voffV = (unsigned)(kreal * 256 + (cblk * 32 + (lane & 3) * 8) * 2);
    }
    const int vb0 = (int)(uintptr_t)V_lds + v_rd_base(lane);
    int koff[4];
#pragma unroll
    for (int i = 0; i < 4; ++i) koff[i] = r32 * 256 + (((2 * i + hi) ^ (r32 & 7)) << 4);
    if (MODE == 1) { for (int i = tid; i < 768; i += 512) { const int k = i - 128; rpbz[i] = (k >= 0 && k < 465) ? a.rpb[h * 465 + k] * LOG2E : 0.f; } }
    f32x16 negm0 = f32x16{}, negm1 = f32x16{};
    if (MODE == 1 && FAST) { const int j = half * 32 + r32, c0 = min(max(j - 8, 0), 48);
#pragma unroll
        for (int r = 0; r < 16; ++r) { const int kc = crow(r, hi); negm0[r] = ((unsigned)(kc - c0) < 16u) ? 0.f : -1e30f; negm1[r] = ((unsigned)(kc + 32 - c0) < 16u) ? 0.f : -1e30f; } }
    f32x16 o[NMAP][4]; float m_reg[NMAP], l_reg[NMAP];
#pragma unroll
    for (int mp = 0; mp < NMAP; ++mp) { m_reg[mp] = -1e30f; l_reg[mp] = 0.f;
#pragma unroll
        for (int d = 0; d < 4; ++d) o[mp][d] = f32x16{}; }
#define TROW(t) (MODE == 0 ? (t) * 64 : ((t) < 4 ? SEQ + (t) * 64 : (ulo + (t) - 4) * 64))
#define STAGE(t, bi) do { const size_t g0_ = (size_t)TROW(t) * 256; _Pragma("unroll") for (int ii_ = 0; ii_ < 2; ++ii_) { \
        __builtin_amdgcn_global_load_lds((const unsigned*)(Kh + g0_ + ii_ * 8192 + voffK), (LAS unsigned*)((LAS unsigned char*)K_lds + (bi) * 16384 + wid * 1024 + ii_ * 8192), 16, 0, 0); \
        __builtin_amdgcn_global_load_lds((const unsigned*)(Vh + g0_ + ii_ * 8192 + voffV), (LAS unsigned*)((LAS unsigned char*)V_lds + (bi) * 16384 + wid * 1024 + ii_ * 8192), 16, 0, 0); } } while (0)
    STAGE(0, 0);
    asm volatile("s_waitcnt vmcnt(0) lgkmcnt(0)" ::: "memory");
    __syncthreads();
#pragma nounroll
    for (int t = 0; t < NT; ++t) {
        const int cur = t & 1;
        if (t + 1 < NT) STAGE(t + 1, cur ^ 1);
        bool active = true; int br = 0;
        if (MODE == 1 && t >= 4) { br = ulo + t - 4; active = (br >= r0w) && (br <= r0w + 7); }
        if (active) {
            const char* Kc = K_lds + cur * 16384; const int vb = vb0 + cur * 16384;
            bf16x8 pa[NMAP][4];
#pragma unroll
            for (int mp = 0; mp < NMAP; ++mp) {
                SBAR();
                f32x16 p0 = f32x16{}, p1 = f32x16{};
                if (MODE == 1 && FAST && t >= 4) { p0 = negm0; p1 = negm1; }
#pragma unroll
                for (int d0 = 0; d0 < KD0; ++d0) { const int dd = (MODE == 0 ? mp * 4 : 0) + d0; const int off = koff[dd & 3] + (dd >> 2) * 128;
                    const bf16x8 k0 = *(const bf16x8*)(Kc + off); const bf16x8 k1 = *(const bf16x8*)(Kc + off + 8192);
                    const bf16x8 qf = *(const bf16x8*)(Qw + off);
                    p0 = __builtin_amdgcn_mfma_f32_32x32x16_bf16(k0, qf, p0, 0, 0, 0);
                    p1 = __builtin_amdgcn_mfma_f32_32x32x16_bf16(k1, qf, p1, 0, 0, 0);
                    if ((d0 & 1) == 1) SBAR(); }
                if (MODE == 1 && FAST && t >= 4) {
                    const float* bp = rpbs + (br - qrow + 7) * 31 + 15 - (half * 32 + r32) + 4 * hi;
#pragma unroll
                    for (int r = 0; r < 16; ++r) { p0[r] += bp[(r & 3) + 8 * (r >> 2)]; p1[r] += bp[32 + (r & 3) + 8 * (r >> 2)]; }
                }
                if (MODE == 1 && !FAST && t >= 4) {
                    const int j = half * 32 + r32, c0 = min(max(j - 8, 0), 48);
                    const float* bp = rpbs + (br - qrow + 7) * 31 + 15 - j;
#pragma unroll
                    for (int r = 0; r < 16; ++r) { const int kc = crow(r, hi); const bool ok = (unsigned)(kc - c0) < 16u; const float bv = bp[ok ? kc : j];
                        p0[r] = ok ? p0[r] + bv : -1e30f; }
#pragma unroll
                    for (int r = 0; r < 16; ++r) { const int kc = 32 + crow(r, hi); const bool ok = (unsigned)(kc - c0) < 16u; const float bv = bp[ok ? kc : j];
                        p1[r] = ok ? p1[r] + bv : -1e30f; }
                }
                float alpha = 1.f;
                if (FAST) {
                    float psa = 0.f, psb = 0.f;
#pragma unroll
                    for (int r = 0; r < 16; ++r) { p0[r] = __builtin_amdgcn_exp2f(p0[r]); psa += p0[r]; }
#pragma unroll
                    for (int r = 0; r < 16; ++r) { p1[r] = __builtin_amdgcn_exp2f(p1[r]); psb += p1[r]; }
                    l_reg[mp] += psa + psb;
                } else {
                float pmax = p0[0];
#pragma unroll
                for (int r = 1; r < 16; ++r) pmax = fmaxf(pmax, p0[r]);
#pragma unroll
                for (int r = 0; r < 16; ++r) pmax = fmaxf(pmax, p1[r]);
                { auto rr = __builtin_amdgcn_permlane32_swap(__float_as_uint(pmax), __float_as_uint(pmax), false, false);
                  pmax = fmaxf(__uint_as_float(rr[0]), __uint_as_float(rr[1])); }
                float mn = m_reg[mp];
                if (!__all(pmax - m_reg[mp] <= THR)) { mn = fmaxf(m_reg[mp], pmax); alpha = __builtin_amdgcn_exp2f(m_reg[mp] - mn); m_reg[mp] = mn; }
                float ps = 0.f;
#pragma unroll
                for (int r = 0; r < 16; ++r) { p0[r] = __builtin_amdgcn_exp2f(p0[r] - mn); ps += p0[r]; }
#pragma unroll
                for (int r = 0; r < 16; ++r) { p1[r] = __builtin_amdgcn_exp2f(p1[r] - mn); ps += p1[r]; }
                { auto rr = __builtin_amdgcn_permlane32_swap(__float_as_uint(ps), __float_as_uint(ps), false, false);
                  ps = __uint_as_float(rr[0]) + __uint_as_float(rr[1]); }
                l_reg[mp] = l_reg[mp] * alpha + ps;
                }
#define PK4(P, BASE, OUT) do { u32x4 w = {cvtpk(P[BASE + 0], P[BASE + 1]), cvtpk(P[BASE + 2], P[BASE + 3]), cvtpk(P[BASE + 4], P[BASE + 5]), cvtpk(P[BASE + 6], P[BASE + 7])}; \
    OUT = *reinterpret_cast<bf16x8*>(&w); } while (0)
                PK4(p0, 0, pa[mp][0]); PK4(p0, 8, pa[mp][1]); PK4(p1, 0, pa[mp][2]); PK4(p1, 8, pa[mp][3]);
#undef PK4
                if (!FAST && __any(alpha < 1.f)) {
                    if (hi == 0) wsf[r32] = alpha;
                    asm volatile("s_waitcnt lgkmcnt(0)" ::: "memory");
#pragma unroll
                    for (int r = 0; r < 16; ++r) { const float al = wsf[crow(r, hi)];
#pragma unroll
                        for (int d = 0; d < 4; ++d) o[mp][d][r] *= al; }
                }
            }
            SBAR();
            pv_all<NMAP, 0>(o, vb, pa); pv_all<NMAP, 1>(o, vb, pa); pv_all<NMAP, 2>(o, vb, pa); pv_all<NMAP, 3>(o, vb, pa);
        }
        asm volatile("s_waitcnt vmcnt(0)" ::: "memory");
        __syncthreads();
    }
#undef TROW
#undef STAGE
    if (FAST) {
        bool bad = false;
#pragma unroll
        for (int mp = 0; mp < NMAP; ++mp) { auto rr = __builtin_amdgcn_permlane32_swap(__float_as_uint(l_reg[mp]), __float_as_uint(l_reg[mp]), false, false);
            l_reg[mp] = __uint_as_float(rr[0]) + __uint_as_float(rr[1]); bad = bad || !(l_reg[mp] <= 1.0e30f) || !(l_reg[mp] >= 1.0e-30f); }
        if (lane == 0) rpbz[wid] = __any(bad) ? 1.f : 0.f;
        __syncthreads();
        float anyb = 0.f;
#pragma unroll
        for (int w = 0; w < 8; ++w) anyb += rpbz[w];
        __syncthreads();
        if (anyb != 0.f) return 1;
    }
    const float lam = MODE == 0 ? a.lam[0] : 0.f;
    if (hi == 0) { wsf[r32] = 1.f / l_reg[0]; if (MODE == 0) wsf[32 + r32] = lam / l_reg[NMAP - 1]; }
    asm volatile("s_waitcnt lgkmcnt(0)" ::: "memory");
    const size_t obase = ((size_t)b * SEQ + qtok) * DM + (MODE == 0 ? 0 : 1024) + h * 128 + r32;
    float sg[4];
#pragma unroll
    for (int d = 0; d < 4; ++d) sg[d] = MODE == 0 ? a.subln_g[d * 32 + r32] * 0.8f : 1.f;
#pragma unroll
    for (int r = 0; r < 16; ++r) {
        const int cr = crow(r, hi);
        const float ra = wsf[cr];
        float v[4];
        if (MODE == 0) {
            const float rb = wsf[32 + cr];
            float ss = 0.f;
#pragma unroll
            for (int d = 0; d < 4; ++d) { v[d] = o[0][d][r] * ra - o[NMAP - 1][d][r] * rb; ss += v[d] * v[d]; }
            ss += __shfl_xor(ss, 1); ss += __shfl_xor(ss, 2); ss += __shfl_xor(ss, 4); ss += __shfl_xor(ss, 8); ss += __shfl_xor(ss, 16);
            const float rstd = rsqrtf(ss * (1.f / 128.f) + 1e-5f);
#pragma unroll
            for (int d = 0; d < 4; ++d) v[d] *= rstd * sg[d];
        } else {
#pragma unroll
            for (int d = 0; d < 4; ++d) v[d] = o[0][d][r] * ra;
        }
        const size_t ro = obase + (size_t)cr * DM;
#pragma unroll
        for (int d = 0; d < 4; ++d) { const float gg = bf2f(a.G[ro + d * 32]); a.MIX[ro + d * 32] = (bf16_t)(cvtpk(v[d] * gg, 0.f) & 0xffffu); }
    }
    return 0;
}

struct Params {
    const float *x, *c, *ctx, *c_ctx, *norm_g, *w_mod, *b_mod, *w_in, *w_out, *lq1, *lk1, *lq2, *lk2, *subln_g, *rpb, *final_g;
    float* out; unsigned char* ws;
};

__device__ __forceinline__ void transpose_item(const float* W, int K, int N, bf16_t* WT, LAS float* scr, int item, int lane, int perm_below) {
    const int nblk = N / 32, kb = item / nblk, nb = item % nblk, k0 = 64 * kb, n0 = 32 * nb;
#pragma unroll 8
    for (int i = 0; i < 32; ++i) { const int kk = 2 * i + (lane >> 5); scr[kk * 33 + (lane & 31)] = W[(size_t)(k0 + kk) * N + n0 + (lane & 31)]; }
    asm volatile("s_waitcnt lgkmcnt(0)" ::: "memory");
    const int c = lane & 7; const bool pr = n0 < perm_below;
#pragma unroll
    for (int j = 0; j < 4; ++j) { const int n = (lane >> 3) + 8 * j; const int ns = pr ? pg8::perm32inv(n) : n; const LAS float* s = scr + (8 * c) * 33 + ns;
        u32x4 o; o.x = cvtpk(s[0 * 33], s[1 * 33]); o.y = cvtpk(s[2 * 33], s[3 * 33]); o.z = cvtpk(s[4 * 33], s[5 * 33]); o.w = cvtpk(s[6 * 33], s[7 * 33]);
        *(u32x4*)(WT + (size_t)(n0 + n) * K + k0 + 8 * c) = o; }
    asm volatile("s_waitcnt lgkmcnt(0)" ::: "memory");
}

__global__ void __launch_bounds__(512, 2) fwd_megakernel(Params p) {
    extern __shared__ __attribute__((aligned(16))) unsigned char lds[];
    cg::grid_group grid = cg::this_grid();
    const int bid = blockIdx.x, G = gridDim.x;
#define TIDS() int tid = threadIdx.x; asm volatile("" : "+v"(tid)); const int lane = tid & 63, wid = __builtin_amdgcn_readfirstlane(tid >> 6); (void)lane; (void)wid;
#define WSPTRS() size_t wsz_ = 0; asm volatile("" : "+s"(wsz_)); unsigned char* ws = p.ws + wsz_;     \
    float* mod = (float*)(ws + WS_MOD); float* lamp = (float*)(ws + WS_LAM); float* rope = (float*)(ws + WS_ROPE); \
    bf16_t* WinT = (bf16_t*)(ws + WS_WIN); bf16_t* WoutT = (bf16_t*)(ws + WS_WOUT); bf16_t* HX = (bf16_t*)(ws + WS_HX); \
    bf16_t* QA = (bf16_t*)(ws + WS_QA); bf16_t* KA = (bf16_t*)(ws + WS_KA); bf16_t* VA = (bf16_t*)(ws + WS_VA); \
    bf16_t* QB = (bf16_t*)(ws + WS_QB); bf16_t* KB = (bf16_t*)(ws + WS_KB); bf16_t* VB = (bf16_t*)(ws + WS_VB); \
    bf16_t* GB = (bf16_t*)(ws + WS_G); bf16_t* MIX = (bf16_t*)(ws + WS_MIX); \
    (void)mod; (void)lamp; (void)rope; (void)WinT; (void)WoutT; (void)HX; (void)QA; (void)KA; (void)VA; (void)QB; (void)KB; (void)VB; (void)GB; (void)MIX;
    { WSPTRS(); TIDS();
    if (bid < 192) {
        const int cgp = bid % 12, kc = bid / 12;
        float* sl = (float*)lds;
        for (int i = tid; i < 640; i += 512) { const int bb = i >> 7, k = kc * 128 + (i & 127); const float v = bb < 4 ? p.c[bb * DM + k] : p.c_ctx[k]; sl[i] = v / (1.f + expf(-v)); }
        __syncthreads();
        const int col = cgp * 512 + tid;
        float a0 = 0.f, a1 = 0.f, a2 = 0.f, a3 = 0.f, a4 = 0.f;
        const float* wp = p.w_mod + (size_t)(kc * 128) * 6144 + col;
#pragma unroll 8
        for (int k = 0; k < 128; ++k) { const float w = wp[(size_t)k * 6144]; a0 += sl[k] * w; a1 += sl[128 + k] * w; a2 += sl[256 + k] * w; a3 += sl[384 + k] * w; a4 += sl[512 + k] * w; }
        if (kc == 0) { const float bm = p.b_mod[col]; a0 += bm; a1 += bm; a2 += bm; a3 += bm; a4 += bm; }
        atomicAdd(mod + col, a0); atomicAdd(mod + 6144 + col, a1); atomicAdd(mod + 2 * 6144 + col, a2); atomicAdd(mod + 3 * 6144 + col, a3); atomicAdd(mod + 4 * 6144 + col, a4);
        __syncthreads();
    } else if (bid < 196) {
        const int idx = (bid - 192) * 512 + tid, pos = idx >> 4, i = idx & 15;
        const float inv = powf(10000.f, -(float)i / 16.f), ang = (float)pos * inv;
        rope[2 * idx] = cosf(ang); rope[2 * idx + 1] = sinf(ang);
    } else if (bid == 196 && wid == 0) {
        const float d1 = wave_sum(p.lq1[lane] * p.lk1[lane]), d2 = wave_sum(p.lq2[lane] * p.lk2[lane]);
        if (lane == 0) lamp[0] = expf(d1) - expf(d2) + 0.2f;
    }
    {
        LAS float* scr = (LAS float*)((LAS unsigned char*)lds + wid * 16384);
        const int gw = bid * 8 + wid, NGW = G * 8;
        constexpr int I_IN = (DM / 64) * (INC / 32), I_OUT = (DM / 64) * (DM / 32);
        for (int it = gw; it < I_IN + I_OUT; it += NGW) {
            if (it < I_IN) transpose_item(p.w_in, DM, INC, WinT, scr, it, lane, 2048);
            else transpose_item(p.w_out, DM, DM, WoutT, scr, it - I_IN, lane, 0);
        }
    }
    }
    grid.sync();

    { WSPTRS(); TIDS();
        const int gw = bid * 8 + wid, NGW = G * 8;
        for (int R = gw; R < NTOK + NCTX; R += NGW) {
            const float* src = R < NTOK ? p.x + (size_t)R * DM : p.ctx + (size_t)(R - NTOK) * DM;
            const float* mr = mod + (R < NTOK ? (R >> 13) : 4) * 6144;
            f32x4 v[8]; float ss = 0.f;
#pragma unroll
            for (int j = 0; j < 8; ++j) { v[j] = *(const f32x4*)(src + j * 256 + lane * 4); ss += (v[j].x * v[j].x + v[j].y * v[j].y) + (v[j].z * v[j].z + v[j].w * v[j].w); }
            const float rstd = rsqrtf(wave_sum(ss) * (1.f / DM) + 1e-6f);
            bf16_t* orow = HX + (size_t)R * DM;
#pragma unroll
            for (int j = 0; j < 8; ++j) { const int k = j * 256 + lane * 4;
                const f32x4 g4 = *(const f32x4*)(p.norm_g + k), sh = *(const f32x4*)(mr + k), sc4 = *(const f32x4*)(mr + 2048 + k);
                const f32x4 y = v[j] * rstd * g4 * (sc4 + 1.f) + sh;
                uint2 w; w.x = cvtpk(y.x, y.y); w.y = cvtpk(y.z, y.w); *(uint2*)(orow + k) = w; }
        }
    }
    grid.sync();

    { WSPTRS();
        pg8::Gemm g{HX, WinT, DM}; pg8::Order S; S.init(NTOK / 256, INC / 256, G, bid, 64);
        EpiIn E{QA, KA, VA, QB, KB, VB, GB, rope};
        pg8::gemm_phase<EpiIn, pg8::Order>((LAS unsigned char*)lds, g, S, E);
    }
    grid.sync();

    { WSPTRS();
        AttnP ap{QA, KA, VA, QB, KB, VB, GB, MIX, p.subln_g, p.rpb, lamp};
        unsigned badmask = 0u; int it = 0;
        for (int L = bid; L < 1024; L += G, ++it) { const int xcd = L & 7, rest = L >> 3, blk = rest & 31, bh = xcd + 8 * (rest >> 5);
            if (attn_item<0, true>(ap, bh >> 3, bh & 7, blk, (char*)lds)) badmask |= 1u << (it & 31); }
        badmask = __builtin_amdgcn_readfirstlane(badmask);
        if (badmask) { it = 0;
            for (int L = bid; L < 1024; L += G, ++it) { const int xcd = L & 7, rest = L >> 3, blk = rest & 31, bh = xcd + 8 * (rest >> 5);
                if ((badmask >> (it & 31)) & 1u) attn_item<0, false>(ap, bh >> 3, bh & 7, blk, (char*)lds); } }
    }
    { WSPTRS();
        AttnP ap{QA, KA, VA, QB, KB, VB, GB, MIX, p.subln_g, p.rpb, lamp};
        unsigned badmask = 0u; int it = 0;
        for (int L = bid; L < 1024; L += G, ++it) { const int xcd = L & 7, rest = L >> 3, blk = rest & 31, bh = xcd + 8 * (rest >> 5);
            if (attn_item<1, true>(ap, bh >> 3, bh & 7, blk, (char*)lds)) badmask |= 1u << (it & 31); }
        badmask = __builtin_amdgcn_readfirstlane(badmask);
        if (badmask) { it = 0;
            for (int L = bid; L < 1024; L += G, ++it) { const int xcd = L & 7, rest = L >> 3, blk = rest & 31, bh = xcd + 8 * (rest >> 5);
                if ((badmask >> (it & 31)) & 1u) attn_item<1, false>(ap, bh >> 3, bh & 7, blk, (char*)lds); } }
    }
    grid.sync();

    { WSPTRS();
        pg8::Gemm g{MIX, WoutT, DM}; pg8::OrderPanel S{bid};
        EpiOutNorm E{p.x, mod, p.final_g, p.out, (float*)(ws + WS_XCH), (unsigned*)(ws + 126976), (LAS float*)((LAS unsigned char*)lds + 131072)};
        pg8::gemm_phase<EpiOutNorm, pg8::OrderPanel>((LAS unsigned char*)lds, g, S, E);
    }
}

extern "C" void kernel_launch(void* const* d_in, const int* in_sizes, int n_in, void* d_out, int out_size, void* d_ws, size_t ws_size, hipStream_t stream) {
    static int grid_blocks = 0;
    if (grid_blocks == 0) {
        if (n_in != 16 || in_sizes[0] != NTOK * DM || out_size != NTOK * DM || ws_size < WS_END) {
            fprintf(stderr, "kernel_launch: shape mismatch (n_in %d in0 %d out %d ws %zu)\n", n_in, n_in > 0 ? in_sizes[0] : -1, out_size, ws_size); grid_blocks = -1; return; }
        int dev = 0, cus = 0, per_cu = 0;
        hipGetDevice(&dev);
        hipDeviceGetAttribute(&cus, hipDeviceAttributeMultiprocessorCount, dev);
        if (hipFuncSetAttribute((const void*)fwd_megakernel, hipFuncAttributeMaxDynamicSharedMemorySize, LDS_BYTES) != hipSuccess) { fprintf(stderr, "kernel_launch: hipFuncSetAttribute failed\n"); grid_blocks = -1; return; }
        hipOccupancyMaxActiveBlocksPerMultiprocessor(&per_cu, (const void*)fwd_megakernel, 512, LDS_BYTES);
        if (per_cu < 1) { fprintf(stderr, "kernel_launch: occupancy query returned %d\n", per_cu); per_cu = 1; }
        (void)hipGetLastError();
        if (cus != 256) { fprintf(stderr, "kernel_launch: built for a 256-CU device (got %d CUs)\n", cus); grid_blocks = -1; return; }
        grid_blocks = cus;
    }
    if (grid_blocks < 0) return;
    hipMemsetAsync((char*)d_ws + WS_MOD, 0, 128 * 1024, stream);
    Params p{};
    p.x = (const float*)d_in[0]; p.c = (const float*)d_in[1]; p.ctx = (const float*)d_in[2]; p.c_ctx = (const float*)d_in[3]; p.norm_g = (const float*)d_in[4];
    p.w_mod = (const float*)d_in[5]; p.b_mod = (const float*)d_in[6]; p.w_in = (const float*)d_in[7]; p.w_out = (const float*)d_in[8];
    p.lq1 = (const float*)d_in[9]; p.lk1 = (const float*)d_in[10]; p.lq2 = (const float*)d_in[11]; p.lk2 = (const float*)d_in[12];
    p.subln_g = (const float*)d_in[13]; p.rpb = (const float*)d_in[14]; p.final_g = (const float*)d_in[15];
    p.out = (float*)d_out; p.ws = (unsigned char*)d_ws;
    void* args[] = {&p};
    hipError_t e = hipLaunchCooperativeKernel((const void*)fwd_megakernel, dim3(grid_blocks), dim3(512), args, LDS_BYTES, stream);
    if (e != hipSuccess) fprintf(stderr, "cooperative launch failed: %s (grid %d)\n", hipGetErrorString(e), grid_blocks);
}
```

```cpp
#include <hip/hip_runtime.h>
#include <hip/hip_cooperative_groups.h>
#include <cstdio>
#include <cstdint>
namespace cg = cooperative_groups;

#define LAS __attribute__((address_space(3)))
typedef unsigned short bf16_t;
typedef short bf16x8 __attribute__((ext_vector_type(8)));
typedef short s16x4 __attribute__((ext_vector_type(4)));
typedef float f32x4 __attribute__((ext_vector_type(4)));
typedef float f32x16 __attribute__((ext_vector_type(16)));
typedef unsigned u32x4 __attribute__((ext_vector_type(4)));

constexpr int DM = 2048, NB = 4, SEQ = 8192, CTX = 256, NTOK = NB * SEQ, NCTX = NB * CTX, INC = 8192, SKV = SEQ + CTX;
constexpr float LOG2E = 1.4426950408889634f;
constexpr float C2A = 0.125f * LOG2E;
constexpr float C2B = 0.08838834764831845f * LOG2E;
constexpr size_t MiB = 1u << 20;
constexpr size_t WS_MOD = 0, WS_LAM = 128 * 1024, WS_ROPE = 192 * 1024, WS_WIN = 1 * MiB, WS_WOUT = 33 * MiB, WS_HX = 48 * MiB;
constexpr size_t WS_QA = 192 * MiB, WS_KA = 256 * MiB, WS_VA = 328 * MiB, WS_QB = 400 * MiB, WS_KB = 464 * MiB, WS_VB = 536 * MiB;
constexpr size_t WS_G = 608 * MiB, WS_MIX = 736 * MiB, WS_XCH = 864 * MiB, WS_END = 866 * MiB;
constexpr int LDS_BYTES = 136192;

__device__ __forceinline__ unsigned cvtpk(float lo, float hi) { unsigned r; asm volatile("v_cvt_pk_bf16_f32 %0, %1, %2" : "=v"(r) : "v"(lo), "v"(hi)); return r; }
__device__ __forceinline__ float bf2f(bf16_t v) { return __uint_as_float((unsigned)v << 16); }
__device__ __forceinline__ float silu_f(float v) { return v * __builtin_amdgcn_rcpf(1.f + __builtin_amdgcn_exp2f(-v * LOG2E)); }
__device__ __forceinline__ float wave_sum(float v) {
#pragma unroll
    for (int o = 1; o < 64; o <<= 1) v += __shfl_xor(v, o);
    return v;
}

namespace pg8 {
constexpr int BM = 256, BK = 64, HALF = 128, HTB = HALF * BK * 2, NXCD = 8, WGM = 8;
__host__ __device__ __forceinline__ int lds_byte(int r, int c) { const int st = (r >> 4) * 2 + (c >> 5), rr = r & 15, cc = c & 31, ob = rr * 64 + cc * 2; return st * 1024 + (ob ^ (((ob >> 9) & 1) << 5)); }
__host__ __device__ __forceinline__ void stage_rc(int b, int& R, int& C) { const int st = b / 1024, sb = b % 1024, swz = sb ^ (((sb >> 9) & 1) << 5); R = (st >> 1) * 16 + swz / 64; C = (st & 1) * 32 + (swz % 64) / 2; }
__host__ __device__ __forceinline__ int perm32(int rho) { const int n = rho >> 4, i = rho & 15; return 8 * (i >> 2) + 4 * n + (i & 3); }
__host__ __device__ __forceinline__ int perm32inv(int q) { return 16 * ((q >> 2) & 1) + 4 * (q >> 3) + (q & 3); }
struct Unit { int pm, pn; };
struct Gemm { const bf16_t* A; const bf16_t* Bt; int K; };

struct Order {
    int nM, nN, nwg, G, c, nX;
    __device__ void init(int nM_, int nN_, int G_, int c_, int nX_) { nM = nM_; nN = nN_; nwg = nM * nN; G = G_; c = c_; nX = nX_; }
    __device__ bool next(int i, Unit& u) const {
        const int L = i * G + c; if (L >= nwg + nX) return false;
        if (L >= nwg) { const int e = L - nwg; u.pm = nM + (e >> 4); const int q = e & 15; u.pn = q < 8 ? 4 + q : 12 + q; return true; }
        int wgid = L; { const int q = nwg / NXCD, r = nwg % NXCD, xcd = wgid % NXCD, off = wgid / NXCD; wgid = (xcd < r ? xcd * (q + 1) : r * (q + 1) + (xcd - r) * q) + off; }
        const int nig = WGM * nN, gid = wgid / nig, fm = gid * WGM, gsz = (nM - fm) < WGM ? (nM - fm) : WGM;
        u.pm = fm + ((wgid % nig) % gsz); u.pn = (wgid % nig) / gsz; return true;
    }
};

struct OrderPanel { int c; __device__ bool next(int i, Unit& u) const { if (i >= 4) return false; const int xcd = c & 7, j = c >> 3; u.pm = xcd * 4 + (j >> 3) + 32 * i; u.pn = j & 7; return true; } };

template <class Epi, class Sched>
__device__ __forceinline__ void gemm_phase(LAS unsigned char* lds, const Gemm g, const Sched& S, const Epi& E) {
    int tid = threadIdx.x; asm volatile("" : "+v"(tid));
    const int wid = __builtin_amdgcn_readfirstlane(tid >> 6), lane = tid & 63, wr = wid >> 2, wc = wid & 3, fr = lane & 15, fq = lane >> 4;
    const int K = g.K, nt = K / BK;
    unsigned voffA[2], voffB[2];
#pragma unroll
    for (int i = 0; i < 2; ++i) { int R, C; stage_rc(tid * 16 + i * 8192, R, C); const int Rb = (R & ~31) + perm32(R & 31);
        voffA[i] = (unsigned)(R * K + C) * 2u; voffB[i] = (unsigned)(Rb * K + C) * 2u; }
    const size_t kstep = (size_t)(BK * 2);
    const size_t hstep = (size_t)HALF * K * 2;
    const size_t tstep = 2 * hstep;
    const unsigned ldsw = (unsigned)wid * 1024u;
    const int aoff = lds_byte(wr * 64 + fr, fq * 8), boff = lds_byte(wc * 32 + fr, fq * 8);
#define PG8_SA(b, h) (((b) * 2 + (h)) * HTB)
#define PG8_SB(b, h) ((4 + (b) * 2 + (h)) * HTB)
#define PG8_STAGE(bufoff, gbase, voff) do { _Pragma("unroll") for (int _i = 0; _i < 2; ++_i) \
        __builtin_amdgcn_global_load_lds((const unsigned*)((const char*)(gbase) + (voff)[_i]), (LAS unsigned*)(lds + (bufoff) + ldsw + _i * 8192), 16, 0, 0); } while (0)
#define PG8_LDA(dst, b, h) do { _Pragma("unroll") for (int m = 0; m < 4; ++m) _Pragma("unroll") for (int k = 0; k < 2; ++k) dst[m][k] = *(const LAS bf16x8*)(lds + PG8_SA(b, h) + aoff + m * 2048 + k * 1024); } while (0)
#define PG8_LDB(dst, b, h) do { _Pragma("unroll") for (int n = 0; n < 2; ++n) _Pragma("unroll") for (int k = 0; k < 2; ++k) dst[n][k] = *(const LAS bf16x8*)(lds + PG8_SB(b, h) + boff + n * 2048 + k * 1024); } while (0)
#define PG8_MMA(ai, bj, At, Bt) do { __builtin_amdgcn_s_setprio(1); _Pragma("unroll") for (int m = 0; m < 4; ++m) _Pragma("unroll") for (int n = 0; n < 2; ++n) _Pragma("unroll") for (int k = 0; k < 2; ++k) \
        acc[ai][bj][m][n] = __builtin_amdgcn_mfma_f32_16x16x32_bf16(Bt[n][k], At[m][k], acc[ai][bj][m][n], 0, 0, 0); __builtin_amdgcn_s_setprio(0); } while (0)
#define PG8_WAIT_V(n) asm volatile("s_waitcnt vmcnt(" #n ")" ::: "memory")
#define PG8_WAIT_L(n) asm volatile("s_waitcnt lgkmcnt(" #n ")" ::: "memory")
#define PG8_BAR __builtin_amdgcn_s_barrier()
#define PG8_SCHED __builtin_amdgcn_sched_barrier(0)
    Unit cur, nxt; int ui = 0;
    if (!S.next(0, cur)) return;
    f32x4 acc[2][2][4][2];
#pragma unroll
    for (int a = 0; a < 2; ++a)
#pragma unroll
        for (int b = 0; b < 2; ++b)
#pragma unroll
            for (int m = 0; m < 4; ++m)
#pragma unroll
                for (int n = 0; n < 2; ++n) acc[a][b][m][n] = (f32x4){0.f, 0.f, 0.f, 0.f};
    bf16x8 At[4][2], B0[2][2], B1[2][2];
    const char* cA = (const char*)g.A + (size_t)cur.pm * tstep; const char* cB = (const char*)g.Bt + (size_t)cur.pn * tstep;
    PG8_STAGE(PG8_SB(0, 0), cB, voffB); PG8_STAGE(PG8_SB(0, 1), cB + hstep, voffB); PG8_STAGE(PG8_SA(0, 0), cA, voffA); PG8_STAGE(PG8_SA(0, 1), cA + hstep, voffA);
    if (wr == 1) PG8_BAR;
    PG8_WAIT_V(2); PG8_BAR;
    PG8_STAGE(PG8_SB(1, 0), cB + kstep, voffB); PG8_STAGE(PG8_SA(1, 0), cA + kstep, voffA); PG8_STAGE(PG8_SB(1, 1), cB + hstep + kstep, voffB);
    PG8_WAIT_V(6); PG8_BAR;
    for (;;) {
        const bool has_next = S.next(ui + 1, nxt);
        const char* nA = has_next ? (const char*)g.A + (size_t)nxt.pm * tstep : cA; const char* nB = has_next ? (const char*)g.Bt + (size_t)nxt.pn * tstep : cB;
        for (int t = 0; t < nt; t += 2) {
            const bool last = (t == nt - 2);
            const char* a1 = cA + (size_t)(t + 1) * kstep;
            const char* a2 = last ? nA : cA + (size_t)(t + 2) * kstep; const char* b2 = last ? nB : cB + (size_t)(t + 2) * kstep;
            const char* a3 = a2 + kstep; const char* b3 = b2 + kstep;
            PG8_LDB(B0, 0, 0); PG8_LDB(B1, 0, 1); PG8_SCHED; PG8_LDA(At, 0, 0); PG8_STAGE(PG8_SA(1, 1), a1 + hstep, voffA);
            PG8_WAIT_V(8); PG8_WAIT_L(0); PG8_BAR; PG8_MMA(0, 0, At, B0); PG8_MMA(0, 1, At, B1); PG8_BAR; PG8_SCHED;
            PG8_LDA(At, 0, 1); PG8_STAGE(PG8_SB(0, 0), b2, voffB); PG8_STAGE(PG8_SB(0, 1), b2 + hstep, voffB); PG8_STAGE(PG8_SA(0, 0), a2, voffA);
            PG8_WAIT_V(8); PG8_WAIT_L(0); PG8_BAR; PG8_MMA(1, 0, At, B0); PG8_MMA(1, 1, At, B1); PG8_BAR; PG8_SCHED;
            PG8_LDB(B0, 1, 0); PG8_LDB(B1, 1, 1); PG8_SCHED; PG8_LDA(At, 1, 0); PG8_STAGE(PG8_SA(0, 1), a2 + hstep, voffA);
            PG8_WAIT_V(8); PG8_WAIT_L(0); PG8_BAR; PG8_MMA(0, 0, At, B0); PG8_MMA(0, 1, At, B1); PG8_BAR; PG8_SCHED;
            PG8_LDA(At, 1, 1); PG8_STAGE(PG8_SB(1, 0), b3, voffB); PG8_STAGE(PG8_SB(1, 1), b3 + hstep, voffB); PG8_STAGE(PG8_SA(1, 0), a3, voffA);
            PG8_WAIT_V(8); PG8_WAIT_L(0); PG8_BAR; PG8_MMA(1, 0, At, B0); PG8_MMA(1, 1, At, B1); PG8_BAR; PG8_SCHED;
        }
        if (wr == 0) PG8_BAR;
        E(acc, cur, wr, wc, fr, fq);
        if (!has_next) break;
#pragma unroll
        for (int a = 0; a < 2; ++a)
#pragma unroll
            for (int b = 0; b < 2; ++b)
#pragma unroll
                for (int m = 0; m < 4; ++m)
#pragma unroll
                    for (int n = 0; n < 2; ++n) acc[a][b][m][n] = (f32x4){0.f, 0.f, 0.f, 0.f};
        cur = nxt; cA = nA; cB = nB; ++ui;
        if (wr == 1) PG8_BAR;
    }
    PG8_WAIT_V(0);
    PG8_BAR;
#undef PG8_SA
#undef PG8_SB
#undef PG8_STAGE
#undef PG8_LDA
#undef PG8_LDB
#undef PG8_MMA
#undef PG8_WAIT_V
#undef PG8_WAIT_L
#undef PG8_BAR
#undef PG8_SCHED
}
}

struct EpiIn {
    static constexpr bool PERM = true;
    bf16_t *QA, *KA, *VA, *QB, *KB, *VB, *G; const float* rope;
    __device__ __forceinline__ void operator()(const f32x4 (&acc)[2][2][4][2], const pg8::Unit& u, int wr, int wc, int fr, int fq) const {
        const int type = u.pn >> 2, hb = (u.pn & 3) * 2;
        const bool isctx = u.pm >= 128;
        const int b = isctx ? u.pm - 128 : (u.pm >> 5);
        const int sbase = (isctx ? SEQ : (u.pm & 31) * 256) + wr * 64 + fr;
        const int dcol = wc * 32 + 8 * fq;
        if (type == 3 || type == 7) {
            bf16_t* gp = G + ((size_t)b * SEQ + sbase) * DM + (type == 7 ? 1024 : 0) + hb * 128 + dcol;
#pragma unroll
            for (int ai = 0; ai < 2; ++ai)
#pragma unroll
                for (int m = 0; m < 4; ++m)
#pragma unroll
                    for (int bj = 0; bj < 2; ++bj) {
                        const f32x4 v0 = acc[ai][bj][m][0], v1 = acc[ai][bj][m][1];
                        u32x4 w; w.x = cvtpk(silu_f(v0[0]), silu_f(v0[1])); w.y = cvtpk(silu_f(v0[2]), silu_f(v0[3]));
                        w.z = cvtpk(silu_f(v1[0]), silu_f(v1[1])); w.w = cvtpk(silu_f(v1[2]), silu_f(v1[3]));
                        *(u32x4*)(gp + (size_t)(ai * 128 + m * 16) * DM + bj * 128) = w;
                    }
            return;
        }
        bf16_t* base; int SK; float sc = 1.f;
        switch (type) {
            case 0: base = QA; SK = SEQ; sc = C2A; break;
            case 1: base = KA; SK = SKV; break;
            case 2: base = VA; SK = SKV; break;
            case 4: base = QB; SK = SEQ; sc = C2B; break;
            case 5: base = KB; SK = SKV; break;
            default: base = VB; SK = SKV; break;
        }
        const bool dorope = (type <= 1) && !isctx;
        bf16_t* op = base + ((size_t)(b * 8 + hb) * SK + sbase) * 128 + dcol;
        const size_t hstride = (size_t)SK * 128;
#pragma unroll
        for (int ai = 0; ai < 2; ++ai)
#pragma unroll
            for (int m = 0; m < 4; ++m) {
                f32x4 cs0 = {1.f, 0.f, 1.f, 0.f}, cs1 = {1.f, 0.f, 1.f, 0.f};
                if (dorope) { const int s = sbase + ai * 128 + m * 16; const int pos = (wc & 1) ? (s & 63) : (s >> 6);
                    const f32x4* rp = (const f32x4*)(rope + (size_t)(pos * 16 + 4 * fq) * 2); cs0 = rp[0]; cs1 = rp[1]; }
#pragma unroll
                for (int bj = 0; bj < 2; ++bj) {
                    const f32x4 x1 = acc[ai][bj][m][0], x2 = acc[ai][bj][m][1];
                    f32x4 y1, y2;
                    y1[0] = x1[0] * cs0[0] - x2[0] * cs0[1]; y2[0] = x2[0] * cs0[0] + x1[0] * cs0[1];
                    y1[1] = x1[1] * cs0[2] - x2[1] * cs0[3]; y2[1] = x2[1] * cs0[2] + x1[1] * cs0[3];
                    y1[2] = x1[2] * cs1[0] - x2[2] * cs1[1]; y2[2] = x2[2] * cs1[0] + x1[2] * cs1[1];
                    y1[3] = x1[3] * cs1[2] - x2[3] * cs1[3]; y2[3] = x2[3] * cs1[2] + x1[3] * cs1[3];
                    y1 = y1 * sc; y2 = y2 * sc;
                    u32x4 w; w.x = cvtpk(y1[0], y1[1]); w.y = cvtpk(y1[2], y1[3]); w.z = cvtpk(y2[0], y2[1]); w.w = cvtpk(y2[2], y2[3]);
                    *(u32x4*)(op + (size_t)(ai * 128 + m * 16) * 128 + bj * hstride) = w;
                }
            }
    }
};
struct EpiOutNorm {
    static constexpr bool PERM = true;
    const float* x; const float* mod; const float* fg; float* out; float* X; unsigned* cnt; LAS float* sc;
    __device__ __forceinline__ void operator()(f32x4 (&acc)[2][2][4][2], const pg8::Unit& u, int wr, int wc, int fr, int fq) const {
        const int row0 = u.pm * 256 + wr * 64 + fr, b = u.pm >> 5, col0 = u.pn * 256 + wc * 32 + 8 * fq;
        int tid = threadIdx.x; asm volatile("" : "+v"(tid));
        f32x4 gv[2][2];
#pragma unroll
        for (int bj = 0; bj < 2; ++bj)
#pragma unroll
            for (int n = 0; n < 2; ++n) gv[bj][n] = *(const f32x4*)(mod + b * 6144 + 4096 + col0 + bj * 128 + 4 * n);
#pragma unroll
        for (int ai = 0; ai < 2; ++ai)
#pragma unroll
            for (int m = 0; m < 4; ++m) {
                const size_t ro = (size_t)(row0 + ai * 128 + m * 16) * DM + col0;
                float s = 0.f;
#pragma unroll
                for (int bj = 0; bj < 2; ++bj) {
                    const f32x4 x0 = *(const f32x4*)(x + ro + bj * 128), x1 = *(const f32x4*)(x + ro + bj * 128 + 4);
                    const f32x4 h0 = x0 + gv[bj][0] * acc[ai][bj][m][0], h1 = x1 + gv[bj][1] * acc[ai][bj][m][1];
                    acc[ai][bj][m][0] = h0; acc[ai][bj][m][1] = h1;
                    s += (h0.x * h0.x + h0.y * h0.y) + (h0.z * h0.z + h0.w * h0.w) + (h1.x * h1.x + h1.y * h1.y) + (h1.z * h1.z + h1.w * h1.w);
                }
                s += __shfl_xor(s, 16); s += __shfl_xor(s, 32);
                if (fq == 0) sc[wc * 256 + ai * 128 + wr * 64 + m * 16 + fr] = s;
            }
        asm volatile("s_waitcnt lgkmcnt(0)" ::: "memory"); __builtin_amdgcn_s_barrier(); asm volatile("" ::: "memory");
        if (tid < 256) X[((size_t)u.pm * 8 + u.pn) * 256 + tid] = (sc[tid] + sc[256 + tid]) + (sc[512 + tid] + sc[768 + tid]);
        asm volatile("s_waitcnt vmcnt(0) lgkmcnt(0)" ::: "memory"); __builtin_amdgcn_s_barrier(); asm volatile("" ::: "memory");
        if (tid == 0) {
            unsigned* c = cnt + u.pm * 8;
            __builtin_amdgcn_fence(__ATOMIC_RELEASE, "agent");
            asm volatile("s_waitcnt vmcnt(0) lgkmcnt(0)" ::: "memory");
            __hip_atomic_fetch_add(c, 1u, __ATOMIC_RELAXED, __HIP_MEMORY_SCOPE_AGENT);
            while (__hip_atomic_load(c, __ATOMIC_RELAXED, __HIP_MEMORY_SCOPE_AGENT) < 8u) __builtin_amdgcn_s_sleep(1);
            __builtin_amdgcn_fence(__ATOMIC_ACQUIRE, "agent");
            asm volatile("s_waitcnt vmcnt(0) lgkmcnt(0)" ::: "memory");
        }
        __builtin_amdgcn_s_barrier(); asm volatile("" ::: "memory");
        if (tid < 256) { float t = 0.f;
#pragma unroll
            for (int k = 0; k < 8; ++k) t += __hip_atomic_load(X + ((size_t)u.pm * 8 + k) * 256 + tid, __ATOMIC_RELAXED, __HIP_MEMORY_SCOPE_AGENT);
            sc[1024 + tid] = rsqrtf(t * (1.f / DM) + 1e-6f); }
        asm volatile("s_waitcnt lgkmcnt(0)" ::: "memory"); __builtin_amdgcn_s_barrier(); asm volatile("" ::: "memory");
        f32x4 fv[2][2];
#pragma unroll
        for (int bj = 0; bj < 2; ++bj)
#pragma unroll
            for (int n = 0; n < 2; ++n) fv[bj][n] = *(const f32x4*)(fg + col0 + bj * 128 + 4 * n);
#pragma unroll
        for (int ai = 0; ai < 2; ++ai)
#pragma unroll
            for (int m = 0; m < 4; ++m) {
                const size_t ro = (size_t)(row0 + ai * 128 + m * 16) * DM + col0;
                const float r = sc[1024 + ai * 128 + wr * 64 + m * 16 + fr];
#pragma unroll
                for (int bj = 0; bj < 2; ++bj) {
                    *(f32x4*)(out + ro + bj * 128) = acc[ai][bj][m][0] * r * fv[bj][0];
                    *(f32x4*)(out + ro + bj * 128 + 4) = acc[ai][bj][m][1] * r * fv[bj][1];
                }
            }
    }
};

#define KSWZ(row, colB) ((row) * 256 + ((colB) ^ (((row) & 7) << 4)))
#define SBAR() __builtin_amdgcn_sched_barrier(0)
__device__ __forceinline__ int crow(int r, int hi) { return (r & 3) + 8 * (r >> 2) + 4 * hi; }
__device__ __forceinline__ int v_st(int k, int c) { const int kk = (k & ~0xC) | ((k & 4) << 1) | ((k & 8) >> 1); return ((kk >> 3) * 4 + (c >> 5)) * 512 + ((kk & 7) * 32 + (c & 31)) * 2; }
__device__ __forceinline__ int v_rd_base(int lane) { return ((lane & 3) << 3) | (((lane >> 2) & 3) << 6) | (((lane >> 4) & 1) << 5) | (((lane >> 5) & 1) << 8); }
constexpr int v_rd_off(int d0, int ks, int half) { return d0 * 512 + ks * 4096 + half * 2048; }
template <int OFF> __device__ __forceinline__ s16x4 tr_read(int vb) {
    s16x4 r; asm volatile("ds_read_b64_tr_b16 %0, %1 offset:%2" : "=&v"(r) : "v"(vb), "i"(OFF) : "memory"); return r;
}
template <int D0> __device__ __forceinline__ void pv_one(f32x16& od, int vb, bf16x8 pa0, bf16x8 pa1, bf16x8 pa2, bf16x8 pa3) {
    const s16x4 l0 = tr_read<v_rd_off(D0, 0, 0)>(vb), h0 = tr_read<v_rd_off(D0, 0, 1)>(vb), l1 = tr_read<v_rd_off(D0, 1, 0)>(vb), h1 = tr_read<v_rd_off(D0, 1, 1)>(vb);
    const s16x4 l2 = tr_read<v_rd_off(D0, 2, 0)>(vb), h2 = tr_read<v_rd_off(D0, 2, 1)>(vb), l3 = tr_read<v_rd_off(D0, 3, 0)>(vb), h3 = tr_read<v_rd_off(D0, 3, 1)>(vb);
    asm volatile("s_waitcnt lgkmcnt(0)" ::: "memory"); SBAR();
#define PK(L, H) (bf16x8){L[0], L[1], L[2], L[3], H[0], H[1], H[2], H[3]}
    od = __builtin_amdgcn_mfma_f32_32x32x16_bf16(pa0, PK(l0, h0), od, 0, 0, 0);
    od = __builtin_amdgcn_mfma_f32_32x32x16_bf16(pa1, PK(l1, h1), od, 0, 0, 0);
    od = __builtin_amdgcn_mfma_f32_32x32x16_bf16(pa2, PK(l2, h2), od, 0, 0, 0);
    od = __builtin_amdgcn_mfma_f32_32x32x16_bf16(pa3, PK(l3, h3), od, 0, 0, 0);
#undef PK
}

template <int NMAP, int D0> __device__ __forceinline__ void pv_all(f32x16 (&o)[NMAP][4], int vb, const bf16x8 (&pa)[NMAP][4]) {
    const s16x4 l0 = tr_read<v_rd_off(D0, 0, 0)>(vb), h0 = tr_read<v_rd_off(D0, 0, 1)>(vb), l1 = tr_read<v_rd_off(D0, 1, 0)>(vb), h1 = tr_read<v_rd_off(D0, 1, 1)>(vb);
    const s16x4 l2 = tr_read<v_rd_off(D0, 2, 0)>(vb), h2 = tr_read<v_rd_off(D0, 2, 1)>(vb), l3 = tr_read<v_rd_off(D0, 3, 0)>(vb), h3 = tr_read<v_rd_off(D0, 3, 1)>(vb);
    asm volatile("s_waitcnt lgkmcnt(0)" ::: "memory"); SBAR();
#define PK(L, H) (bf16x8){L[0], L[1], L[2], L[3], H[0], H[1], H[2], H[3]}
    const bf16x8 v0 = PK(l0, h0), v1 = PK(l1, h1), v2 = PK(l2, h2), v3 = PK(l3, h3);
#undef PK
#pragma unroll
    for (int mp = 0; mp < NMAP; ++mp) o[mp][D0] = __builtin_amdgcn_mfma_f32_32x32x16_bf16(pa[mp][0], v0, o[mp][D0], 0, 0, 0);
#pragma unroll
    for (int mp = 0; mp < NMAP; ++mp) o[mp][D0] = __builtin_amdgcn_mfma_f32_32x32x16_bf16(pa[mp][1], v1, o[mp][D0], 0, 0, 0);
#pragma unroll
    for (int mp = 0; mp < NMAP; ++mp) o[mp][D0] = __builtin_amdgcn_mfma_f32_32x32x16_bf16(pa[mp][2], v2, o[mp][D0], 0, 0, 0);
#pragma unroll
    for (int mp = 0; mp < NMAP; ++mp) o[mp][D0] = __builtin_amdgcn_mfma_f32_32x32x16_bf16(pa[mp][3], v3, o[mp][D0], 0, 0, 0);
}

struct AttnP { const bf16_t *QA, *KA, *VA, *QB, *KB, *VB, *G; bf16_t* MIX; const float *subln_g, *rpb, *lam; };

template <int MODE, bool FAST>
__device__ __forceinline__ int attn_item(const AttnP& a, int b, int h, int blk, char* lds) {
    constexpr int NMAP = MODE == 0 ? 2 : 1, KD0 = MODE == 0 ? 4 : 8, NT = MODE == 0 ? SKV / 64 : 16;
    constexpr float THR = 8.f;
    int tid = threadIdx.x; asm volatile("" : "+v"(tid));
    const int wid = __builtin_amdgcn_readfirstlane(tid >> 6), lane = tid & 63, r32 = lane & 31, hi = lane >> 5;
    char* V_lds = lds; char* K_lds = lds + 32768;
    float* wsf = (float*)(lds + 65536) + wid * 64;
    float* rpbz = (float*)(lds + 65536 + 2048);
    float* rpbs = rpbz + 128;
    char* Qw = lds + 70656 + wid * 8192;
    const size_t bh = (size_t)(b * 8 + h);
    const int qrow = 4 * blk + (wid >> 1), half = wid & 1;
    const int qtok = MODE == 0 ? blk * 256 + wid * 32 : qrow * 64 + half * 32;
    const int ulo = min(max(4 * blk - 4, 0), 116), r0w = min(max(qrow - 4, 0), 120);
    {
        const bf16_t* Qg = (MODE == 0 ? a.QA : a.QB) + (bh * SEQ + qtok) * 128;
#pragma unroll
        for (int i = 0; i < 8; ++i) { const int row = i * 4 + (lane >> 4), c16 = lane & 15;
            const bf16x8 qv = *(const bf16x8*)(Qg + (size_t)row * 128 + c16 * 8);
            *(bf16x8*)(Qw + KSWZ(row, c16 * 16)) = qv; }
    }
    const char* Kh = (const char*)((MODE == 0 ? a.KA : a.KB) + bh * SKV * 128);
    const char* Vh = (const char*)((MODE == 0 ? a.VA : a.VB) + bh * SKV * 128);
    unsigned voffK, voffV;
    {
        const int krow = 4 * wid + (lane >> 4), kch = (lane & 15) ^ (krow & 7);
        voffK = (unsigned)(krow * 256 + kch * 16);
        const int sub = 2 * wid + (lane >> 5), kk = (sub >> 2) * 8 + ((lane & 31) >> 2), cblk = sub & 3;
        const int kreal = kk;
        voffV = (unsigned)(kreal * 256 + (cblk * 32 + (lane & 3) * 8) * 2);
    }
    const int vb0 = (int)(uintptr_t)V_lds + v_rd_base(lane);
    int koff[4];
#pragma unroll
    for (int i = 0; i < 4; ++i) koff[i] = r32 * 256 + (((2 * i + hi) ^ (r32 & 7)) << 4);
    if (MODE == 1) { for (int i = tid; i < 768; i += 512) { const int k = i - 128; rpbz[i] = (k >= 0 && k < 465) ? a.rpb[h * 465 + k] * LOG2E : 0.f; } }
    f32x16 negm0 = f32x16{}, negm1 = f32x16{};
    if (MODE == 1 && FAST) { const int j = half * 32 + r32, c0 = min(max(j - 8, 0), 48);
#pragma unroll
        for (int r = 0; r < 16; ++r) { const int kc = crow(r, hi); negm0[r] = ((unsigned)(kc - c0) < 16u) ? 0.f : -1e30f; negm1[r] = ((unsigned)(kc + 32 - c0) < 16u) ? 0.f : -1e30f; } }
    f32x16 o[NMAP][4]; float m_reg[NMAP], l_reg[NMAP];
#pragma unroll
    for (int mp = 0; mp < NMAP; ++mp) { m_reg[mp] = -1e30f; l_reg[mp] = 0.f;
#pragma unroll
        for (int d = 0; d < 4; ++d) o[mp][d] = f32x16{}; }
#define TROW(t) (MODE == 0 ? (t) * 64 : ((t) < 4 ? SEQ + (t) * 64 : (ulo + (t) - 4) * 64))
#define STAGE(t, bi) do { const size_t g0_ = (size_t)TROW(t) * 256; _Pragma("unroll") for (int ii_ = 0; ii_ < 2; ++ii_) { \
        __builtin_amdgcn_global_load_lds((const unsigned*)(Kh + g0_ + ii_ * 8192 + voffK), (LAS unsigned*)((LAS unsigned char*)K_lds + (bi) * 16384 + wid * 1024 + ii_ * 8192), 16, 0, 0); \
        __builtin_amdgcn_global_load_lds((const unsigned*)(Vh + g0_ + ii_ * 8192 + voffV), (LAS unsigned*)((LAS unsigned char*)V_lds + (bi) * 16384 + wid * 1024 + ii_ * 8192), 16, 0, 0); } } while (0)
    STAGE(0, 0);
    asm volatile("s_waitcnt vmcnt(0) lgkmcnt(0)" ::: "memory");
    __syncthreads();
#pragma nounroll
    for (int t = 0; t < NT; ++t) {
        const int cur = t & 1;
        if (t + 1 < NT) STAGE(t + 1, cur ^ 1);
        bool active = true; int br = 0;
        if (MODE == 1 && t >= 4) { br = ulo + t - 4; active = (br >= r0w) && (br <= r0w + 7); }
        if (active) {
            const char* Kc = K_lds + cur * 16384; const int vb = vb0 + cur * 16384;
            bf16x8 pa[NMAP][4];
#pragma unroll
            for (int mp = 0; mp < NMAP; ++mp) {
                SBAR();
                f32x16 p0 = f32x16{}, p1 = f32x16{};
                if (MODE == 1 && FAST && t >= 4) { p0 = negm0; p1 = negm1; }
#pragma unroll
                for (int d0 = 0; d0 < KD0; ++d0) { const int dd = (MODE == 0 ? mp * 4 : 0) + d0; const int off = koff[dd & 3] + (dd >> 2) * 128;
                    const bf16x8 k0 = *(const bf16x8*)(Kc + off); const bf16x8 k1 = *(const bf16x8*)(Kc + off + 8192);
                    const bf16x8 qf = *(const bf16x8*)(Qw + off);
                    p0 = __builtin_amdgcn_mfma_f32_32x32x16_bf16(k0, qf, p0, 0, 0, 0);
                    p1 = __builtin_amdgcn_mfma_f32_32x32x16_bf16(k1, qf, p1, 0, 0, 0);
                    if ((d0 & 1) == 1) SBAR(); }
                if (MODE == 1 && FAST && t >= 4) {
                    const float* bp = rpbs + (br - qrow + 7) * 31 + 15 - (half * 32 + r32) + 4 * hi;
#pragma unroll
                    for (int r = 0; r < 16; ++r) { p0[r] += bp[(r & 3) + 8 * (r >> 2)]; p1[r] += bp[32 + (r & 3) + 8 * (r >> 2)]; }
                }
                if (MODE == 1 && !FAST && t >= 4) {
                    const int j = half * 32 + r32, c0 = min(max(j - 8, 0), 48);
                    const float* bp = rpbs + (br - qrow + 7) * 31 + 15 - j;
#pragma unroll
                    for (int r = 0; r < 16; ++r) { const int kc = crow(r, hi); const bool ok = (unsigned)(kc - c0) < 16u; const float bv = bp[ok ? kc : j];
                        p0[r] = ok ? p0[r] + bv : -1e30f; }
#pragma unroll
                    for (int r = 0; r < 16; ++r) { const int kc = 32 + crow(r, hi); const bool ok = (unsigned)(kc - c0) < 16u; const float bv = bp[ok ? kc : j];
                        p1[r] = ok ? p1[r] + bv : -1e30f; }
                }
                float alpha = 1.f;
                if (FAST) {
                    float psa = 0.f, psb = 0.f;
#pragma unroll
                    for (int r = 0; r < 16; ++r) { p0[r] = __builtin_amdgcn_exp2f(p0[r]); psa += p0[r]; }
#pragma unroll
                    for (int r = 0; r < 16; ++r) { p1[r] = __builtin_amdgcn_exp2f(p1[r]); psb += p1[r]; }
                    l_reg[mp] += psa + psb;
                } else {
                float pmax = p0[0];
#pragma unroll
                for (int r = 1; r < 16; ++r) pmax = fmaxf(pmax, p0[r]);
#pragma unroll
                for (int r = 0; r < 16; ++r) pmax = fmaxf(pmax, p1[r]);
                { auto rr = __builtin_amdgcn_permlane32_swap(__float_as_uint(pmax), __float_as_uint(pmax), false, false);
                  pmax = fmaxf(__uint_as_float(rr[0]), __uint_as_float(rr[1])); }
                float mn = m_reg[mp];
                if (!__all(pmax - m_reg[mp] <= THR)) { mn = fmaxf(m_reg[mp], pmax); alpha = __builtin_amdgcn_exp2f(m_reg[mp] - mn); m_reg[mp] = mn; }
                float ps = 0.f;
#pragma unroll
                for (int r = 0; r < 16; ++r) { p0[r] = __builtin_amdgcn_exp2f(p0[r] - mn); ps += p0[r]; }
#pragma unroll
                for (int r = 0; r < 16; ++r) { p1[r] = __builtin_amdgcn_exp2f(p1[r] - mn); ps += p1[r]; }
                { auto rr = __builtin_amdgcn_permlane32_swap(__float_as_uint(ps), __float_as_uint(ps), false, false);
                  ps = __uint_as_float(rr[0]) + __uint_as_float(rr[1]); }
                l_reg[mp] = l_reg[mp] * alpha + ps;
                }
#define PK4(P, BASE, OUT) do { u32x4 w = {cvtpk(P[BASE + 0], P[BASE + 1]), cvtpk(P[BASE + 2], P[BASE + 3]), cvtpk(P[BASE + 4], P[BASE + 5]), cvtpk(P[BASE + 6], P[BASE + 7])}; \
    OUT = *reinterpret_cast<bf16x8*>(&w); } while (0)
                PK4(p0, 0, pa[mp][0]); PK4(p0, 8, pa[mp][1]); PK4(p1, 0, pa[mp][2]); PK4(p1, 8, pa[mp][3]);
#undef PK4
                if (!FAST && __any(alpha < 1.f)) {
                    if (hi == 0) wsf[r32] = alpha;
                    asm volatile("s_waitcnt lgkmcnt(0)" ::: "memory");
#pragma unroll
                    for (int r = 0; r < 16; ++r) { const float al = wsf[crow(r, hi)];
#pragma unroll
                        for (int d = 0; d < 4; ++d) o[mp][d][r] *= al; }
                }
            }
            SBAR();
            pv_all<NMAP, 0>(o, vb, pa); pv_all<NMAP, 1>(o, vb, pa); pv_all<NMAP, 2>(o, vb, pa); pv_all<NMAP, 3>(o, vb, pa);
        }
        asm volatile("s_waitcnt vmcnt(0)" ::: "memory");
        __syncthreads();
    }
#undef TROW
#undef STAGE
    if (FAST) {
        bool bad = false;
#pragma unroll
        for (int mp = 0; mp < NMAP; ++mp) { auto rr = __builtin_amdgcn_permlane32_swap(__float_as_uint(l_reg[mp]), __float_as_uint(l_reg[mp]), false, false);
            l_reg[mp] = __uint_as_float(rr[0]) + __uint_as_float(rr[1]); bad = bad || !(l_reg[mp] <= 1.0e30f) || !(l_reg[mp] >= 1.0e-30f); }
        if (lane == 0) rpbz[wid] = __any(bad) ? 1.f : 0.f;
        __syncthreads();
        float anyb = 0.f;
#pragma unroll
        for (int w = 0; w < 8; ++w) anyb += rpbz[w];
        __syncthreads();
        if (anyb != 0.f) return 1;
    }
    const float lam = MODE == 0 ? a.lam[0] : 0.f;
    if (hi == 0) { wsf[r32] = 1.f / l_reg[0]; if (MODE == 0) wsf[32 + r32] = lam / l_reg[NMAP - 1]; }
    asm volatile("s_waitcnt lgkmcnt(0)" ::: "memory");
    const size_t obase = ((size_t)b * SEQ + qtok) * DM + (MODE == 0 ? 0 : 1024) + h * 128 + r32;
    float sg[4];
#pragma unroll
    for (int d = 0; d < 4; ++d) sg[d] = MODE == 0 ? a.subln_g[d * 32 + r32] * 0.8f : 1.f;
    bf16_t gq[16][4];
#pragma unroll
    for (int r = 0; r < 16; ++r)
#pragma unroll
        for (int d = 0; d < 4; ++d) gq[r][d] = a.G[obase + (size_t)crow(r, hi) * DM + d * 32];
    asm volatile("s_waitcnt vmcnt(0)" ::: "memory"); SBAR();
#pragma unroll
    for (int r = 0; r < 16; ++r) {
        const int cr = crow(r, hi);
        const float ra = wsf[cr];
        float v[4];
        if (MODE == 0) {
            const float rb = wsf[32 + cr];
            float ss = 0.f;
#pragma unroll
            for (int d = 0; d < 4; ++d) { v[d] = o[0][d][r] * ra - o[NMAP - 1][d][r] * rb; ss += v[d] * v[d]; }
            ss += __shfl_xor(ss, 1); ss += __shfl_xor(ss, 2); ss += __shfl_xor(ss, 4); ss += __shfl_xor(ss, 8); ss += __shfl_xor(ss, 16);
            const float rstd = rsqrtf(ss * (1.f / 128.f) + 1e-5f);
#pragma unroll
            for (int d = 0; d < 4; ++d) v[d] *= rstd * sg[d];
        } else {
#pragma unroll
            for (int d = 0; d < 4; ++d) v[d] = o[0][d][r] * ra;
        }
        const size_t ro = obase + (size_t)cr * DM;
#pragma unroll
        for (int d = 0; d < 4; ++d) { const float gg = bf2f(gq[r][d]); a.MIX[ro + d * 32] = (bf16_t)(cvtpk(v[d] * gg, 0.f) & 0xffffu); }
    }
    return 0;
}

struct Params {
    const float *x, *c, *ctx, *c_ctx, *norm_g, *w_mod, *b_mod, *w_in, *w_out, *lq1, *lk1, *lq2, *lk2, *subln_g, *rpb, *final_g;
    float* out; unsigned char* ws;
};

__device__ __forceinline__ void transpose_item(const float* W, int K, int N, bf16_t* WT, LAS float* scr, int item, int lane, int perm_below) {
    const int nblk = N / 32, kb = item / nblk, nb = item % nblk, k0 = 64 * kb, n0 = 32 * nb;
#pragma unroll 8
    for (int i = 0; i < 32; ++i) { const int kk = 2 * i + (lane >> 5); scr[kk * 33 + (lane & 31)] = W[(size_t)(k0 + kk) * N + n0 + (lane & 31)]; }
    asm volatile("s_waitcnt lgkmcnt(0)" ::: "memory");
    const int c = lane & 7; const bool pr = n0 < perm_below;
#pragma unroll
    for (int j = 0; j < 4; ++j) { const int n = (lane >> 3) + 8 * j; const int ns = pr ? pg8::perm32inv(n) : n; const LAS float* s = scr + (8 * c) * 33 + ns;
        u32x4 o; o.x = cvtpk(s[0 * 33], s[1 * 33]); o.y = cvtpk(s[2 * 33], s[3 * 33]); o.z = cvtpk(s[4 * 33], s[5 * 33]); o.w = cvtpk(s[6 * 33], s[7 * 33]);
        *(u32x4*)(WT + (size_t)(n0 + n) * K + k0 + 8 * c) = o; }
    asm volatile("s_waitcnt lgkmcnt(0)" ::: "memory");
}

__global__ void __launch_bounds__(512, 2) fwd_megakernel(Params p) {
    extern __shared__ __attribute__((aligned(16))) unsigned char lds[];
    cg::grid_group grid = cg::this_grid();
    const int bid = blockIdx.x, G = gridDim.x;
#define TIDS() int tid = threadIdx.x; asm volatile("" : "+v"(tid)); const int lane = tid & 63, wid = __builtin_amdgcn_readfirstlane(tid >> 6); (void)lane; (void)wid;
#define WSPTRS() size_t wsz_ = 0; asm volatile("" : "+s"(wsz_)); unsigned char* ws = p.ws + wsz_;     \
    float* mod = (float*)(ws + WS_MOD); float* lamp = (float*)(ws + WS_LAM); float* rope = (float*)(ws + WS_ROPE); \
    bf16_t* WinT = (bf16_t*)(ws + WS_WIN); bf16_t* WoutT = (bf16_t*)(ws + WS_WOUT); bf16_t* HX = (bf16_t*)(ws + WS_HX); \
    bf16_t* QA = (bf16_t*)(ws + WS_QA); bf16_t* KA = (bf16_t*)(ws + WS_KA); bf16_t* VA = (bf16_t*)(ws + WS_VA); \
    bf16_t* QB = (bf16_t*)(ws + WS_QB); bf16_t* KB = (bf16_t*)(ws + WS_KB); bf16_t* VB = (bf16_t*)(ws + WS_VB); \
    bf16_t* GB = (bf16_t*)(ws + WS_G); bf16_t* MIX = (bf16_t*)(ws + WS_MIX); \
    (void)mod; (void)lamp; (void)rope; (void)WinT; (void)WoutT; (void)HX; (void)QA; (void)KA; (void)VA; (void)QB; (void)KB; (void)VB; (void)GB; (void)MIX;
    { WSPTRS(); TIDS();
    if (bid < 192) {
        const int cgp = bid % 12, kc = bid / 12;
        float* sl = (float*)lds;
        for (int i = tid; i < 640; i += 512) { const int bb = i >> 7, k = kc * 128 + (i & 127); const float v = bb < 4 ? p.c[bb * DM + k] : p.c_ctx[k]; sl[i] = v / (1.f + expf(-v)); }
        __syncthreads();
        const int col = cgp * 512 + tid;
        float a0 = 0.f, a1 = 0.f, a2 = 0.f, a3 = 0.f, a4 = 0.f;
        const float* wp = p.w_mod + (size_t)(kc * 128) * 6144 + col;
#pragma unroll 8
        for (int k = 0; k < 128; ++k) { const float w = wp[(size_t)k * 6144]; a0 += sl[k] * w; a1 += sl[128 + k] * w; a2 += sl[256 + k] * w; a3 += sl[384 + k] * w; a4 += sl[512 + k] * w; }
        if (kc == 0) { const float bm = p.b_mod[col]; a0 += bm; a1 += bm; a2 += bm; a3 += bm; a4 += bm; }
        atomicAdd(mod + col, a0); atomicAdd(mod + 6144 + col, a1); atomicAdd(mod + 2 * 6144 + col, a2); atomicAdd(mod + 3 * 6144 + col, a3); atomicAdd(mod + 4 * 6144 + col, a4);
        __syncthreads();
    } else if (bid < 196) {
        const int idx = (bid - 192) * 512 + tid, pos = idx >> 4, i = idx & 15;
        const float inv = powf(10000.f, -(float)i / 16.f), ang = (float)pos * inv;
        rope[2 * idx] = cosf(ang); rope[2 * idx + 1] = sinf(ang);
    } else if (bid == 196 && wid == 0) {
        const float d1 = wave_sum(p.lq1[lane] * p.lk1[lane]), d2 = wave_sum(p.lq2[lane] * p.lk2[lane]);
        if (lane == 0) lamp[0] = expf(d1) - expf(d2) + 0.2f;
    }
    {
        LAS float* scr = (LAS float*)((LAS unsigned char*)lds + wid * 16384);
        const int gw = bid * 8 + wid, NGW = G * 8;
        constexpr int I_IN = (DM / 64) * (INC / 32), I_OUT = (DM / 64) * (DM / 32);
        for (int it = gw; it < I_IN + I_OUT; it += NGW) {
            if (it < I_IN) transpose_item(p.w_in, DM, INC, WinT, scr, it, lane, 2048);
            else transpose_item(p.w_out, DM, DM, WoutT, scr, it - I_IN, lane, 0);
        }
    }
    }
    grid.sync();

    { WSPTRS(); TIDS();
        const int gw = bid * 8 + wid, NGW = G * 8;
        for (int R = gw; R < NTOK + NCTX; R += NGW) {
            const float* src = R < NTOK ? p.x + (size_t)R * DM : p.ctx + (size_t)(R - NTOK) * DM;
            const float* mr = mod + (R < NTOK ? (R >> 13) : 4) * 6144;
            f32x4 v[8]; float ss = 0.f;
#pragma unroll
            for (int j = 0; j < 8; ++j) { v[j] = *(const f32x4*)(src + j * 256 + lane * 4); ss += (v[j].x * v[j].x + v[j].y * v[j].y) + (v[j].z * v[j].z + v[j].w * v[j].w); }
            const float rstd = rsqrtf(wave_sum(ss) * (1.f / DM) + 1e-6f);
            bf16_t* orow = HX + (size_t)R * DM;
#pragma unroll
            for (int j = 0; j < 8; ++j) { const int k = j * 256 + lane * 4;
                const f32x4 g4 = *(const f32x4*)(p.norm_g + k), sh = *(const f32x4*)(mr + k), sc4 = *(const f32x4*)(mr + 2048 + k);
                const f32x4 y = v[j] * rstd * g4 * (sc4 + 1.f) + sh;
                uint2 w; w.x = cvtpk(y.x, y.y); w.y = cvtpk(y.z, y.w); *(uint2*)(orow + k) = w; }
        }
    }
    grid.sync();

    { WSPTRS();
        pg8::Gemm g{HX, WinT, DM}; pg8::Order S; S.init(NTOK / 256, INC / 256, G, bid, 64);
        EpiIn E{QA, KA, VA, QB, KB, VB, GB, rope};
        pg8::gemm_phase<EpiIn, pg8::Order>((LAS unsigned char*)lds, g, S, E);
    }
    grid.sync();

    { WSPTRS();
        AttnP ap{QA, KA, VA, QB, KB, VB, GB, MIX, p.subln_g, p.rpb, lamp};
        unsigned badmask = 0u; int it = 0;
        for (int L = bid; L < 1024; L += G, ++it) { const int xcd = L & 7, rest = L >> 3, blk = rest & 31, bh = xcd + 8 * (rest >> 5);
            if (attn_item<0, true>(ap, bh >> 3, bh & 7, blk, (char*)lds)) badmask |= 1u << (it & 31); }
        badmask = __builtin_amdgcn_readfirstlane(badmask);
        if (badmask) { it = 0;
            for (int L = bid; L < 1024; L += G, ++it) { const int xcd = L & 7, rest = L >> 3, blk = rest & 31, bh = xcd + 8 * (rest >> 5);
                if ((badmask >> (it & 31)) & 1u) attn_item<0, false>(ap, bh >> 3, bh & 7, blk, (char*)lds); } }
    }
    { WSPTRS();
        AttnP ap{QA, KA, VA, QB, KB, VB, GB, MIX, p.subln_g, p.rpb, lamp};
        unsigned badmask = 0u; int it = 0;
        for (int L = bid; L < 1024; L += G, ++it) { const int xcd = L & 7, rest = L >> 3, blk = rest & 31, bh = xcd + 8 * (rest >> 5);
            if (attn_item<1, true>(ap, bh >> 3, bh & 7, blk, (char*)lds)) badmask |= 1u << (it & 31); }
        badmask = __builtin_amdgcn_readfirstlane(badmask);
        if (badmask) { it = 0;
            for (int L = bid; L < 1024; L += G, ++it) { const int xcd = L & 7, rest = L >> 3, blk = rest & 31, bh = xcd + 8 * (rest >> 5);
                if ((badmask >> (it & 31)) & 1u) attn_item<1, false>(ap, bh >> 3, bh & 7, blk, (char*)lds); } }
    }
    grid.sync();

    { WSPTRS();
        pg8::Gemm g{MIX, WoutT, DM}; pg8::OrderPanel S{bid};
        EpiOutNorm E{p.x, mod, p.final_g, p.out, (float*)(ws + WS_XCH), (unsigned*)(ws + 126976), (LAS float*)((LAS unsigned char*)lds + 131072)};
        pg8::gemm_phase<EpiOutNorm, pg8::OrderPanel>((LAS unsigned char*)lds, g, S, E);
    }
}

extern "C" void kernel_launch(void* const* d_in, const int* in_sizes, int n_in, void* d_out, int out_size, void* d_ws, size_t ws_size, hipStream_t stream) {
    static int grid_blocks = 0;
    if (grid_blocks == 0) {
        if (n_in != 16 || in_sizes[0] != NTOK * DM || out_size != NTOK * DM || ws_size < WS_END) {
            fprintf(stderr, "kernel_launch: shape mismatch (n_in %d in0 %d out %d ws %zu)\n", n_in, n_in > 0 ? in_sizes[0] : -1, out_size, ws_size); grid_blocks = -1; return; }
        int dev = 0, cus = 0, per_cu = 0;
        hipGetDevice(&dev);
        hipDeviceGetAttribute(&cus, hipDeviceAttributeMultiprocessorCount, dev);
        if (hipFuncSetAttribute((const void*)fwd_megakernel, hipFuncAttributeMaxDynamicSharedMemorySize, LDS_BYTES) != hipSuccess) { fprintf(stderr, "kernel_launch: hipFuncSetAttribute failed\n"); grid_blocks = -1; return; }
        hipOccupancyMaxActiveBlocksPerMultiprocessor(&per_cu, (const void*)fwd_megakernel, 512, LDS_BYTES);
        if (per_cu < 1) { fprintf(stderr, "kernel_launch: occupancy query returned %d\n", per_cu); per_cu = 1; }
        (void)hipGetLastError();
        if (cus != 256) { fprintf(stderr, "kernel_launch: built for a 256-CU device (got %d CUs)\n", cus); grid_blocks = -1; return; }
        grid_blocks = cus;
    }
    if (grid_blocks < 0) return;
    hipMemsetAsync((char*)d_ws + WS_MOD, 0, 128 * 1024, stream);
    Params p{};
    p.x = (const float*)d_in[0]; p.c = (const float*)d_in[1]; p.ctx = (const float*)d_in[2]; p.c_ctx = (const float*)d_in[3]; p.norm_g = (const float*)d_in[4];
    p.w_mod = (const float*)d_in[5]; p.b_mod = (const float*)d_in[6]; p.w_in = (const float*)d_in[7]; p.w_out = (const float*)d_in[8];
    p.lq1 = (const float*)d_in[9]; p.lk1 = (const float*)d_in[10]; p.lq2 = (const float*)d_in[11]; p.lk2 = (const float*)d_in[12];
    p.subln_g = (const float*)d_in[13]; p.rpb = (const float*)d_in[14]; p.final_g = (const float*)d_in[15];
    p.out = (float*)d_out; p.ws = (unsigned char*)d_ws;
    void* args[] = {&p};
    hipError_t e = hipLaunchCooperativeKernel((const void*)fwd_megakernel, dim3(grid_blocks), dim3(512), args, LDS_BYTES, stream);
    if (e != hipSuccess) fprintf(stderr, "cooperative launch failed: %s (grid %d)\n", hipGetErrorString(e), grid_blocks);
}
```

```cpp
#include <hip/hip_runtime.h>
#include <hip/hip_cooperative_groups.h>
#include <cstdio>
#include <cstdint>
namespace cg = cooperative_groups;

#define LAS __attribute__((address_space(3)))
typedef unsigned short bf16_t;
typedef short bf16x8 __attribute__((ext_vector_type(8)));
typedef short s16x4 __attribute__((ext_vector_type(4)));
typedef float f32x4 __attribute__((ext_vector_type(4)));
typedef float f32x16 __attribute__((ext_vector_type(16)));
typedef unsigned u32x4 __attribute__((ext_vector_type(4)));

constexpr int DM = 2048, NB = 4, SEQ = 8192, CTX = 256, NTOK = NB * SEQ, NCTX = NB * CTX, INC = 8192, SKV = SEQ + CTX;
constexpr float LOG2E = 1.4426950408889634f;
constexpr float C2A = 0.125f * LOG2E;
constexpr float C2B = 0.08838834764831845f * LOG2E;
constexpr size_t MiB = 1u << 20;
constexpr size_t WS_MOD = 0, WS_LAM = 128 * 1024, WS_ROPE = 192 * 1024, WS_WIN = 1 * MiB, WS_WOUT = 33 * MiB, WS_HX = 48 * MiB;
constexpr size_t WS_QA = 192 * MiB, WS_KA = 256 * MiB, WS_VA = 328 * MiB, WS_QB = 400 * MiB, WS_KB = 464 * MiB, WS_VB = 536 * MiB;
constexpr size_t WS_G = 608 * MiB, WS_MIX = 736 * MiB, WS_XCH = 864 * MiB, WS_END = 866 * MiB;
constexpr int LDS_BYTES = 136192;

__device__ __forceinline__ unsigned cvtpk(float lo, float hi) { unsigned r; asm volatile("v_cvt_pk_bf16_f32 %0, %1, %2" : "=v"(r) : "v"(lo), "v"(hi)); return r; }
__device__ __forceinline__ float fadd_s(float a, float b) { float r; asm("v_add_f32_e32 %0, %1, %2" : "=v"(r) : "v"(a), "v"(b)); return r; }
__device__ __forceinline__ float bf2f(bf16_t v) { return __uint_as_float((unsigned)v << 16); }
__device__ __forceinline__ float silu_f(float v) { return v * __builtin_amdgcn_rcpf(1.f + __builtin_amdgcn_exp2f(-v * LOG2E)); }
__device__ __forceinline__ float wave_sum(float v) {
#pragma unroll
    for (int o = 1; o < 64; o <<= 1) v += __shfl_xor(v, o);
    return v;
}

namespace pg8 {
constexpr int BM = 256, BK = 64, HALF = 128, HTB = HALF * BK * 2, NXCD = 8, WGM = 8;
__host__ __device__ __forceinline__ int lds_byte(int r, int c) { const int st = (r >> 4) * 2 + (c >> 5), rr = r & 15, cc = c & 31, ob = rr * 64 + cc * 2; return st * 1024 + (ob ^ (((ob >> 9) & 1) << 5)); }
__host__ __device__ __forceinline__ void stage_rc(int b, int& R, int& C) { const int st = b / 1024, sb = b % 1024, swz = sb ^ (((sb >> 9) & 1) << 5); R = (st >> 1) * 16 + swz / 64; C = (st & 1) * 32 + (swz % 64) / 2; }
__host__ __device__ __forceinline__ int perm32(int rho) { const int n = rho >> 4, i = rho & 15; return 8 * (i >> 2) + 4 * n + (i & 3); }
__host__ __device__ __forceinline__ int perm32inv(int q) { return 16 * ((q >> 2) & 1) + 4 * (q >> 3) + (q & 3); }
struct Unit { int pm, pn; };
struct Gemm { const bf16_t* A; const bf16_t* Bt; int K; };

struct Order {
    int nM, nN, nwg, G, c, nX;
    __device__ void init(int nM_, int nN_, int G_, int c_, int nX_) { nM = nM_; nN = nN_; nwg = nM * nN; G = G_; c = c_; nX = nX_; }
    __device__ bool next(int i, Unit& u) const {
        const int L = i * G + c; if (L >= nwg + nX) return false;
        if (L >= nwg) { const int e = L - nwg; u.pm = nM + (e >> 4); const int q = e & 15; u.pn = q < 8 ? 4 + q : 12 + q; return true; }
        int wgid = L; { const int q = nwg / NXCD, r = nwg % NXCD, xcd = wgid % NXCD, off = wgid / NXCD; wgid = (xcd < r ? xcd * (q + 1) : r * (q + 1) + (xcd - r) * q) + off; }
        const int nig = WGM * nN, gid = wgid / nig, fm = gid * WGM, gsz = (nM - fm) < WGM ? (nM - fm) : WGM;
        u.pm = fm + ((wgid % nig) % gsz); u.pn = (wgid % nig) / gsz; return true;
    }
};

struct OrderPanel { int c; __device__ bool next(int i, Unit& u) const { if (i >= 4) return false; const int xcd = c & 7, j = c >> 3; u.pm = xcd * 4 + (j >> 3) + 32 * i; u.pn = j & 7; return true; } };

template <class Epi, class Sched>
__device__ __forceinline__ void gemm_phase(LAS unsigned char* lds, const Gemm g, const Sched& S, const Epi& E) {
    int tid = threadIdx.x; asm volatile("" : "+v"(tid));
    const int wid = __builtin_amdgcn_readfirstlane(tid >> 6), lane = tid & 63, wr = wid >> 2, wc = wid & 3, fr = lane & 15, fq = lane >> 4;
    const int K = g.K, nt = K / BK;
    unsigned voffA[2], voffB[2];
#pragma unroll
    for (int i = 0; i < 2; ++i) { int R, C; stage_rc(tid * 16 + i * 8192, R, C); const int Rb = (R & ~31) + perm32(R & 31);
        voffA[i] = (unsigned)(R * K + C) * 2u; voffB[i] = (unsigned)(Rb * K + C) * 2u; }
    const size_t kstep = (size_t)(BK * 2);
    const size_t hstep = (size_t)HALF * K * 2;
    const size_t tstep = 2 * hstep;
    const unsigned ldsw = (unsigned)wid * 1024u;
    const int aoff = lds_byte(wr * 64 + fr, fq * 8), boff = lds_byte(wc * 32 + fr, fq * 8);
#define PG8_SA(b, h) (((b) * 2 + (h)) * HTB)
#define PG8_SB(b, h) ((4 + (b) * 2 + (h)) * HTB)
#define PG8_STAGE(bufoff, gbase, voff) do { _Pragma("unroll") for (int _i = 0; _i < 2; ++_i) \
        __builtin_amdgcn_global_load_lds((const unsigned*)((const char*)(gbase) + (voff)[_i]), (LAS unsigned*)(lds + (bufoff) + ldsw + _i * 8192), 16, 0, 0); } while (0)
#define PG8_LDA(dst, b, h) do { _Pragma("unroll") for (int m = 0; m < 4; ++m) _Pragma("unroll") for (int k = 0; k < 2; ++k) dst[m][k] = *(const LAS bf16x8*)(lds + PG8_SA(b, h) + aoff + m * 2048 + k * 1024); } while (0)
#define PG8_LDB(dst, b, h) do { _Pragma("unroll") for (int n = 0; n < 2; ++n) _Pragma("unroll") for (int k = 0; k < 2; ++k) dst[n][k] = *(const LAS bf16x8*)(lds + PG8_SB(b, h) + boff + n * 2048 + k * 1024); } while (0)
#define PG8_MMA(ai, bj, At, Bt) do { __builtin_amdgcn_s_setprio(1); _Pragma("unroll") for (int m = 0; m < 4; ++m) _Pragma("unroll") for (int n = 0; n < 2; ++n) _Pragma("unroll") for (int k = 0; k < 2; ++k) \
        acc[ai][bj][m][n] = __builtin_amdgcn_mfma_f32_16x16x32_bf16(Bt[n][k], At[m][k], acc[ai][bj][m][n], 0, 0, 0); __builtin_amdgcn_s_setprio(0); } while (0)
#define PG8_WAIT_V(n) asm volatile("s_waitcnt vmcnt(" #n ")" ::: "memory")
#define PG8_WAIT_L(n) asm volatile("s_waitcnt lgkmcnt(" #n ")" ::: "memory")
#define PG8_BAR __builtin_amdgcn_s_barrier()
#define PG8_SCHED __builtin_amdgcn_sched_barrier(0)
    Unit cur, nxt; int ui = 0;
    if (!S.next(0, cur)) return;
    f32x4 acc[2][2][4][2];
#pragma unroll
    for (int a = 0; a < 2; ++a)
#pragma unroll
        for (int b = 0; b < 2; ++b)
#pragma unroll
            for (int m = 0; m < 4; ++m)
#pragma unroll
                for (int n = 0; n < 2; ++n) acc[a][b][m][n] = (f32x4){0.f, 0.f, 0.f, 0.f};
    bf16x8 At[4][2], B0[2][2], B1[2][2];
    const char* cA = (const char*)g.A + (size_t)cur.pm * tstep; const char* cB = (const char*)g.Bt + (size_t)cur.pn * tstep;
    PG8_STAGE(PG8_SB(0, 0), cB, voffB); PG8_STAGE(PG8_SB(0, 1), cB + hstep, voffB); PG8_STAGE(PG8_SA(0, 0), cA, voffA); PG8_STAGE(PG8_SA(0, 1), cA + hstep, voffA);
    if (wr == 1) PG8_BAR;
    PG8_WAIT_V(2); PG8_BAR;
    PG8_STAGE(PG8_SB(1, 0), cB + kstep, voffB); PG8_STAGE(PG8_SA(1, 0), cA + kstep, voffA); PG8_STAGE(PG8_SB(1, 1), cB + hstep + kstep, voffB);
    PG8_WAIT_V(6); PG8_BAR;
    for (;;) {
        const bool has_next = S.next(ui + 1, nxt);
        const char* nA = has_next ? (const char*)g.A + (size_t)nxt.pm * tstep : cA; const char* nB = has_next ? (const char*)g.Bt + (size_t)nxt.pn * tstep : cB;
        for (int t = 0; t < nt; t += 2) {
            const bool last = (t == nt - 2);
            const char* a1 = cA + (size_t)(t + 1) * kstep;
            const char* a2 = last ? nA : cA + (size_t)(t + 2) * kstep; const char* b2 = last ? nB : cB + (size_t)(t + 2) * kstep;
            const char* a3 = a2 + kstep; const char* b3 = b2 + kstep;
            PG8_LDB(B0, 0, 0); PG8_LDB(B1, 0, 1); PG8_SCHED; PG8_LDA(At, 0, 0); PG8_STAGE(PG8_SA(1, 1), a1 + hstep, voffA);
            PG8_WAIT_V(8); PG8_WAIT_L(0); PG8_BAR; PG8_MMA(0, 0, At, B0); PG8_MMA(0, 1, At, B1); PG8_BAR; PG8_SCHED;
            PG8_LDA(At, 0, 1); PG8_STAGE(PG8_SB(0, 0), b2, voffB); PG8_STAGE(PG8_SB(0, 1), b2 + hstep, voffB); PG8_STAGE(PG8_SA(0, 0), a2, voffA);
            PG8_WAIT_V(8); PG8_WAIT_L(0); PG8_BAR; PG8_MMA(1, 0, At, B0); PG8_MMA(1, 1, At, B1); PG8_BAR; PG8_SCHED;
            PG8_LDB(B0, 1, 0); PG8_LDB(B1, 1, 1); PG8_SCHED; PG8_LDA(At, 1, 0); PG8_STAGE(PG8_SA(0, 1), a2 + hstep, voffA);
            PG8_WAIT_V(8); PG8_WAIT_L(0); PG8_BAR; PG8_MMA(0, 0, At, B0); PG8_MMA(0, 1, At, B1); PG8_BAR; PG8_SCHED;
            PG8_LDA(At, 1, 1); PG8_STAGE(PG8_SB(1, 0), b3, voffB); PG8_STAGE(PG8_SB(1, 1), b3 + hstep, voffB); PG8_STAGE(PG8_SA(1, 0), a3, voffA);
            PG8_WAIT_V(8); PG8_WAIT_L(0); PG8_BAR; PG8_MMA(1, 0, At, B0); PG8_MMA(1, 1, At, B1); PG8_BAR; PG8_SCHED;
        }
        if (wr == 0) PG8_BAR;
        E(acc, cur, wr, wc, fr, fq);
        if (!has_next) break;
#pragma unroll
        for (int a = 0; a < 2; ++a)
#pragma unroll
            for (int b = 0; b < 2; ++b)
#pragma unroll
                for (int m = 0; m < 4; ++m)
#pragma unroll
                    for (int n = 0; n < 2; ++n) acc[a][b][m][n] = (f32x4){0.f, 0.f, 0.f, 0.f};
        cur = nxt; cA = nA; cB = nB; ++ui;
        if (wr == 1) PG8_BAR;
    }
    PG8_WAIT_V(0);
    PG8_BAR;
#undef PG8_SA
#undef PG8_SB
#undef PG8_STAGE
#undef PG8_LDA
#undef PG8_LDB
#undef PG8_MMA
#undef PG8_WAIT_V
#undef PG8_WAIT_L
#undef PG8_BAR
#undef PG8_SCHED
}
}

struct EpiIn {
    static constexpr bool PERM = true;
    bf16_t *QA, *KA, *VA, *QB, *KB, *VB, *G; const float* rope;
    __device__ __forceinline__ void operator()(const f32x4 (&acc)[2][2][4][2], const pg8::Unit& u, int wr, int wc, int fr, int fq) const {
        const int type = u.pn >> 2, hb = (u.pn & 3) * 2;
        const bool isctx = u.pm >= 128;
        const int b = isctx ? u.pm - 128 : (u.pm >> 5);
        const int sbase = (isctx ? SEQ : (u.pm & 31) * 256) + wr * 64 + fr;
        const int dcol = wc * 32 + 8 * fq;
        if (type == 3 || type == 7) {
            bf16_t* gp = G + ((size_t)b * SEQ + sbase) * DM + (type == 7 ? 1024 : 0) + hb * 128 + dcol;
#pragma unroll
            for (int ai = 0; ai < 2; ++ai)
#pragma unroll
                for (int m = 0; m < 4; ++m)
#pragma unroll
                    for (int bj = 0; bj < 2; ++bj) {
                        const f32x4 v0 = acc[ai][bj][m][0], v1 = acc[ai][bj][m][1];
                        u32x4 w; w.x = cvtpk(silu_f(v0[0]), silu_f(v0[1])); w.y = cvtpk(silu_f(v0[2]), silu_f(v0[3]));
                        w.z = cvtpk(silu_f(v1[0]), silu_f(v1[1])); w.w = cvtpk(silu_f(v1[2]), silu_f(v1[3]));
                        *(u32x4*)(gp + (size_t)(ai * 128 + m * 16) * DM + bj * 128) = w;
                    }
            return;
        }
        bf16_t* base; int SK; float sc = 1.f;
        switch (type) {
            case 0: base = QA; SK = SEQ; sc = C2A; break;
            case 1: base = KA; SK = SKV; break;
            case 2: base = VA; SK = SKV; break;
            case 4: base = QB; SK = SEQ; sc = C2B; break;
            case 5: base = KB; SK = SKV; break;
            default: base = VB; SK = SKV; break;
        }
        const bool dorope = (type <= 1) && !isctx;
        bf16_t* op = base + ((size_t)(b * 8 + hb) * SK + sbase) * 128 + dcol;
        const size_t hstride = (size_t)SK * 128;
#pragma unroll
        for (int ai = 0; ai < 2; ++ai)
#pragma unroll
            for (int m = 0; m < 4; ++m) {
                f32x4 cs0 = {1.f, 0.f, 1.f, 0.f}, cs1 = {1.f, 0.f, 1.f, 0.f};
                if (dorope) { const int s = sbase + ai * 128 + m * 16; const int pos = (wc & 1) ? (s & 63) : (s >> 6);
                    const f32x4* rp = (const f32x4*)(rope + (size_t)(pos * 16 + 4 * fq) * 2); cs0 = rp[0]; cs1 = rp[1]; }
#pragma unroll
                for (int bj = 0; bj < 2; ++bj) {
                    const f32x4 x1 = acc[ai][bj][m][0], x2 = acc[ai][bj][m][1];
                    f32x4 y1, y2;
                    y1[0] = x1[0] * cs0[0] - x2[0] * cs0[1]; y2[0] = x2[0] * cs0[0] + x1[0] * cs0[1];
                    y1[1] = x1[1] * cs0[2] - x2[1] * cs0[3]; y2[1] = x2[1] * cs0[2] + x1[1] * cs0[3];
                    y1[2] = x1[2] * cs1[0] - x2[2] * cs1[1]; y2[2] = x2[2] * cs1[0] + x1[2] * cs1[1];
                    y1[3] = x1[3] * cs1[2] - x2[3] * cs1[3]; y2[3] = x2[3] * cs1[2] + x1[3] * cs1[3];
                    y1 = y1 * sc; y2 = y2 * sc;
                    u32x4 w; w.x = cvtpk(y1[0], y1[1]); w.y = cvtpk(y1[2], y1[3]); w.z = cvtpk(y2[0], y2[1]); w.w = cvtpk(y2[2], y2[3]);
                    *(u32x4*)(op + (size_t)(ai * 128 + m * 16) * 128 + bj * hstride) = w;
                }
            }
    }
};
struct EpiOutNorm {
    static constexpr bool PERM = true;
    const float* x; const float* mod; const float* fg; float* out; float* X; unsigned* cnt; LAS float* sc;
    __device__ __forceinline__ void operator()(f32x4 (&acc)[2][2][4][2], const pg8::Unit& u, int wr, int wc, int fr, int fq) const {
        const int row0 = u.pm * 256 + wr * 64 + fr, b = u.pm >> 5, col0 = u.pn * 256 + wc * 32 + 8 * fq;
        int tid = threadIdx.x; asm volatile("" : "+v"(tid));
        f32x4 gv[2][2];
#pragma unroll
        for (int bj = 0; bj < 2; ++bj)
#pragma unroll
            for (int n = 0; n < 2; ++n) gv[bj][n] = *(const f32x4*)(mod + b * 6144 + 4096 + col0 + bj * 128 + 4 * n);
#pragma unroll
        for (int ai = 0; ai < 2; ++ai)
#pragma unroll
            for (int m = 0; m < 4; ++m) {
                const size_t ro = (size_t)(row0 + ai * 128 + m * 16) * DM + col0;
                float s = 0.f;
#pragma unroll
                for (int bj = 0; bj < 2; ++bj) {
                    const f32x4 x0 = *(const f32x4*)(x + ro + bj * 128), x1 = *(const f32x4*)(x + ro + bj * 128 + 4);
                    const f32x4 h0 = x0 + gv[bj][0] * acc[ai][bj][m][0], h1 = x1 + gv[bj][1] * acc[ai][bj][m][1];
                    acc[ai][bj][m][0] = h0; acc[ai][bj][m][1] = h1;
                    s += (h0.x * h0.x + h0.y * h0.y) + (h0.z * h0.z + h0.w * h0.w) + (h1.x * h1.x + h1.y * h1.y) + (h1.z * h1.z + h1.w * h1.w);
                }
                s += __shfl_xor(s, 16); s += __shfl_xor(s, 32);
                if (fq == 0) sc[wc * 256 + ai * 128 + wr * 64 + m * 16 + fr] = s;
            }
        asm volatile("s_waitcnt lgkmcnt(0)" ::: "memory"); __builtin_amdgcn_s_barrier(); asm volatile("" ::: "memory");
        if (tid < 256) X[((size_t)u.pm * 8 + u.pn) * 256 + tid] = (sc[tid] + sc[256 + tid]) + (sc[512 + tid] + sc[768 + tid]);
        asm volatile("s_waitcnt vmcnt(0) lgkmcnt(0)" ::: "memory"); __builtin_amdgcn_s_barrier(); asm volatile("" ::: "memory");
        if (tid == 0) {
            unsigned* c = cnt + u.pm * 8;
            __builtin_amdgcn_fence(__ATOMIC_RELEASE, "agent");
            asm volatile("s_waitcnt vmcnt(0) lgkmcnt(0)" ::: "memory");
            __hip_atomic_fetch_add(c, 1u, __ATOMIC_RELAXED, __HIP_MEMORY_SCOPE_AGENT);
            while (__hip_atomic_load(c, __ATOMIC_RELAXED, __HIP_MEMORY_SCOPE_AGENT) < 8u) __builtin_amdgcn_s_sleep(1);
            __builtin_amdgcn_fence(__ATOMIC_ACQUIRE, "agent");
            asm volatile("s_waitcnt vmcnt(0) lgkmcnt(0)" ::: "memory");
        }
        __builtin_amdgcn_s_barrier(); asm volatile("" ::: "memory");
        if (tid < 256) { float t = 0.f;
#pragma unroll
            for (int k = 0; k < 8; ++k) t += __hip_atomic_load(X + ((size_t)u.pm * 8 + k) * 256 + tid, __ATOMIC_RELAXED, __HIP_MEMORY_SCOPE_AGENT);
            sc[1024 + tid] = rsqrtf(t * (1.f / DM) + 1e-6f); }
        asm volatile("s_waitcnt lgkmcnt(0)" ::: "memory"); __builtin_amdgcn_s_barrier(); asm volatile("" ::: "memory");
        f32x4 fv[2][2];
#pragma unroll
        for (int bj = 0; bj < 2; ++bj)
#pragma unroll
            for (int n = 0; n < 2; ++n) fv[bj][n] = *(const f32x4*)(fg + col0 + bj * 128 + 4 * n);
#pragma unroll
        for (int ai = 0; ai < 2; ++ai)
#pragma unroll
            for (int m = 0; m < 4; ++m) {
                const size_t ro = (size_t)(row0 + ai * 128 + m * 16) * DM + col0;
                const float r = sc[1024 + ai * 128 + wr * 64 + m * 16 + fr];
#pragma unroll
                for (int bj = 0; bj < 2; ++bj) {
                    *(f32x4*)(out + ro + bj * 128) = acc[ai][bj][m][0] * r * fv[bj][0];
                    *(f32x4*)(out + ro + bj * 128 + 4) = acc[ai][bj][m][1] * r * fv[bj][1];
                }
            }
    }
};

#define KSWZ(row, colB) ((row) * 256 + ((colB) ^ (((row) & 7) << 4)))
#define SBAR() __builtin_amdgcn_sched_barrier(0)
__device__ __forceinline__ int crow(int r, int hi) { return (r & 3) + 8 * (r >> 2) + 4 * hi; }
__device__ __forceinline__ int v_st(int k, int c) { const int kk = (k & ~0xC) | ((k & 4) << 1) | ((k & 8) >> 1); return ((kk >> 3) * 4 + (c >> 5)) * 512 + ((kk & 7) * 32 + (c & 31)) * 2; }
__device__ __forceinline__ int v_rd_base(int lane) { return ((lane & 3) << 3) | (((lane >> 2) & 3) << 6) | (((lane >> 4) & 1) << 5) | (((lane >> 5) & 1) << 8); }
constexpr int v_rd_off(int d0, int ks, int half) { return d0 * 512 + ks * 4096 + half * 2048; }
template <int OFF> __device__ __forceinline__ s16x4 tr_read(int vb) {
    s16x4 r; asm volatile("ds_read_b64_tr_b16 %0, %1 offset:%2" : "=&v"(r) : "v"(vb), "i"(OFF) : "memory"); return r;
}
template <int D0> __device__ __forceinline__ void pv_one(f32x16& od, int vb, bf16x8 pa0, bf16x8 pa1, bf16x8 pa2, bf16x8 pa3) {
    const s16x4 l0 = tr_read<v_rd_off(D0, 0, 0)>(vb), h0 = tr_read<v_rd_off(D0, 0, 1)>(vb), l1 = tr_read<v_rd_off(D0, 1, 0)>(vb), h1 = tr_read<v_rd_off(D0, 1, 1)>(vb);
    const s16x4 l2 = tr_read<v_rd_off(D0, 2, 0)>(vb), h2 = tr_read<v_rd_off(D0, 2, 1)>(vb), l3 = tr_read<v_rd_off(D0, 3, 0)>(vb), h3 = tr_read<v_rd_off(D0, 3, 1)>(vb);
    asm volatile("s_waitcnt lgkmcnt(0)" ::: "memory"); SBAR();
#define PK(L, H) (bf16x8){L[0], L[1], L[2], L[3], H[0], H[1], H[2], H[3]}
    od = __builtin_amdgcn_mfma_f32_32x32x16_bf16(pa0, PK(l0, h0), od, 0, 0, 0);
    od = __builtin_amdgcn_mfma_f32_32x32x16_bf16(pa1, PK(l1, h1), od, 0, 0, 0);
    od = __builtin_amdgcn_mfma_f32_32x32x16_bf16(pa2, PK(l2, h2), od, 0, 0, 0);
    od = __builtin_amdgcn_mfma_f32_32x32x16_bf16(pa3, PK(l3, h3), od, 0, 0, 0);
#undef PK
}

template <int NMAP, int D0> __device__ __forceinline__ void pv_all(f32x16 (&o)[NMAP][4], int vb, const bf16x8 (&pa)[NMAP][4]) {
    const s16x4 l0 = tr_read<v_rd_off(D0, 0, 0)>(vb), h0 = tr_read<v_rd_off(D0, 0, 1)>(vb), l1 = tr_read<v_rd_off(D0, 1, 0)>(vb), h1 = tr_read<v_rd_off(D0, 1, 1)>(vb);
    const s16x4 l2 = tr_read<v_rd_off(D0, 2, 0)>(vb), h2 = tr_read<v_rd_off(D0, 2, 1)>(vb), l3 = tr_read<v_rd_off(D0, 3, 0)>(vb), h3 = tr_read<v_rd_off(D0, 3, 1)>(vb);
    asm volatile("s_waitcnt lgkmcnt(0)" ::: "memory"); SBAR();
#define PK(L, H) (bf16x8){L[0], L[1], L[2], L[3], H[0], H[1], H[2], H[3]}
    const bf16x8 v0 = PK(l0, h0), v1 = PK(l1, h1), v2 = PK(l2, h2), v3 = PK(l3, h3);
#undef PK
#pragma unroll
    for (int mp = 0; mp < NMAP; ++mp) o[mp][D0] = __builtin_amdgcn_mfma_f32_32x32x16_bf16(pa[mp][0], v0, o[mp][D0], 0, 0, 0);
#pragma unroll
    for (int mp = 0; mp < NMAP; ++mp) o[mp][D0] = __builtin_amdgcn_mfma_f32_32x32x16_bf16(pa[mp][1], v1, o[mp][D0], 0, 0, 0);
#pragma unroll
    for (int mp = 0; mp < NMAP; ++mp) o[mp][D0] = __builtin_amdgcn_mfma_f32_32x32x16_bf16(pa[mp][2], v2, o[mp][D0], 0, 0, 0);
#pragma unroll
    for (int mp = 0; mp < NMAP; ++mp) o[mp][D0] = __builtin_amdgcn_mfma_f32_32x32x16_bf16(pa[mp][3], v3, o[mp][D0], 0, 0, 0);
}

struct AttnP { const bf16_t *QA, *KA, *VA, *QB, *KB, *VB, *G; bf16_t* MIX; const float *subln_g, *rpb, *lam; };

template <int MODE, bool FAST>
__device__ __forceinline__ int attn_item(const AttnP& a, int b, int h, int blk, char* lds) {
    constexpr int NMAP = MODE == 0 ? 2 : 1, KD0 = MODE == 0 ? 4 : 8, NT = MODE == 0 ? SKV / 64 : 16;
    constexpr float THR = 8.f;
    int tid = threadIdx.x; asm volatile("" : "+v"(tid));
    const int wid = __builtin_amdgcn_readfirstlane(tid >> 6), lane = tid & 63, r32 = lane & 31, hi = lane >> 5;
    char* V_lds = lds; char* K_lds = lds + 32768;
    float* wsf = (float*)(lds + 65536) + wid * 64;
    float* rpbz = (float*)(lds + 65536 + 2048);
    float* rpbs = rpbz + 128;
    char* Qw = lds + 70656 + wid * 8192;
    const size_t bh = (size_t)(b * 8 + h);
    const int qrow = 4 * blk + (wid >> 1), half = wid & 1;
    const int qtok = MODE == 0 ? blk * 256 + wid * 32 : qrow * 64 + half * 32;
    const int ulo = min(max(4 * blk - 4, 0), 116), r0w = min(max(qrow - 4, 0), 120);
    {
        const bf16_t* Qg = (MODE == 0 ? a.QA : a.QB) + (bh * SEQ + qtok) * 128;
#pragma unroll
        for (int i = 0; i < 8; ++i) { const int row = i * 4 + (lane >> 4), c16 = lane & 15;
            const bf16x8 qv = *(const bf16x8*)(Qg + (size_t)row * 128 + c16 * 8);
            *(bf16x8*)(Qw + KSWZ(row, c16 * 16)) = qv; }
    }
    const char* Kh = (const char*)((MODE == 0 ? a.KA : a.KB) + bh * SKV * 128);
    const char* Vh = (const char*)((MODE == 0 ? a.VA : a.VB) + bh * SKV * 128);
    unsigned voffK, voffV;
    {
        const int krow = 4 * wid + (lane >> 4), kch = (lane & 15) ^ (krow & 7);
        voffK = (unsigned)(krow * 256 + kch * 16);
        const int sub = 2 * wid + (lane >> 5), kk = (sub >> 2) * 8 + ((lane & 31) >> 2), cblk = sub & 3;
        const int kreal = kk;
        voffV = (unsigned)(kreal * 256 + (cblk * 32 + (lane & 3) * 8) * 2);
    }
    const int vb0 = (int)(uintptr_t)V_lds + v_rd_base(lane);
    int koff[4];
#pragma unroll
    for (int i = 0; i < 4; ++i) koff[i] = r32 * 256 + (((2 * i + hi) ^ (r32 & 7)) << 4);
    if (MODE == 1) { for (int i = tid; i < 768; i += 512) { const int k = i - 128; rpbz[i] = (k >= 0 && k < 465) ? a.rpb[h * 465 + k] * LOG2E : 0.f; } }
    f32x16 negm0 = f32x16{}, negm1 = f32x16{};
    if (MODE == 1 && FAST) { const int j = half * 32 + r32, c0 = min(max(j - 8, 0), 48);
#pragma unroll
        for (int r = 0; r < 16; ++r) { const int kc = crow(r, hi); negm0[r] = ((unsigned)(kc - c0) < 16u) ? 0.f : -1e30f; negm1[r] = ((unsigned)(kc + 32 - c0) < 16u) ? 0.f : -1e30f; } }
    f32x16 o[NMAP][4]; float m_reg[NMAP], l_reg[NMAP];
#pragma unroll
    for (int mp = 0; mp < NMAP; ++mp) { m_reg[mp] = -1e30f; l_reg[mp] = 0.f;
#pragma unroll
        for (int d = 0; d < 4; ++d) o[mp][d] = f32x16{}; }
#define TROW(t) (MODE == 0 ? (t) * 64 : ((t) < 4 ? SEQ + (t) * 64 : (ulo + (t) - 4) * 64))
#define STAGE(t, bi) do { const size_t g0_ = (size_t)TROW(t) * 256; _Pragma("unroll") for (int ii_ = 0; ii_ < 2; ++ii_) { \
        __builtin_amdgcn_global_load_lds((const unsigned*)(Kh + g0_ + ii_ * 8192 + voffK), (LAS unsigned*)((LAS unsigned char*)K_lds + (bi) * 16384 + wid * 1024 + ii_ * 8192), 16, 0, 0); \
        __builtin_amdgcn_global_load_lds((const unsigned*)(Vh + g0_ + ii_ * 8192 + voffV), (LAS unsigned*)((LAS unsigned char*)V_lds + (bi) * 16384 + wid * 1024 + ii_ * 8192), 16, 0, 0); } } while (0)
    STAGE(0, 0);
    asm volatile("s_waitcnt lgkmcnt(0)" ::: "memory");
    bf16x8 qreg[4];
#pragma unroll
    for (int i = 0; i < 4; ++i) qreg[i] = *(const bf16x8*)(Qw + koff[i]);
    asm volatile("s_waitcnt vmcnt(0) lgkmcnt(0)" ::: "memory");
    __syncthreads();
#pragma nounroll
    for (int t = 0; t < NT; ++t) {
        const int cur = t & 1;
        if (t + 1 < NT) STAGE(t + 1, cur ^ 1);
        bool active = true; int br = 0;
        if (MODE == 1 && t >= 4) { br = ulo + t - 4; active = (br >= r0w) && (br <= r0w + 7); }
        if (active) {
            const char* Kc = K_lds + cur * 16384; const int vb = vb0 + cur * 16384;
            bf16x8 pa[NMAP][4];
#pragma unroll
            for (int mp = 0; mp < NMAP; ++mp) {
                SBAR();
                f32x16 p0 = f32x16{}, p1 = f32x16{};
                if (MODE == 1 && FAST && t >= 4) { p0 = negm0; p1 = negm1; }
#pragma unroll
                for (int d0 = 0; d0 < KD0; ++d0) { const int dd = (MODE == 0 ? mp * 4 : 0) + d0; const int off = koff[dd & 3] + (dd >> 2) * 128;
                    const bf16x8 k0 = *(const bf16x8*)(Kc + off); const bf16x8 k1 = *(const bf16x8*)(Kc + off + 8192);
                    const bf16x8 qf = (dd < 4) ? qreg[dd < 4 ? dd : 0] : *(const bf16x8*)(Qw + off);
                    p0 = __builtin_amdgcn_mfma_f32_32x32x16_bf16(k0, qf, p0, 0, 0, 0);
                    p1 = __builtin_amdgcn_mfma_f32_32x32x16_bf16(k1, qf, p1, 0, 0, 0);
                    if ((d0 & 1) == 1) SBAR(); }
                if (MODE == 1 && FAST && t >= 4) {
                    const float* bp = rpbs + (br - qrow + 7) * 31 + 15 - (half * 32 + r32) + 4 * hi;
#pragma unroll
                    for (int r = 0; r < 16; ++r) { p0[r] += bp[(r & 3) + 8 * (r >> 2)]; p1[r] += bp[32 + (r & 3) + 8 * (r >> 2)]; }
                }
                if (MODE == 1 && !FAST && t >= 4) {
                    const int j = half * 32 + r32, c0 = min(max(j - 8, 0), 48);
                    const float* bp = rpbs + (br - qrow + 7) * 31 + 15 - j;
#pragma unroll
                    for (int r = 0; r < 16; ++r) { const int kc = crow(r, hi); const bool ok = (unsigned)(kc - c0) < 16u; const float bv = bp[ok ? kc : j];
                        p0[r] = ok ? p0[r] + bv : -1e30f; }
#pragma unroll
                    for (int r = 0; r < 16; ++r) { const int kc = 32 + crow(r, hi); const bool ok = (unsigned)(kc - c0) < 16u; const float bv = bp[ok ? kc : j];
                        p1[r] = ok ? p1[r] + bv : -1e30f; }
                }
                float alpha = 1.f;
                if (FAST) {
                    float ps1 = 0.f;
#pragma unroll
                    for (int r = 0; r < 16; ++r) p0[r] = __builtin_amdgcn_exp2f(p0[r]);
#pragma unroll
                    for (int r = 0; r < 16; ++r) p1[r] = __builtin_amdgcn_exp2f(p1[r]);
#pragma unroll
                    for (int r = 0; r < 16; ++r) { ps1 += p0[r]; ps1 += p1[r]; }
                    l_reg[mp] += ps1;
                } else {
                float pmax = p0[0];
#pragma unroll
                for (int r = 1; r < 16; ++r) pmax = fmaxf(pmax, p0[r]);
#pragma unroll
                for (int r = 0; r < 16; ++r) pmax = fmaxf(pmax, p1[r]);
                { auto rr = __builtin_amdgcn_permlane32_swap(__float_as_uint(pmax), __float_as_uint(pmax), false, false);
                  pmax = fmaxf(__uint_as_float(rr[0]), __uint_as_float(rr[1])); }
                float mn = m_reg[mp];
                if (!__all(pmax - m_reg[mp] <= THR)) { mn = fmaxf(m_reg[mp], pmax); alpha = __builtin_amdgcn_exp2f(m_reg[mp] - mn); m_reg[mp] = mn; }
                float ps = 0.f;
#pragma unroll
                for (int r = 0; r < 16; ++r) { p0[r] = __builtin_amdgcn_exp2f(p0[r] - mn); ps += p0[r]; }
#pragma unroll
                for (int r = 0; r < 16; ++r) { p1[r] = __builtin_amdgcn_exp2f(p1[r] - mn); ps += p1[r]; }
                { auto rr = __builtin_amdgcn_permlane32_swap(__float_as_uint(ps), __float_as_uint(ps), false, false);
                  ps = __uint_as_float(rr[0]) + __uint_as_float(rr[1]); }
                l_reg[mp] = l_reg[mp] * alpha + ps;
                }
#define PK4(P, BASE, OUT) do { u32x4 w = {cvtpk(P[BASE + 0], P[BASE + 1]), cvtpk(P[BASE + 2], P[BASE + 3]), cvtpk(P[BASE + 4], P[BASE + 5]), cvtpk(P[BASE + 6], P[BASE + 7])}; \
    OUT = *reinterpret_cast<bf16x8*>(&w); } while (0)
                PK4(p0, 0, pa[mp][0]); PK4(p0, 8, pa[mp][1]); PK4(p1, 0, pa[mp][2]); PK4(p1, 8, pa[mp][3]);
#undef PK4
                if (!FAST && __any(alpha < 1.f)) {
                    if (hi == 0) wsf[r32] = alpha;
                    asm volatile("s_waitcnt lgkmcnt(0)" ::: "memory");
#pragma unroll
                    for (int r = 0; r < 16; ++r) { const float al = wsf[crow(r, hi)];
#pragma unroll
                        for (int d = 0; d < 4; ++d) o[mp][d][r] *= al; }
                }
            }
            SBAR();
            pv_all<NMAP, 0>(o, vb, pa); pv_all<NMAP, 1>(o, vb, pa); pv_all<NMAP, 2>(o, vb, pa); pv_all<NMAP, 3>(o, vb, pa);
        }
        asm volatile("s_waitcnt vmcnt(0)" ::: "memory");
        __syncthreads();
    }
#undef TROW
#undef STAGE
    if (FAST) {
        bool bad = false;
#pragma unroll
        for (int mp = 0; mp < NMAP; ++mp) { auto rr = __builtin_amdgcn_permlane32_swap(__float_as_uint(l_reg[mp]), __float_as_uint(l_reg[mp]), false, false);
            l_reg[mp] = __uint_as_float(rr[0]) + __uint_as_float(rr[1]); bad = bad || !(l_reg[mp] <= 1.0e30f) || !(l_reg[mp] >= 1.0e-30f); }
        if (lane == 0) rpbz[wid] = __any(bad) ? 1.f : 0.f;
        __syncthreads();
        float anyb = 0.f;
#pragma unroll
        for (int w = 0; w < 8; ++w) anyb += rpbz[w];
        __syncthreads();
        if (anyb != 0.f) return 1;
    }
    const float lam = MODE == 0 ? a.lam[0] : 0.f;
    if (hi == 0) { wsf[r32] = 1.f / l_reg[0]; if (MODE == 0) wsf[32 + r32] = lam / l_reg[NMAP - 1]; }
    asm volatile("s_waitcnt lgkmcnt(0)" ::: "memory");
    const size_t obase = ((size_t)b * SEQ + qtok) * DM + (MODE == 0 ? 0 : 1024) + h * 128 + r32;
    float sg[4];
#pragma unroll
    for (int d = 0; d < 4; ++d) sg[d] = MODE == 0 ? a.subln_g[d * 32 + r32] * 0.8f : 1.f;
    bf16_t gq[16][4];
#pragma unroll
    for (int r = 0; r < 16; ++r)
#pragma unroll
        for (int d = 0; d < 4; ++d) gq[r][d] = a.G[obase + (size_t)crow(r, hi) * DM + d * 32];
    asm volatile("s_waitcnt vmcnt(0)" ::: "memory"); SBAR();
#pragma unroll
    for (int r = 0; r < 16; ++r) {
        const int cr = crow(r, hi);
        const float ra = wsf[cr];
        float v[4];
        if (MODE == 0) {
            const float rb = wsf[32 + cr];
            float ss = 0.f;
#pragma unroll
            for (int d = 0; d < 4; ++d) { v[d] = o[0][d][r] * ra - o[NMAP - 1][d][r] * rb; ss += v[d] * v[d]; }
            ss += __shfl_xor(ss, 1); ss += __shfl_xor(ss, 2); ss += __shfl_xor(ss, 4); ss += __shfl_xor(ss, 8); ss += __shfl_xor(ss, 16);
            const float rstd = rsqrtf(ss * (1.f / 128.f) + 1e-5f);
#pragma unroll
            for (int d = 0; d < 4; ++d) v[d] *= rstd * sg[d];
        } else {
#pragma unroll
            for (int d = 0; d < 4; ++d) v[d] = o[0][d][r] * ra;
        }
        const size_t ro = obase + (size_t)cr * DM;
#pragma unroll
        for (int d = 0; d < 4; ++d) { const float gg = bf2f(gq[r][d]); a.MIX[ro + d * 32] = (bf16_t)(cvtpk(v[d] * gg, 0.f) & 0xffffu); }
    }
    return 0;
}

struct Params {
    const float *x, *c, *ctx, *c_ctx, *norm_g, *w_mod, *b_mod, *w_in, *w_out, *lq1, *lk1, *lq2, *lk2, *subln_g, *rpb, *final_g;
    float* out; unsigned char* ws;
};

__device__ __forceinline__ void transpose_item(const float* W, int K, int N, bf16_t* WT, LAS float* scr, int item, int lane, int perm_below) {
    const int nblk = N / 32, kb = item / nblk, nb = item % nblk, k0 = 64 * kb, n0 = 32 * nb;
#pragma unroll 8
    for (int i = 0; i < 32; ++i) { const int kk = 2 * i + (lane >> 5); scr[kk * 33 + (lane & 31)] = W[(size_t)(k0 + kk) * N + n0 + (lane & 31)]; }
    asm volatile("s_waitcnt lgkmcnt(0)" ::: "memory");
    const int c = lane & 7; const bool pr = n0 < perm_below;
#pragma unroll
    for (int j = 0; j < 4; ++j) { const int n = (lane >> 3) + 8 * j; const int ns = pr ? pg8::perm32inv(n) : n; const LAS float* s = scr + (8 * c) * 33 + ns;
        u32x4 o; o.x = cvtpk(s[0 * 33], s[1 * 33]); o.y = cvtpk(s[2 * 33], s[3 * 33]); o.z = cvtpk(s[4 * 33], s[5 * 33]); o.w = cvtpk(s[6 * 33], s[7 * 33]);
        *(u32x4*)(WT + (size_t)(n0 + n) * K + k0 + 8 * c) = o; }
    asm volatile("s_waitcnt lgkmcnt(0)" ::: "memory");
}

__global__ void __launch_bounds__(512, 2) fwd_megakernel(Params p) {
    extern __shared__ __attribute__((aligned(16))) unsigned char lds[];
    cg::grid_group grid = cg::this_grid();
    const int bid = blockIdx.x, G = gridDim.x;
#define TIDS() int tid = threadIdx.x; asm volatile("" : "+v"(tid)); const int lane = tid & 63, wid = __builtin_amdgcn_readfirstlane(tid >> 6); (void)lane; (void)wid;
#define WSPTRS() size_t wsz_ = 0; asm volatile("" : "+s"(wsz_)); unsigned char* ws = p.ws + wsz_;     \
    float* mod = (float*)(ws + WS_MOD); float* lamp = (float*)(ws + WS_LAM); float* rope = (float*)(ws + WS_ROPE); \
    bf16_t* WinT = (bf16_t*)(ws + WS_WIN); bf16_t* WoutT = (bf16_t*)(ws + WS_WOUT); bf16_t* HX = (bf16_t*)(ws + WS_HX); \
    bf16_t* QA = (bf16_t*)(ws + WS_QA); bf16_t* KA = (bf16_t*)(ws + WS_KA); bf16_t* VA = (bf16_t*)(ws + WS_VA); \
    bf16_t* QB = (bf16_t*)(ws + WS_QB); bf16_t* KB = (bf16_t*)(ws + WS_KB); bf16_t* VB = (bf16_t*)(ws + WS_VB); \
    bf16_t* GB = (bf16_t*)(ws + WS_G); bf16_t* MIX = (bf16_t*)(ws + WS_MIX); \
    (void)mod; (void)lamp; (void)rope; (void)WinT; (void)WoutT; (void)HX; (void)QA; (void)KA; (void)VA; (void)QB; (void)KB; (void)VB; (void)GB; (void)MIX;
    { WSPTRS(); TIDS();
    if (bid < 192) {
        const int cgp = bid % 12, kc = bid / 12;
        float* sl = (float*)lds;
        for (int i = tid; i < 640; i += 512) { const int bb = i >> 7, k = kc * 128 + (i & 127); const float v = bb < 4 ? p.c[bb * DM + k] : p.c_ctx[k]; sl[i] = v / (1.f + expf(-v)); }
        __syncthreads();
        const int col = cgp * 512 + tid;
        float a0 = 0.f, a1 = 0.f, a2 = 0.f, a3 = 0.f, a4 = 0.f;
        const float* wp = p.w_mod + (size_t)(kc * 128) * 6144 + col;
#pragma unroll 8
        for (int k = 0; k < 128; ++k) { const float w = wp[(size_t)k * 6144]; a0 += sl[k] * w; a1 += sl[128 + k] * w; a2 += sl[256 + k] * w; a3 += sl[384 + k] * w; a4 += sl[512 + k] * w; }
        if (kc == 0) { const float bm = p.b_mod[col]; a0 += bm; a1 += bm; a2 += bm; a3 += bm; a4 += bm; }
        atomicAdd(mod + col, a0); atomicAdd(mod + 6144 + col, a1); atomicAdd(mod + 2 * 6144 + col, a2); atomicAdd(mod + 3 * 6144 + col, a3); atomicAdd(mod + 4 * 6144 + col, a4);
        __syncthreads();
    } else if (bid < 196) {
        const int idx = (bid - 192) * 512 + tid, pos = idx >> 4, i = idx & 15;
        const float inv = powf(10000.f, -(float)i / 16.f), ang = (float)pos * inv;
        rope[2 * idx] = cosf(ang); rope[2 * idx + 1] = sinf(ang);
    } else if (bid == 196 && wid == 0) {
        const float d1 = wave_sum(p.lq1[lane] * p.lk1[lane]), d2 = wave_sum(p.lq2[lane] * p.lk2[lane]);
        if (lane == 0) lamp[0] = expf(d1) - expf(d2) + 0.2f;
    }
    {
        LAS float* scr = (LAS float*)((LAS unsigned char*)lds + wid * 16384);
        const int gw = bid * 8 + wid, NGW = G * 8;
        constexpr int I_IN = (DM / 64) * (INC / 32), I_OUT = (DM / 64) * (DM / 32);
        for (int it = gw; it < I_IN + I_OUT; it += NGW) {
            if (it < I_IN) transpose_item(p.w_in, DM, INC, WinT, scr, it, lane, 2048);
            else transpose_item(p.w_out, DM, DM, WoutT, scr, it - I_IN, lane, 0);
        }
    }
    }
    grid.sync();

    { WSPTRS(); TIDS();
        const int gw = bid * 8 + wid, NGW = G * 8;
        for (int R = gw; R < NTOK + NCTX; R += NGW) {
            const float* src = R < NTOK ? p.x + (size_t)R * DM : p.ctx + (size_t)(R - NTOK) * DM;
            const float* mr = mod + (R < NTOK ? (R >> 13) : 4) * 6144;
            f32x4 v[8]; float ss = 0.f;
#pragma unroll
            for (int j = 0; j < 8; ++j) { v[j] = *(const f32x4*)(src + j * 256 + lane * 4); ss += (v[j].x * v[j].x + v[j].y * v[j].y) + (v[j].z * v[j].z + v[j].w * v[j].w); }
            const float rstd = rsqrtf(wave_sum(ss) * (1.f / DM) + 1e-6f);
            bf16_t* orow = HX + (size_t)R * DM;
#pragma unroll
            for (int j = 0; j < 8; ++j) { const int k = j * 256 + lane * 4;
                const f32x4 g4 = *(const f32x4*)(p.norm_g + k), sh = *(const f32x4*)(mr + k), sc4 = *(const f32x4*)(mr + 2048 + k);
                const f32x4 y = v[j] * rstd * g4 * (sc4 + 1.f) + sh;
                uint2 w; w.x = cvtpk(y.x, y.y); w.y = cvtpk(y.z, y.w); *(uint2*)(orow + k) = w; }
        }
    }
    grid.sync();

    { WSPTRS();
        pg8::Gemm g{HX, WinT, DM}; pg8::Order S; S.init(NTOK / 256, INC / 256, G, bid, 64);
        EpiIn E{QA, KA, VA, QB, KB, VB, GB, rope};
        pg8::gemm_phase<EpiIn, pg8::Order>((LAS unsigned char*)lds, g, S, E);
    }
    grid.sync();

    { WSPTRS();
        AttnP ap{QA, KA, VA, QB, KB, VB, GB, MIX, p.subln_g, p.rpb, lamp};
        unsigned badmask = 0u; int it = 0;
        for (int L = bid; L < 1024; L += G, ++it) { const int xcd = L & 7, rest = L >> 3, blk = rest & 31, bh = xcd + 8 * (rest >> 5);
            if (attn_item<0, true>(ap, bh >> 3, bh & 7, blk, (char*)lds)) badmask |= 1u << (it & 31); }
        badmask = __builtin_amdgcn_readfirstlane(badmask);
        if (badmask) { it = 0;
            for (int L = bid; L < 1024; L += G, ++it) { const int xcd = L & 7, rest = L >> 3, blk = rest & 31, bh = xcd + 8 * (rest >> 5);
                if ((badmask >> (it & 31)) & 1u) attn_item<0, false>(ap, bh >> 3, bh & 7, blk, (char*)lds); } }
    }
    { WSPTRS();
        AttnP ap{QA, KA, VA, QB, KB, VB, GB, MIX, p.subln_g, p.rpb, lamp};
        unsigned badmask = 0u; int it = 0;
        for (int L = bid; L < 1024; L += G, ++it) { const int xcd = L & 7, rest = L >> 3, blk = rest & 31, bh = xcd + 8 * (rest >> 5);
            if (attn_item<1, true>(ap, bh >> 3, bh & 7, blk, (char*)lds)) badmask |= 1u << (it & 31); }
        badmask = __builtin_amdgcn_readfirstlane(badmask);
        if (badmask) { it = 0;
            for (int L = bid; L < 1024; L += G, ++it) { const int xcd = L & 7, rest = L >> 3, blk = rest & 31, bh = xcd + 8 * (rest >> 5);
                if ((badmask >> (it & 31)) & 1u) attn_item<1, false>(ap, bh >> 3, bh & 7, blk, (char*)lds); } }
    }
    grid.sync();

    { WSPTRS();
        pg8::Gemm g{MIX, WoutT, DM}; pg8::OrderPanel S{bid};
        EpiOutNorm E{p.x, mod, p.final_g, p.out, (float*)(ws + WS_XCH), (unsigned*)(ws + 126976), (LAS float*)((LAS unsigned char*)lds + 131072)};
        pg8::gemm_phase<EpiOutNorm, pg8::OrderPanel>((LAS unsigned char*)lds, g, S, E);
    }
}

extern "C" void kernel_launch(void* const* d_in, const int* in_sizes, int n_in, void* d_out, int out_size, void* d_ws, size_t ws_size, hipStream_t stream) {
    static int grid_blocks = 0;
    if (grid_blocks == 0) {
        if (n_in != 16 || in_sizes[0] != NTOK * DM || out_size != NTOK * DM || ws_size < WS_END) {
            fprintf(stderr, "kernel_launch: shape mismatch (n_in %d in0 %d out %d ws %zu)\n", n_in, n_in > 0 ? in_sizes[0] : -1, out_size, ws_size); grid_blocks = -1; return; }
        int dev = 0, cus = 0, per_cu = 0;
        hipGetDevice(&dev);
        hipDeviceGetAttribute(&cus, hipDeviceAttributeMultiprocessorCount, dev);
        if (hipFuncSetAttribute((const void*)fwd_megakernel, hipFuncAttributeMaxDynamicSharedMemorySize, LDS_BYTES) != hipSuccess) { fprintf(stderr, "kernel_launch: hipFuncSetAttribute failed\n"); grid_blocks = -1; return; }
        hipOccupancyMaxActiveBlocksPerMultiprocessor(&per_cu, (const void*)fwd_megakernel, 512, LDS_BYTES);
        if (per_cu < 1) { fprintf(stderr, "kernel_launch: occupancy query returned %d\n", per_cu); per_cu = 1; }
        (void)hipGetLastError();
        if (cus != 256) { fprintf(stderr, "kernel_launch: built for a 256-CU device (got %d CUs)\n", cus); grid_blocks = -1; return; }
        grid_blocks = cus;
    }
    if (grid_blocks < 0) return;
    hipMemsetAsync((char*)d_ws + WS_MOD, 0, 128 * 1024, stream);
    Params p{};
    p.x = (const float*)d_in[0]; p.c = (const float*)d_in[1]; p.ctx = (const float*)d_in[2]; p.c_ctx = (const float*)d_in[3]; p.norm_g = (const float*)d_in[4];
    p.w_mod = (const float*)d_in[5]; p.b_mod = (const float*)d_in[6]; p.w_in = (const float*)d_in[7]; p.w_out = (const float*)d_in[8];
    p.lq1 = (const float*)d_in[9]; p.lk1 = (const float*)d_in[10]; p.lq2 = (const float*)d_in[11]; p.lk2 = (const float*)d_in[12];
    p.subln_g = (const float*)d_in[13]; p.rpb = (const float*)d_in[14]; p.final_g = (const float*)d_in[15];
    p.out = (float*)d_out; p.ws = (unsigned char*)d_ws;
    void* args[] = {&p};
    hipError_t e = hipLaunchCooperativeKernel((const void*)fwd_megakernel, dim3(grid_blocks), dim3(512), args, LDS_BYTES, stream);
    if (e != hipSuccess) fprintf(stderr, "cooperative launch failed: %s (grid %d)\n", hipGetErrorString(e), grid_blocks);
}
```

```cpp
#include <hip/hip_runtime.h>
#include <hip/hip_cooperative_groups.h>
#include <cstdio>
#include <cstdint>
namespace cg = cooperative_groups;

#define LAS __attribute__((address_space(3)))
typedef unsigned short bf16_t;
typedef short bf16x8 __attribute__((ext_vector_type(8)));
typedef short s16x4 __attribute__((ext_vector_type(4)));
typedef float f32x4 __attribute__((ext_vector_type(4)));
typedef float f32x16 __attribute__((ext_vector_type(16)));
typedef unsigned u32x4 __attribute__((ext_vector_type(4)));

constexpr int DM = 2048, NB = 4, SEQ = 8192, CTX = 256, NTOK = NB * SEQ, NCTX = NB * CTX, INC = 8192, SKV = SEQ + CTX;
constexpr float LOG2E = 1.4426950408889634f;
constexpr float C2A = 0.125f * LOG2E;
constexpr float C2B = 0.08838834764831845f * LOG2E;
constexpr size_t MiB = 1u << 20;
constexpr size_t WS_MOD = 0, WS_LAM = 128 * 1024, WS_ROPE = 192 * 1024, WS_WIN = 1 * MiB, WS_WOUT = 33 * MiB, WS_HX = 48 * MiB;
constexpr size_t WS_QA = 192 * MiB, WS_KA = 256 * MiB, WS_VA = 328 * MiB, WS_QB = 400 * MiB, WS_KB = 464 * MiB, WS_VB = 536 * MiB;
constexpr size_t WS_G = 608 * MiB, WS_MIX = 736 * MiB, WS_XCH = 864 * MiB, WS_END = 866 * MiB;
constexpr int LDS_BYTES = 136192;

__device__ __forceinline__ unsigned cvtpk(float lo, float hi) { unsigned r; asm volatile("v_cvt_pk_bf16_f32 %0, %1, %2" : "=v"(r) : "v"(lo), "v"(hi)); return r; }
__device__ __forceinline__ float fadd_s(float a, float b) { float r; asm("v_add_f32_e32 %0, %1, %2" : "=v"(r) : "v"(a), "v"(b)); return r; }
__device__ __forceinline__ float bf2f(bf16_t v) { return __uint_as_float((unsigned)v << 16); }
__device__ __forceinline__ float silu_f(float v) { return v * __builtin_amdgcn_rcpf(1.f + __builtin_amdgcn_exp2f(-v * LOG2E)); }
__device__ __forceinline__ float wave_sum(float v) {
#pragma unroll
    for (int o = 1; o < 64; o <<= 1) v += __shfl_xor(v, o);
    return v;
}

namespace pg8 {
constexpr int BM = 256, BK = 64, HALF = 128, HTB = HALF * BK * 2, NXCD = 8, WGM = 8;
__host__ __device__ __forceinline__ int lds_byte(int r, int c) { const int st = (r >> 4) * 2 + (c >> 5), rr = r & 15, cc = c & 31, ob = rr * 64 + cc * 2; return st * 1024 + (ob ^ (((ob >> 9) & 1) << 5)); }
__host__ __device__ __forceinline__ void stage_rc(int b, int& R, int& C) { const int st = b / 1024, sb = b % 1024, swz = sb ^ (((sb >> 9) & 1) << 5); R = (st >> 1) * 16 + swz / 64; C = (st & 1) * 32 + (swz % 64) / 2; }
__host__ __device__ __forceinline__ int perm32(int rho) { const int n = rho >> 4, i = rho & 15; return 8 * (i >> 2) + 4 * n + (i & 3); }
__host__ __device__ __forceinline__ int perm32inv(int q) { return 16 * ((q >> 2) & 1) + 4 * (q >> 3) + (q & 3); }
struct Unit { int pm, pn; };
struct Gemm { const bf16_t* A; const bf16_t* Bt; int K; };

struct Order {
    int nM, nN, nwg, G, c, nX;
    __device__ void init(int nM_, int nN_, int G_, int c_, int nX_) { nM = nM_; nN = nN_; nwg = nM * nN; G = G_; c = c_; nX = nX_; }
    __device__ bool next(int i, Unit& u) const {
        const int L = i * G + c; if (L >= nwg + nX) return false;
        if (L >= nwg) { const int e = L - nwg; u.pm = nM + (e >> 4); const int q = e & 15; u.pn = q < 8 ? 4 + q : 12 + q; return true; }
        int wgid = L; { const int q = nwg / NXCD, r = nwg % NXCD, xcd = wgid % NXCD, off = wgid / NXCD; wgid = (xcd < r ? xcd * (q + 1) : r * (q + 1) + (xcd - r) * q) + off; }
        const int nig = WGM * nN, gid = wgid / nig, fm = gid * WGM, gsz = (nM - fm) < WGM ? (nM - fm) : WGM;
        u.pm = fm + ((wgid % nig) % gsz); u.pn = (wgid % nig) / gsz; return true;
    }
};

struct OrderPanel { int c; __device__ bool next(int i, Unit& u) const { if (i >= 4) return false; const int xcd = c & 7, j = c >> 3; u.pm = xcd * 4 + (j >> 3) + 32 * i; u.pn = j & 7; return true; } };

template <class Epi, class Sched>
__device__ __forceinline__ void gemm_phase(LAS unsigned char* lds, const Gemm g, const Sched& S, const Epi& E) {
    int tid = threadIdx.x; asm volatile("" : "+v"(tid));
    const int wid = __builtin_amdgcn_readfirstlane(tid >> 6), lane = tid & 63, wr = wid >> 2, wc = wid & 3, fr = lane & 15, fq = lane >> 4;
    const int K = g.K, nt = K / BK;
    unsigned voffA[2], voffB[2];
#pragma unroll
    for (int i = 0; i < 2; ++i) { int R, C; stage_rc(tid * 16 + i * 8192, R, C); const int Rb = (R & ~31) + perm32(R & 31);
        voffA[i] = (unsigned)(R * K + C) * 2u; voffB[i] = (unsigned)(Rb * K + C) * 2u; }
    const size_t kstep = (size_t)(BK * 2);
    const size_t hstep = (size_t)HALF * K * 2;
    const size_t tstep = 2 * hstep;
    const unsigned ldsw = (unsigned)wid * 1024u;
    const int aoff = lds_byte(wr * 64 + fr, fq * 8), boff = lds_byte(wc * 32 + fr, fq * 8);
#define PG8_SA(b, h) (((b) * 2 + (h)) * HTB)
#define PG8_SB(b, h) ((4 + (b) * 2 + (h)) * HTB)
#define PG8_STAGE(bufoff, gbase, voff) do { _Pragma("unroll") for (int _i = 0; _i < 2; ++_i) \
        __builtin_amdgcn_global_load_lds((const unsigned*)((const char*)(gbase) + (voff)[_i]), (LAS unsigned*)(lds + (bufoff) + ldsw + _i * 8192), 16, 0, 0); } while (0)
#define PG8_LDA(dst, b, h) do { _Pragma("unroll") for (int m = 0; m < 4; ++m) _Pragma("unroll") for (int k = 0; k < 2; ++k) dst[m][k] = *(const LAS bf16x8*)(lds + PG8_SA(b, h) + aoff + m * 2048 + k * 1024); } while (0)
#define PG8_LDB(dst, b, h) do { _Pragma("unroll") for (int n = 0; n < 2; ++n) _Pragma("unroll") for (int k = 0; k < 2; ++k) dst[n][k] = *(const LAS bf16x8*)(lds + PG8_SB(b, h) + boff + n * 2048 + k * 1024); } while (0)
#define PG8_MMA(ai, bj, At, Bt) do { __builtin_amdgcn_s_setprio(1); _Pragma("unroll") for (int m = 0; m < 4; ++m) _Pragma("unroll") for (int n = 0; n < 2; ++n) _Pragma("unroll") for (int k = 0; k < 2; ++k) \
        acc[ai][bj][m][n] = __builtin_amdgcn_mfma_f32_16x16x32_bf16(Bt[n][k], At[m][k], acc[ai][bj][m][n], 0, 0, 0); __builtin_amdgcn_s_setprio(0); } while (0)
#define PG8_WAIT_V(n) asm volatile("s_waitcnt vmcnt(" #n ")" ::: "memory")
#define PG8_WAIT_L(n) asm volatile("s_waitcnt lgkmcnt(" #n ")" ::: "memory")
#define PG8_BAR __builtin_amdgcn_s_barrier()
#define PG8_SCHED __builtin_amdgcn_sched_barrier(0)
    Unit cur, nxt; int ui = 0;
    if (!S.next(0, cur)) return;
    f32x4 acc[2][2][4][2];
#pragma unroll
    for (int a = 0; a < 2; ++a)
#pragma unroll
        for (int b = 0; b < 2; ++b)
#pragma unroll
            for (int m = 0; m < 4; ++m)
#pragma unroll
                for (int n = 0; n < 2; ++n) acc[a][b][m][n] = (f32x4){0.f, 0.f, 0.f, 0.f};
    bf16x8 At[4][2], B0[2][2], B1[2][2];
    const char* cA = (const char*)g.A + (size_t)cur.pm * tstep; const char* cB = (const char*)g.Bt + (size_t)cur.pn * tstep;
    PG8_STAGE(PG8_SB(0, 0), cB, voffB); PG8_STAGE(PG8_SB(0, 1), cB + hstep, voffB); PG8_STAGE(PG8_SA(0, 0), cA, voffA); PG8_STAGE(PG8_SA(0, 1), cA + hstep, voffA);
    if (wr == 1) PG8_BAR;
    PG8_WAIT_V(2); PG8_BAR;
    PG8_STAGE(PG8_SB(1, 0), cB + kstep, voffB); PG8_STAGE(PG8_SA(1, 0), cA + kstep, voffA); PG8_STAGE(PG8_SB(1, 1), cB + hstep + kstep, voffB);
    PG8_WAIT_V(6); PG8_BAR;
    for (;;) {
        const bool has_next = S.next(ui + 1, nxt);
        const char* nA = has_next ? (const char*)g.A + (size_t)nxt.pm * tstep : cA; const char* nB = has_next ? (const char*)g.Bt + (size_t)nxt.pn * tstep : cB;
        for (int t = 0; t < nt; t += 2) {
            const bool last = (t == nt - 2);
            const char* a1 = cA + (size_t)(t + 1) * kstep;
            const char* a2 = last ? nA : cA + (size_t)(t + 2) * kstep; const char* b2 = last ? nB : cB + (size_t)(t + 2) * kstep;
            const char* a3 = a2 + kstep; const char* b3 = b2 + kstep;
            PG8_LDB(B0, 0, 0); PG8_LDB(B1, 0, 1); PG8_SCHED; PG8_LDA(At, 0, 0); PG8_STAGE(PG8_SA(1, 1), a1 + hstep, voffA);
            PG8_WAIT_V(8); PG8_WAIT_L(0); PG8_BAR; PG8_MMA(0, 0, At, B0); PG8_MMA(0, 1, At, B1); PG8_BAR; PG8_SCHED;
            PG8_LDA(At, 0, 1); PG8_STAGE(PG8_SB(0, 0), b2, voffB); PG8_STAGE(PG8_SB(0, 1), b2 + hstep, voffB); PG8_STAGE(PG8_SA(0, 0), a2, voffA);
            PG8_WAIT_V(8); PG8_WAIT_L(0); PG8_BAR; PG8_MMA(1, 0, At, B0); PG8_MMA(1, 1, At, B1); PG8_BAR; PG8_SCHED;
            PG8_LDB(B0, 1, 0); PG8_LDB(B1, 1, 1); PG8_SCHED; PG8_LDA(At, 1, 0); PG8_STAGE(PG8_SA(0, 1), a2 + hstep, voffA);
            PG8_WAIT_V(8); PG8_WAIT_L(0); PG8_BAR; PG8_MMA(0, 0, At, B0); PG8_MMA(0, 1, At, B1); PG8_BAR; PG8_SCHED;
            PG8_LDA(At, 1, 1); PG8_STAGE(PG8_SB(1, 0), b3, voffB); PG8_STAGE(PG8_SB(1, 1), b3 + hstep, voffB); PG8_STAGE(PG8_SA(1, 0), a3, voffA);
            PG8_WAIT_V(8); PG8_WAIT_L(0); PG8_BAR; PG8_MMA(1, 0, At, B0); PG8_MMA(1, 1, At, B1); PG8_BAR; PG8_SCHED;
        }
        if (wr == 0) PG8_BAR;
        E(acc, cur, wr, wc, fr, fq);
        if (!has_next) break;
#pragma unroll
        for (int a = 0; a < 2; ++a)
#pragma unroll
            for (int b = 0; b < 2; ++b)
#pragma unroll
                for (int m = 0; m < 4; ++m)
#pragma unroll
                    for (int n = 0; n < 2; ++n) acc[a][b][m][n] = (f32x4){0.f, 0.f, 0.f, 0.f};
        cur = nxt; cA = nA; cB = nB; ++ui;
        if (wr == 1) PG8_BAR;
    }
    PG8_WAIT_V(0);
    PG8_BAR;
#undef PG8_SA
#undef PG8_SB
#undef PG8_STAGE
#undef PG8_LDA
#undef PG8_LDB
#undef PG8_MMA
#undef PG8_WAIT_V
#undef PG8_WAIT_L
#undef PG8_BAR
#undef PG8_SCHED
}
}

struct EpiIn {
    static constexpr bool PERM = true;
    bf16_t *QA, *KA, *VA, *QB, *KB, *VB, *G; const float* rope;
    __device__ __forceinline__ void operator()(const f32x4 (&acc)[2][2][4][2], const pg8::Unit& u, int wr, int wc, int fr, int fq) const {
        const int type = u.pn >> 2, hb = (u.pn & 3) * 2;
        const bool isctx = u.pm >= 128;
        const int b = isctx ? u.pm - 128 : (u.pm >> 5);
        const int sbase = (isctx ? SEQ : (u.pm & 31) * 256) + wr * 64 + fr;
        const int dcol = wc * 32 + 8 * fq;
        if (type == 3 || type == 7) {
            bf16_t* gp = G + ((size_t)b * SEQ + sbase) * DM + (type == 7 ? 1024 : 0) + hb * 128 + dcol;
#pragma unroll
            for (int ai = 0; ai < 2; ++ai)
#pragma unroll
                for (int m = 0; m < 4; ++m)
#pragma unroll
                    for (int bj = 0; bj < 2; ++bj) {
                        const f32x4 v0 = acc[ai][bj][m][0], v1 = acc[ai][bj][m][1];
                        u32x4 w; w.x = cvtpk(silu_f(v0[0]), silu_f(v0[1])); w.y = cvtpk(silu_f(v0[2]), silu_f(v0[3]));
                        w.z = cvtpk(silu_f(v1[0]), silu_f(v1[1])); w.w = cvtpk(silu_f(v1[2]), silu_f(v1[3]));
                        __builtin_nontemporal_store(w, (u32x4*)(gp + (size_t)(ai * 128 + m * 16) * DM + bj * 128));
                    }
            return;
        }
        bf16_t* base; int SK; float sc = 1.f;
        switch (type) {
            case 0: base = QA; SK = SEQ; sc = C2A; break;
            case 1: base = KA; SK = SKV; break;
            case 2: base = VA; SK = SKV; break;
            case 4: base = QB; SK = SEQ; sc = C2B; break;
            case 5: base = KB; SK = SKV; break;
            default: base = VB; SK = SKV; break;
        }
        const bool dorope = (type <= 1) && !isctx;
        bf16_t* op = base + ((size_t)(b * 8 + hb) * SK + sbase) * 128 + dcol;
        const size_t hstride = (size_t)SK * 128;
#pragma unroll
        for (int ai = 0; ai < 2; ++ai)
#pragma unroll
            for (int m = 0; m < 4; ++m) {
                f32x4 cs0 = {1.f, 0.f, 1.f, 0.f}, cs1 = {1.f, 0.f, 1.f, 0.f};
                if (dorope) { const int s = sbase + ai * 128 + m * 16; const int pos = (wc & 1) ? (s & 63) : (s >> 6);
                    const f32x4* rp = (const f32x4*)(rope + (size_t)(pos * 16 + 4 * fq) * 2); cs0 = rp[0]; cs1 = rp[1]; }
#pragma unroll
                for (int bj = 0; bj < 2; ++bj) {
                    const f32x4 x1 = acc[ai][bj][m][0], x2 = acc[ai][bj][m][1];
                    f32x4 y1, y2;
                    y1[0] = x1[0] * cs0[0] - x2[0] * cs0[1]; y2[0] = x2[0] * cs0[0] + x1[0] * cs0[1];
                    y1[1] = x1[1] * cs0[2] - x2[1] * cs0[3]; y2[1] = x2[1] * cs0[2] + x1[1] * cs0[3];
                    y1[2] = x1[2] * cs1[0] - x2[2] * cs1[1]; y2[2] = x2[2] * cs1[0] + x1[2] * cs1[1];
                    y1[3] = x1[3] * cs1[2] - x2[3] * cs1[3]; y2[3] = x2[3] * cs1[2] + x1[3] * cs1[3];
                    y1 = y1 * sc; y2 = y2 * sc;
                    u32x4 w; w.x = cvtpk(y1[0], y1[1]); w.y = cvtpk(y1[2], y1[3]); w.z = cvtpk(y2[0], y2[1]); w.w = cvtpk(y2[2], y2[3]);
                    __builtin_nontemporal_store(w, (u32x4*)(op + (size_t)(ai * 128 + m * 16) * 128 + bj * hstride));
                }
            }
    }
};
struct EpiOutNorm {
    static constexpr bool PERM = true;
    const float* x; const float* mod; const float* fg; float* out; float* X; unsigned* cnt; LAS float* sc;
    __device__ __forceinline__ void operator()(f32x4 (&acc)[2][2][4][2], const pg8::Unit& u, int wr, int wc, int fr, int fq) const {
        const int row0 = u.pm * 256 + wr * 64 + fr, b = u.pm >> 5, col0 = u.pn * 256 + wc * 32 + 8 * fq;
        int tid = threadIdx.x; asm volatile("" : "+v"(tid));
        f32x4 gv[2][2];
#pragma unroll
        for (int bj = 0; bj < 2; ++bj)
#pragma unroll
            for (int n = 0; n < 2; ++n) gv[bj][n] = *(const f32x4*)(mod + b * 6144 + 4096 + col0 + bj * 128 + 4 * n);
#pragma unroll
        for (int ai = 0; ai < 2; ++ai)
#pragma unroll
            for (int m = 0; m < 4; ++m) {
                const size_t ro = (size_t)(row0 + ai * 128 + m * 16) * DM + col0;
                float s = 0.f;
#pragma unroll
                for (int bj = 0; bj < 2; ++bj) {
                    const f32x4 x0 = __builtin_nontemporal_load((const f32x4*)(x + ro + bj * 128)), x1 = __builtin_nontemporal_load((const f32x4*)(x + ro + bj * 128 + 4));
                    const f32x4 h0 = x0 + gv[bj][0] * acc[ai][bj][m][0], h1 = x1 + gv[bj][1] * acc[ai][bj][m][1];
                    acc[ai][bj][m][0] = h0; acc[ai][bj][m][1] = h1;
                    s += (h0.x * h0.x + h0.y * h0.y) + (h0.z * h0.z + h0.w * h0.w) + (h1.x * h1.x + h1.y * h1.y) + (h1.z * h1.z + h1.w * h1.w);
                }
                s += __shfl_xor(s, 16); s += __shfl_xor(s, 32);
                if (fq == 0) sc[wc * 256 + ai * 128 + wr * 64 + m * 16 + fr] = s;
            }
        asm volatile("s_waitcnt lgkmcnt(0)" ::: "memory"); __builtin_amdgcn_s_barrier(); asm volatile("" ::: "memory");
        if (tid < 256) X[((size_t)u.pm * 8 + u.pn) * 256 + tid] = (sc[tid] + sc[256 + tid]) + (sc[512 + tid] + sc[768 + tid]);
        asm volatile("s_waitcnt vmcnt(0) lgkmcnt(0)" ::: "memory"); __builtin_amdgcn_s_barrier(); asm volatile("" ::: "memory");
        if (tid == 0) {
            unsigned* c = cnt + u.pm * 8;
            __builtin_amdgcn_fence(__ATOMIC_RELEASE, "agent");
            asm volatile("s_waitcnt vmcnt(0) lgkmcnt(0)" ::: "memory");
            __hip_atomic_fetch_add(c, 1u, __ATOMIC_RELAXED, __HIP_MEMORY_SCOPE_AGENT);
            while (__hip_atomic_load(c, __ATOMIC_RELAXED, __HIP_MEMORY_SCOPE_AGENT) < 8u) __builtin_amdgcn_s_sleep(1);
            __builtin_amdgcn_fence(__ATOMIC_ACQUIRE, "agent");
            asm volatile("s_waitcnt vmcnt(0) lgkmcnt(0)" ::: "memory");
        }
        __builtin_amdgcn_s_barrier(); asm volatile("" ::: "memory");
        if (tid < 256) { float t = 0.f;
#pragma unroll
            for (int k = 0; k < 8; ++k) t += __hip_atomic_load(X + ((size_t)u.pm * 8 + k) * 256 + tid, __ATOMIC_RELAXED, __HIP_MEMORY_SCOPE_AGENT);
            sc[1024 + tid] = rsqrtf(t * (1.f / DM) + 1e-6f); }
        asm volatile("s_waitcnt lgkmcnt(0)" ::: "memory"); __builtin_amdgcn_s_barrier(); asm volatile("" ::: "memory");
        f32x4 fv[2][2];
#pragma unroll
        for (int bj = 0; bj < 2; ++bj)
#pragma unroll
            for (int n = 0; n < 2; ++n) fv[bj][n] = *(const f32x4*)(fg + col0 + bj * 128 + 4 * n);
#pragma unroll
        for (int ai = 0; ai < 2; ++ai)
#pragma unroll
            for (int m = 0; m < 4; ++m) {
                const size_t ro = (size_t)(row0 + ai * 128 + m * 16) * DM + col0;
                const float r = sc[1024 + ai * 128 + wr * 64 + m * 16 + fr];
#pragma unroll
                for (int bj = 0; bj < 2; ++bj) {
                    __builtin_nontemporal_store(acc[ai][bj][m][0] * r * fv[bj][0], (f32x4*)(out + ro + bj * 128));
                    __builtin_nontemporal_store(acc[ai][bj][m][1] * r * fv[bj][1], (f32x4*)(out + ro + bj * 128 + 4));
                }
            }
    }
};

#define KSWZ(row, colB) ((row) * 256 + ((colB) ^ (((row) & 7) << 4)))
#define SBAR() __builtin_amdgcn_sched_barrier(0)
__device__ __forceinline__ int crow(int r, int hi) { return (r & 3) + 8 * (r >> 2) + 4 * hi; }
__device__ __forceinline__ int v_st(int k, int c) { const int kk = (k & ~0xC) | ((k & 4) << 1) | ((k & 8) >> 1); return ((kk >> 3) * 4 + (c >> 5)) * 512 + ((kk & 7) * 32 + (c & 31)) * 2; }
__device__ __forceinline__ int v_rd_base(int lane) { return ((lane & 3) << 3) | (((lane >> 2) & 3) << 6) | (((lane >> 4) & 1) << 5) | (((lane >> 5) & 1) << 8); }
constexpr int v_rd_off(int d0, int ks, int half) { return d0 * 512 + ks * 4096 + half * 2048; }
template <int OFF> __device__ __forceinline__ s16x4 tr_read(int vb) {
    s16x4 r; asm volatile("ds_read_b64_tr_b16 %0, %1 offset:%2" : "=&v"(r) : "v"(vb), "i"(OFF) : "memory"); return r;
}
template <int D0> __device__ __forceinline__ void pv_one(f32x16& od, int vb, bf16x8 pa0, bf16x8 pa1, bf16x8 pa2, bf16x8 pa3) {
    const s16x4 l0 = tr_read<v_rd_off(D0, 0, 0)>(vb), h0 = tr_read<v_rd_off(D0, 0, 1)>(vb), l1 = tr_read<v_rd_off(D0, 1, 0)>(vb), h1 = tr_read<v_rd_off(D0, 1, 1)>(vb);
    const s16x4 l2 = tr_read<v_rd_off(D0, 2, 0)>(vb), h2 = tr_read<v_rd_off(D0, 2, 1)>(vb), l3 = tr_read<v_rd_off(D0, 3, 0)>(vb), h3 = tr_read<v_rd_off(D0, 3, 1)>(vb);
    asm volatile("s_waitcnt lgkmcnt(0)" ::: "memory"); SBAR();
#define PK(L, H) (bf16x8){L[0], L[1], L[2], L[3], H[0], H[1], H[2], H[3]}
    od = __builtin_amdgcn_mfma_f32_32x32x16_bf16(pa0, PK(l0, h0), od, 0, 0, 0);
    od = __builtin_amdgcn_mfma_f32_32x32x16_bf16(pa1, PK(l1, h1), od, 0, 0, 0);
    od = __builtin_amdgcn_mfma_f32_32x32x16_bf16(pa2, PK(l2, h2), od, 0, 0, 0);
    od = __builtin_amdgcn_mfma_f32_32x32x16_bf16(pa3, PK(l3, h3), od, 0, 0, 0);
#undef PK
}

template <int NMAP, int D0> __device__ __forceinline__ void pv_all(f32x16 (&o)[NMAP][4], int vb, const bf16x8 (&pa)[NMAP][4]) {
    const s16x4 l0 = tr_read<v_rd_off(D0, 0, 0)>(vb), h0 = tr_read<v_rd_off(D0, 0, 1)>(vb), l1 = tr_read<v_rd_off(D0, 1, 0)>(vb), h1 = tr_read<v_rd_off(D0, 1, 1)>(vb);
    const s16x4 l2 = tr_read<v_rd_off(D0, 2, 0)>(vb), h2 = tr_read<v_rd_off(D0, 2, 1)>(vb), l3 = tr_read<v_rd_off(D0, 3, 0)>(vb), h3 = tr_read<v_rd_off(D0, 3, 1)>(vb);
    asm volatile("s_waitcnt lgkmcnt(0)" ::: "memory"); SBAR();
#define PK(L, H) (bf16x8){L[0], L[1], L[2], L[3], H[0], H[1], H[2], H[3]}
    const bf16x8 v0 = PK(l0, h0), v1 = PK(l1, h1), v2 = PK(l2, h2), v3 = PK(l3, h3);
#undef PK
#pragma unroll
    for (int mp = 0; mp < NMAP; ++mp) o[mp][D0] = __builtin_amdgcn_mfma_f32_32x32x16_bf16(pa[mp][0], v0, o[mp][D0], 0, 0, 0);
#pragma unroll
    for (int mp = 0; mp < NMAP; ++mp) o[mp][D0] = __builtin_amdgcn_mfma_f32_32x32x16_bf16(pa[mp][1], v1, o[mp][D0], 0, 0, 0);
#pragma unroll
    for (int mp = 0; mp < NMAP; ++mp) o[mp][D0] = __builtin_amdgcn_mfma_f32_32x32x16_bf16(pa[mp][2], v2, o[mp][D0], 0, 0, 0);
#pragma unroll
    for (int mp = 0; mp < NMAP; ++mp) o[mp][D0] = __builtin_amdgcn_mfma_f32_32x32x16_bf16(pa[mp][3], v3, o[mp][D0], 0, 0, 0);
}

struct AttnP { const bf16_t *QA, *KA, *VA, *QB, *KB, *VB, *G; bf16_t* MIX; const float *subln_g, *rpb, *lam; };

template <int MODE, bool FAST>
__device__ __forceinline__ int attn_item(const AttnP& a, int b, int h, int blk, char* lds) {
    constexpr int NMAP = MODE == 0 ? 2 : 1, KD0 = MODE == 0 ? 4 : 8, NT = MODE == 0 ? SKV / 64 : 16;
    constexpr float THR = 8.f;
    int tid = threadIdx.x; asm volatile("" : "+v"(tid));
    const int wid = __builtin_amdgcn_readfirstlane(tid >> 6), lane = tid & 63, r32 = lane & 31, hi = lane >> 5;
    char* V_lds = lds; char* K_lds = lds + 32768;
    float* wsf = (float*)(lds + 65536) + wid * 64;
    float* rpbz = (float*)(lds + 65536 + 2048);
    float* rpbs = rpbz + 128;
    char* Qw = lds + 70656 + wid * 8192;
    const size_t bh = (size_t)(b * 8 + h);
    const int qrow = 4 * blk + (wid >> 1), half = wid & 1;
    const int qtok = MODE == 0 ? blk * 256 + wid * 32 : qrow * 64 + half * 32;
    const int ulo = min(max(4 * blk - 4, 0), 116), r0w = min(max(qrow - 4, 0), 120);
    {
        const bf16_t* Qg = (MODE == 0 ? a.QA : a.QB) + (bh * SEQ + qtok) * 128;
#pragma unroll
        for (int i = 0; i < 8; ++i) { const int row = i * 4 + (lane >> 4), c16 = lane & 15;
            const bf16x8 qv = *(const bf16x8*)(Qg + (size_t)row * 128 + c16 * 8);
            *(bf16x8*)(Qw + KSWZ(row, c16 * 16)) = qv; }
    }
    const char* Kh = (const char*)((MODE == 0 ? a.KA : a.KB) + bh * SKV * 128);
    const char* Vh = (const char*)((MODE == 0 ? a.VA : a.VB) + bh * SKV * 128);
    unsigned voffK, voffV;
    {
        const int krow = 4 * wid + (lane >> 4), kch = (lane & 15) ^ (krow & 7);
        voffK = (unsigned)(krow * 256 + kch * 16);
        const int sub = 2 * wid + (lane >> 5), kk = (sub >> 2) * 8 + ((lane & 31) >> 2), cblk = sub & 3;
        const int kreal = kk;
        voffV = (unsigned)(kreal * 256 + (cblk * 32 + (lane & 3) * 8) * 2);
    }
    const int vb0 = (int)(uintptr_t)V_lds + v_rd_base(lane);
    int koff[4];
#pragma unroll
    for (int i = 0; i < 4; ++i) koff[i] = r32 * 256 + (((2 * i + hi) ^ (r32 & 7)) << 4);
    if (MODE == 1) { for (int i = tid; i < 768; i += 512) { const int k = i - 128; rpbz[i] = (k >= 0 && k < 465) ? a.rpb[h * 465 + k] * LOG2E : 0.f; } }
    f32x16 negm0 = f32x16{}, negm1 = f32x16{};
    if (MODE == 1 && FAST) { const int j = half * 32 + r32, c0 = min(max(j - 8, 0), 48);
#pragma unroll
        for (int r = 0; r < 16; ++r) { const int kc = crow(r, hi); negm0[r] = ((unsigned)(kc - c0) < 16u) ? 0.f : -1e30f; negm1[r] = ((unsigned)(kc + 32 - c0) < 16u) ? 0.f : -1e30f; } }
    f32x16 o[NMAP][4]; float m_reg[NMAP], l_reg[NMAP];
#pragma unroll
    for (int mp = 0; mp < NMAP; ++mp) { m_reg[mp] = -1e30f; l_reg[mp] = 0.f;
#pragma unroll
        for (int d = 0; d < 4; ++d) o[mp][d] = f32x16{}; }
#define TROW(t) (MODE == 0 ? (t) * 64 : ((t) < 4 ? SEQ + (t) * 64 : (ulo + (t) - 4) * 64))
#define STAGE(t, bi) do { const size_t g0_ = (size_t)TROW(t) * 256; _Pragma("unroll") for (int ii_ = 0; ii_ < 2; ++ii_) { \
        __builtin_amdgcn_global_load_lds((const unsigned*)(Kh + g0_ + ii_ * 8192 + voffK), (LAS unsigned*)((LAS unsigned char*)K_lds + (bi) * 16384 + wid * 1024 + ii_ * 8192), 16, 0, 0); \
        __builtin_amdgcn_global_load_lds((const unsigned*)(Vh + g0_ + ii_ * 8192 + voffV), (LAS unsigned*)((LAS unsigned char*)V_lds + (bi) * 16384 + wid * 1024 + ii_ * 8192), 16, 0, 0); } } while (0)
    STAGE(0, 0);
    asm volatile("s_waitcnt lgkmcnt(0)" ::: "memory");
    bf16x8 qreg[4];
#pragma unroll
    for (int i = 0; i < 4; ++i) qreg[i] = *(const bf16x8*)(Qw + koff[i]);
    asm volatile("s_waitcnt vmcnt(0) lgkmcnt(0)" ::: "memory");
    __syncthreads();
#pragma nounroll
    for (int t = 0; t < NT; ++t) {
        const int cur = t & 1;
        if (t + 1 < NT) STAGE(t + 1, cur ^ 1);
        bool active = true; int br = 0;
        if (MODE == 1 && t >= 4) { br = ulo + t - 4; active = (br >= r0w) && (br <= r0w + 7); }
        if (active) {
            const char* Kc = K_lds + cur * 16384; const int vb = vb0 + cur * 16384;
            bf16x8 pa[NMAP][4];
#pragma unroll
            for (int mp = 0; mp < NMAP; ++mp) {
                SBAR();
                f32x16 p0 = f32x16{}, p1 = f32x16{};
                if (MODE == 1 && FAST && t >= 4) { p0 = negm0; p1 = negm1; }
#pragma unroll
                for (int d0 = 0; d0 < KD0; ++d0) { const int dd = (MODE == 0 ? mp * 4 : 0) + d0; const int off = koff[dd & 3] + (dd >> 2) * 128;
                    const bf16x8 k0 = *(const bf16x8*)(Kc + off); const bf16x8 k1 = *(const bf16x8*)(Kc + off + 8192);
                    const bf16x8 qf = (dd < 4) ? qreg[dd < 4 ? dd : 0] : *(const bf16x8*)(Qw + off);
                    p0 = __builtin_amdgcn_mfma_f32_32x32x16_bf16(k0, qf, p0, 0, 0, 0);
                    p1 = __builtin_amdgcn_mfma_f32_32x32x16_bf16(k1, qf, p1, 0, 0, 0);
                    if ((d0 & 1) == 1) SBAR(); }
                if (MODE == 1 && FAST && t >= 4) {
                    const float* bp = rpbs + (br - qrow + 7) * 31 + 15 - (half * 32 + r32) + 4 * hi;
#pragma unroll
                    for (int r = 0; r < 16; ++r) { p0[r] += bp[(r & 3) + 8 * (r >> 2)]; p1[r] += bp[32 + (r & 3) + 8 * (r >> 2)]; }
                }
                if (MODE == 1 && !FAST && t >= 4) {
                    const int j = half * 32 + r32, c0 = min(max(j - 8, 0), 48);
                    const float* bp = rpbs + (br - qrow + 7) * 31 + 15 - j;
#pragma unroll
                    for (int r = 0; r < 16; ++r) { const int kc = crow(r, hi); const bool ok = (unsigned)(kc - c0) < 16u; const float bv = bp[ok ? kc : j];
                        p0[r] = ok ? p0[r] + bv : -1e30f; }
#pragma unroll
                    for (int r = 0; r < 16; ++r) { const int kc = 32 + crow(r, hi); const bool ok = (unsigned)(kc - c0) < 16u; const float bv = bp[ok ? kc : j];
                        p1[r] = ok ? p1[r] + bv : -1e30f; }
                }
                float alpha = 1.f;
                if (FAST) {
                    float ps1 = 0.f;
#pragma unroll
                    for (int r = 0; r < 16; ++r) p0[r] = __builtin_amdgcn_exp2f(p0[r]);
#pragma unroll
                    for (int r = 0; r < 16; ++r) p1[r] = __builtin_amdgcn_exp2f(p1[r]);
#pragma unroll
                    for (int r = 0; r < 16; ++r) { ps1 += p0[r]; ps1 += p1[r]; }
                    l_reg[mp] += ps1;
                } else {
                float pmax = p0[0];
#pragma unroll
                for (int r = 1; r < 16; ++r) pmax = fmaxf(pmax, p0[r]);
#pragma unroll
                for (int r = 0; r < 16; ++r) pmax = fmaxf(pmax, p1[r]);
                { auto rr = __builtin_amdgcn_permlane32_swap(__float_as_uint(pmax), __float_as_uint(pmax), false, false);
                  pmax = fmaxf(__uint_as_float(rr[0]), __uint_as_float(rr[1])); }
                float mn = m_reg[mp];
                if (!__all(pmax - m_reg[mp] <= THR)) { mn = fmaxf(m_reg[mp], pmax); alpha = __builtin_amdgcn_exp2f(m_reg[mp] - mn); m_reg[mp] = mn; }
                float ps = 0.f;
#pragma unroll
                for (int r = 0; r < 16; ++r) { p0[r] = __builtin_amdgcn_exp2f(p0[r] - mn); ps += p0[r]; }
#pragma unroll
                for (int r = 0; r < 16; ++r) { p1[r] = __builtin_amdgcn_exp2f(p1[r] - mn); ps += p1[r]; }
                { auto rr = __builtin_amdgcn_permlane32_swap(__float_as_uint(ps), __float_as_uint(ps), false, false);
                  ps = __uint_as_float(rr[0]) + __uint_as_float(rr[1]); }
                l_reg[mp] = l_reg[mp] * alpha + ps;
                }
#define PK4(P, BASE, OUT) do { u32x4 w = {cvtpk(P[BASE + 0], P[BASE + 1]), cvtpk(P[BASE + 2], P[BASE + 3]), cvtpk(P[BASE + 4], P[BASE + 5]), cvtpk(P[BASE + 6], P[BASE + 7])}; \
    OUT = *reinterpret_cast<bf16x8*>(&w); } while (0)
                PK4(p0, 0, pa[mp][0]); PK4(p0, 8, pa[mp][1]); PK4(p1, 0, pa[mp][2]); PK4(p1, 8, pa[mp][3]);
#undef PK4
                if (!FAST && __any(alpha < 1.f)) {
                    if (hi == 0) wsf[r32] = alpha;
                    asm volatile("s_waitcnt lgkmcnt(0)" ::: "memory");
#pragma unroll
                    for (int r = 0; r < 16; ++r) { const float al = wsf[crow(r, hi)];
#pragma unroll
                        for (int d = 0; d < 4; ++d) o[mp][d][r] *= al; }
                }
            }
            SBAR();
            pv_all<NMAP, 0>(o, vb, pa); pv_all<NMAP, 1>(o, vb, pa); pv_all<NMAP, 2>(o, vb, pa); pv_all<NMAP, 3>(o, vb, pa);
        }
        asm volatile("s_waitcnt vmcnt(0)" ::: "memory");
        __syncthreads();
    }
#undef TROW
#undef STAGE
    if (FAST) {
        bool bad = false;
#pragma unroll
        for (int mp = 0; mp < NMAP; ++mp) { auto rr = __builtin_amdgcn_permlane32_swap(__float_as_uint(l_reg[mp]), __float_as_uint(l_reg[mp]), false, false);
            l_reg[mp] = __uint_as_float(rr[0]) + __uint_as_float(rr[1]); bad = bad || !(l_reg[mp] <= 1.0e30f) || !(l_reg[mp] >= 1.0e-30f); }
        if (lane == 0) rpbz[wid] = __any(bad) ? 1.f : 0.f;
        __syncthreads();
        float anyb = 0.f;
#pragma unroll
        for (int w = 0; w < 8; ++w) anyb += rpbz[w];
        __syncthreads();
        if (anyb != 0.f) return 1;
    }
    const float lam = MODE == 0 ? a.lam[0] : 0.f;
    if (hi == 0) { wsf[r32] = 1.f / l_reg[0]; if (MODE == 0) wsf[32 + r32] = lam / l_reg[NMAP - 1]; }
    asm volatile("s_waitcnt lgkmcnt(0)" ::: "memory");
    const size_t obase = ((size_t)b * SEQ + qtok) * DM + (MODE == 0 ? 0 : 1024) + h * 128 + r32;
    float sg[4];
#pragma unroll
    for (int d = 0; d < 4; ++d) sg[d] = MODE == 0 ? a.subln_g[d * 32 + r32] * 0.8f : 1.f;
    bf16_t gq[16][4];
#pragma unroll
    for (int r = 0; r < 16; ++r)
#pragma unroll
        for (int d = 0; d < 4; ++d) gq[r][d] = a.G[obase + (size_t)crow(r, hi) * DM + d * 32];
    asm volatile("s_waitcnt vmcnt(0)" ::: "memory"); SBAR();
#pragma unroll
    for (int r = 0; r < 16; ++r) {
        const int cr = crow(r, hi);
        const float ra = wsf[cr];
        float v[4];
        if (MODE == 0) {
            const float rb = wsf[32 + cr];
            float ss = 0.f;
#pragma unroll
            for (int d = 0; d < 4; ++d) { v[d] = o[0][d][r] * ra - o[NMAP - 1][d][r] * rb; ss += v[d] * v[d]; }
            ss += __shfl_xor(ss, 1); ss += __shfl_xor(ss, 2); ss += __shfl_xor(ss, 4); ss += __shfl_xor(ss, 8); ss += __shfl_xor(ss, 16);
            const float rstd = rsqrtf(ss * (1.f / 128.f) + 1e-5f);
#pragma unroll
            for (int d = 0; d < 4; ++d) v[d] *= rstd * sg[d];
        } else {
#pragma unroll
            for (int d = 0; d < 4; ++d) v[d] = o[0][d][r] * ra;
        }
        const size_t ro = obase + (size_t)cr * DM;
#pragma unroll
        for (int d = 0; d < 4; ++d) { const float gg = bf2f(gq[r][d]); a.MIX[ro + d * 32] = (bf16_t)(cvtpk(v[d] * gg, 0.f) & 0xffffu); }
    }
    return 0;
}

struct Params {
    const float *x, *c, *ctx, *c_ctx, *norm_g, *w_mod, *b_mod, *w_in, *w_out, *lq1, *lk1, *lq2, *lk2, *subln_g, *rpb, *final_g;
    float* out; unsigned char* ws;
};

__device__ __forceinline__ void transpose_item(const float* W, int K, int N, bf16_t* WT, LAS float* scr, int item, int lane, int perm_below) {
    const int nblk = N / 32, kb = item / nblk, nb = item % nblk, k0 = 64 * kb, n0 = 32 * nb;
#pragma unroll 8
    for (int i = 0; i < 32; ++i) { const int kk = 2 * i + (lane >> 5); scr[kk * 33 + (lane & 31)] = __builtin_nontemporal_load(W + (size_t)(k0 + kk) * N + n0 + (lane & 31)); }
    asm volatile("s_waitcnt lgkmcnt(0)" ::: "memory");
    const int c = lane & 7; const bool pr = n0 < perm_below;
#pragma unroll
    for (int j = 0; j < 4; ++j) { const int n = (lane >> 3) + 8 * j; const int ns = pr ? pg8::perm32inv(n) : n; const LAS float* s = scr + (8 * c) * 33 + ns;
        u32x4 o; o.x = cvtpk(s[0 * 33], s[1 * 33]); o.y = cvtpk(s[2 * 33], s[3 * 33]); o.z = cvtpk(s[4 * 33], s[5 * 33]); o.w = cvtpk(s[6 * 33], s[7 * 33]);
        *(u32x4*)(WT + (size_t)(n0 + n) * K + k0 + 8 * c) = o; }
    asm volatile("s_waitcnt lgkmcnt(0)" ::: "memory");
}

__global__ void __launch_bounds__(512, 2) fwd_megakernel(Params p) {
    extern __shared__ __attribute__((aligned(16))) unsigned char lds[];
    cg::grid_group grid = cg::this_grid();
    const int bid = blockIdx.x, G = gridDim.x;
#define TIDS() int tid = threadIdx.x; asm volatile("" : "+v"(tid)); const int lane = tid & 63, wid = __builtin_amdgcn_readfirstlane(tid >> 6); (void)lane; (void)wid;
#define WSPTRS() size_t wsz_ = 0; asm volatile("" : "+s"(wsz_)); unsigned char* ws = p.ws + wsz_;     \
    float* mod = (float*)(ws + WS_MOD); float* lamp = (float*)(ws + WS_LAM); float* rope = (float*)(ws + WS_ROPE); \
    bf16_t* WinT = (bf16_t*)(ws + WS_WIN); bf16_t* WoutT = (bf16_t*)(ws + WS_WOUT); bf16_t* HX = (bf16_t*)(ws + WS_HX); \
    bf16_t* QA = (bf16_t*)(ws + WS_QA); bf16_t* KA = (bf16_t*)(ws + WS_KA); bf16_t* VA = (bf16_t*)(ws + WS_VA); \
    bf16_t* QB = (bf16_t*)(ws + WS_QB); bf16_t* KB = (bf16_t*)(ws + WS_KB); bf16_t* VB = (bf16_t*)(ws + WS_VB); \
    bf16_t* GB = (bf16_t*)(ws + WS_G); bf16_t* MIX = (bf16_t*)(ws + WS_MIX); \
    (void)mod; (void)lamp; (void)rope; (void)WinT; (void)WoutT; (void)HX; (void)QA; (void)KA; (void)VA; (void)QB; (void)KB; (void)VB; (void)GB; (void)MIX;
    { WSPTRS(); TIDS();
    if (bid < 192) {
        const int cgp = bid % 12, kc = bid / 12;
        float* sl = (float*)lds;
        for (int i = tid; i < 640; i += 512) { const int bb = i >> 7, k = kc * 128 + (i & 127); const float v = bb < 4 ? p.c[bb * DM + k] : p.c_ctx[k]; sl[i] = v / (1.f + expf(-v)); }
        __syncthreads();
        const int col = cgp * 512 + tid;
        float a0 = 0.f, a1 = 0.f, a2 = 0.f, a3 = 0.f, a4 = 0.f;
        const float* wp = p.w_mod + (size_t)(kc * 128) * 6144 + col;
#pragma unroll 8
        for (int k = 0; k < 128; ++k) { const float w = wp[(size_t)k * 6144]; a0 += sl[k] * w; a1 += sl[128 + k] * w; a2 += sl[256 + k] * w; a3 += sl[384 + k] * w; a4 += sl[512 + k] * w; }
        if (kc == 0) { const float bm = p.b_mod[col]; a0 += bm; a1 += bm; a2 += bm; a3 += bm; a4 += bm; }
        atomicAdd(mod + col, a0); atomicAdd(mod + 6144 + col, a1); atomicAdd(mod + 2 * 6144 + col, a2); atomicAdd(mod + 3 * 6144 + col, a3); atomicAdd(mod + 4 * 6144 + col, a4);
        __syncthreads();
    } else if (bid < 196) {
        const int idx = (bid - 192) * 512 + tid, pos = idx >> 4, i = idx & 15;
        const float inv = powf(10000.f, -(float)i / 16.f), ang = (float)pos * inv;
        rope[2 * idx] = cosf(ang); rope[2 * idx + 1] = sinf(ang);
    } else if (bid == 196 && wid == 0) {
        const float d1 = wave_sum(p.lq1[lane] * p.lk1[lane]), d2 = wave_sum(p.lq2[lane] * p.lk2[lane]);
        if (lane == 0) lamp[0] = expf(d1) - expf(d2) + 0.2f;
    }
    {
        LAS float* scr = (LAS float*)((LAS unsigned char*)lds + wid * 16384);
        const int gw = bid * 8 + wid, NGW = G * 8;
        constexpr int I_IN = (DM / 64) * (INC / 32), I_OUT = (DM / 64) * (DM / 32);
        for (int it = gw; it < I_IN + I_OUT; it += NGW) {
            if (it < I_IN) transpose_item(p.w_in, DM, INC, WinT, scr, it, lane, 2048);
            else transpose_item(p.w_out, DM, DM, WoutT, scr, it - I_IN, lane, 0);
        }
    }
    }
    grid.sync();

    { WSPTRS(); TIDS();
        const int gw = bid * 8 + wid, NGW = G * 8;
        for (int R = gw; R < NTOK + NCTX; R += NGW) {
            const float* src = R < NTOK ? p.x + (size_t)R * DM : p.ctx + (size_t)(R - NTOK) * DM;
            const float* mr = mod + (R < NTOK ? (R >> 13) : 4) * 6144;
            f32x4 v[8]; float ss = 0.f;
#pragma unroll
            for (int j = 0; j < 8; ++j) { v[j] = __builtin_nontemporal_load((const f32x4*)(src + j * 256 + lane * 4)); ss += (v[j].x * v[j].x + v[j].y * v[j].y) + (v[j].z * v[j].z + v[j].w * v[j].w); }
            const float rstd = rsqrtf(wave_sum(ss) * (1.f / DM) + 1e-6f);
            bf16_t* orow = HX + (size_t)R * DM;
#pragma unroll
            for (int j = 0; j < 8; ++j) { const int k = j * 256 + lane * 4;
                const f32x4 g4 = *(const f32x4*)(p.norm_g + k), sh = *(const f32x4*)(mr + k), sc4 = *(const f32x4*)(mr + 2048 + k);
                const f32x4 y = v[j] * rstd * g4 * (sc4 + 1.f) + sh;
                uint2 w; w.x = cvtpk(y.x, y.y); w.y = cvtpk(y.z, y.w); *(uint2*)(orow + k) = w; }
        }
    }
    grid.sync();

    { WSPTRS();
        pg8::Gemm g{HX, WinT, DM}; pg8::Order S; S.init(NTOK / 256, INC / 256, G, bid, 64);
        EpiIn E{QA, KA, VA, QB, KB, VB, GB, rope};
        pg8::gemm_phase<EpiIn, pg8::Order>((LAS unsigned char*)lds, g, S, E);
    }
    grid.sync();

    { WSPTRS();
        AttnP ap{QA, KA, VA, QB, KB, VB, GB, MIX, p.subln_g, p.rpb, lamp};
        unsigned badmask = 0u; int it = 0;
        for (int L = bid; L < 1024; L += G, ++it) { const int xcd = L & 7, rest = L >> 3, blk = rest & 31, bh = xcd + 8 * (rest >> 5);
            if (attn_item<0, true>(ap, bh >> 3, bh & 7, blk, (char*)lds)) badmask |= 1u << (it & 31); }
        badmask = __builtin_amdgcn_readfirstlane(badmask);
        if (badmask) { it = 0;
            for (int L = bid; L < 1024; L += G, ++it) { const int xcd = L & 7, rest = L >> 3, blk = rest & 31, bh = xcd + 8 * (rest >> 5);
                if ((badmask >> (it & 31)) & 1u) attn_item<0, false>(ap, bh >> 3, bh & 7, blk, (char*)lds); } }
    }
    { WSPTRS();
        AttnP ap{QA, KA, VA, QB, KB, VB, GB, MIX, p.subln_g, p.rpb, lamp};
        unsigned badmask = 0u; int it = 0;
        for (int L = bid; L < 1024; L += G, ++it) { const int xcd = L & 7, rest = L >> 3, blk = rest & 31, bh = xcd + 8 * (rest >> 5);
            if (attn_item<1, true>(ap, bh >> 3, bh & 7, blk, (char*)lds)) badmask |= 1u << (it & 31); }
        badmask = __builtin_amdgcn_readfirstlane(badmask);
        if (badmask) { it = 0;
            for (int L = bid; L < 1024; L += G, ++it) { const int xcd = L & 7, rest = L >> 3, blk = rest & 31, bh = xcd + 8 * (rest >> 5);
                if ((badmask >> (it & 31)) & 1u) attn_item<1, false>(ap, bh >> 3, bh & 7, blk, (char*)lds); } }
    }
    grid.sync();

    { WSPTRS();
        pg8::Gemm g{MIX, WoutT, DM}; pg8::OrderPanel S{bid};
        EpiOutNorm E{p.x, mod, p.final_g, p.out, (float*)(ws + WS_XCH), (unsigned*)(ws + 126976), (LAS float*)((LAS unsigned char*)lds + 131072)};
        pg8::gemm_phase<EpiOutNorm, pg8::OrderPanel>((LAS unsigned char*)lds, g, S, E);
    }
}

extern "C" void kernel_launch(void* const* d_in, const int* in_sizes, int n_in, void* d_out, int out_size, void* d_ws, size_t ws_size, hipStream_t stream) {
    static int grid_blocks = 0;
    if (grid_blocks == 0) {
        if (n_in != 16 || in_sizes[0] != NTOK * DM || out_size != NTOK * DM || ws_size < WS_END) {
            fprintf(stderr, "kernel_launch: shape mismatch (n_in %d in0 %d out %d ws %zu)\n", n_in, n_in > 0 ? in_sizes[0] : -1, out_size, ws_size); grid_blocks = -1; return; }
        int dev = 0, cus = 0, per_cu = 0;
        hipGetDevice(&dev);
        hipDeviceGetAttribute(&cus, hipDeviceAttributeMultiprocessorCount, dev);
        if (hipFuncSetAttribute((const void*)fwd_megakernel, hipFuncAttributeMaxDynamicSharedMemorySize, LDS_BYTES) != hipSuccess) { fprintf(stderr, "kernel_launch: hipFuncSetAttribute failed\n"); grid_blocks = -1; return; }
        hipOccupancyMaxActiveBlocksPerMultiprocessor(&per_cu, (const void*)fwd_megakernel, 512, LDS_BYTES);
        if (per_cu < 1) { fprintf(stderr, "kernel_launch: occupancy query returned %d\n", per_cu); per_cu = 1; }
        (void)hipGetLastError();
        if (cus != 256) { fprintf(stderr, "kernel_launch: built for a 256-CU device (got %d CUs)\n", cus); grid_blocks = -1; return; }
        grid_blocks = cus;
    }
    if (grid_blocks < 0) return;
    hipMemsetAsync((char*)d_ws + WS_MOD, 0, 128 * 1024, stream);
    Params p{};
    p.x = (const float*)d_in[0]; p.c = (const float*)d_in[1]; p.ctx = (const float*)d_in[2]; p.c_ctx = (const float*)d_in[3]; p.norm_g = (const float*)d_in[4];
    p.w_mod = (const float*)d_in[5]; p.b_mod = (const float*)d_in[6]; p.w_in = (const float*)d_in[7]; p.w_out = (const float*)d_in[8];
    p.lq1 = (const float*)d_in[9]; p.lk1 = (const float*)d_in[10]; p.lq2 = (const float*)d_in[11]; p.lk2 = (const float*)d_in[12];
    p.subln_g = (const float*)d_in[13]; p.rpb = (const float*)d_in[14]; p.final_g = (const float*)d_in[15];
    p.out = (float*)d_out; p.ws = (unsigned char*)d_ws;
    void* args[] = {&p};
    hipError_t e = hipLaunchCooperativeKernel((const void*)fwd_megakernel, dim3(grid_blocks), dim3(512), args, LDS_BYTES, stream);
    if (e != hipSuccess) fprintf(stderr, "cooperative launch failed: %s (grid %d)\n", hipGetErrorString(e), grid_blocks);
}
```
